# Optimizing an MI355X kernel written in HIP

```python
import jax, jax.numpy as jnp
from jax import lax
import numpy as np

D_MODEL = 1024
BATCH = 2
SEQ = 8192
DEPTH = 4

ATTN_HEADS = 8
ATTN_HEAD_DIM = 64
ATTN_WIDTH = ATTN_HEADS * ATTN_HEAD_DIM
IDX_HEADS = 4
IDX_HEAD_DIM = 64
MAX_TOPK = 256
Q_BLOCK = 128
HGRN_HEADS = 4
HGRN_KEY_DIM = 128
HGRN_VAL_DIM = 128
HGRN_F_WIDTH = HGRN_HEADS * HGRN_KEY_DIM
HGRN_WIDTH = HGRN_HEADS * HGRN_VAL_DIM
HGRN_CHUNK = 64
D_FF = -(-8 * D_MODEL // (3 * 256)) * 256
ROPE_THETA = 10000.0
EPS = 1e-6
IN_WIDTHS = (ATTN_WIDTH, ATTN_WIDTH, ATTN_WIDTH,
             IDX_HEADS * IDX_HEAD_DIM, IDX_HEAD_DIM, IDX_HEADS,
             HGRN_F_WIDTH, HGRN_F_WIDTH, HGRN_WIDTH, HGRN_WIDTH,
             D_MODEL, D_MODEL)
D_IN = sum(IN_WIDTHS)

kernel_name = "hybrid_dsa_hgrn2_gated_block"


def rmsnorm(x, g):
    xf = x.astype(jnp.float32)
    xf = xf * lax.rsqrt(jnp.mean(xf * xf, axis=-1, keepdims=True) + EPS)
    return xf.astype(x.dtype) * g


def rope_tables(positions, dim):
    inv = ROPE_THETA ** (-jnp.arange(0, dim, 2, dtype=jnp.float32) / dim)
    ang = positions.astype(jnp.float32)[..., None] * inv
    return jnp.cos(ang)[:, :, None, :], jnp.sin(ang)[:, :, None, :]


def apply_rope(x, cos, sin):
    half = x.shape[-1] // 2
    x1 = x[..., :half].astype(jnp.float32)
    x2 = x[..., half:].astype(jnp.float32)
    return jnp.concatenate([x1 * cos - x2 * sin, x2 * cos + x1 * sin], axis=-1).astype(x.dtype)


def dsa_attention(q, k, v, qi, ki, wi):
    B, T, H, Dh = q.shape
    topk = min(MAX_TOPK, T // 4)
    nb = T // Q_BLOCK
    scale = Dh ** -0.5
    key_pos = jnp.arange(T)
    ki32 = ki.astype(jnp.float32)
    gather = jax.vmap(lambda a, i: a[i])

    def to_blocks(a):
        return a.reshape((B, nb, Q_BLOCK) + a.shape[2:]).swapaxes(0, 1)

    def block_fn(args):
        qb, qib, wib, start = args
        qpos = start + jnp.arange(Q_BLOCK)
        visible = key_pos[None, :] <= qpos[:, None]
        rel = jax.nn.relu(jnp.einsum('bqhd,bsd->bqhs', qib.astype(jnp.float32), ki32))
        score = jnp.einsum('bqh,bqhs->bqs', wib.astype(jnp.float32), rel)
        score = jnp.where(visible[None], score, -jnp.inf)
        _, idx = lax.top_k(score, topk)
        k_sel = gather(k, idx).astype(jnp.float32)
        v_sel = gather(v, idx).astype(jnp.float32)
        logits = jnp.einsum('bqhd,bqkhd->bhqk', qb.astype(jnp.float32), k_sel) * scale
        valid = idx <= qpos[None, :, None]
        logits = jnp.where(valid[:, None], logits, -jnp.inf)
        p = jax.nn.softmax(logits, axis=-1)
        return jnp.einsum('bhqk,bqkhd->bqhd', p, v_sel).astype(q.dtype)

    starts = jnp.arange(nb) * Q_BLOCK
    out = lax.map(block_fn, (to_blocks(q), to_blocks(qi), to_blocks(wi), starts))
    return out.swapaxes(0, 1).reshape(B, T, H * Dh)


def hgrn2_chunked(q, k, v, log_f):
    B, T, H, dk = q.shape
    dv = v.shape[-1]
    C = HGRN_CHUNK
    nc = T // C

    def chunks(a):
        return a.reshape(B, nc, C, H, a.shape[-1]).transpose(1, 0, 3, 2, 4)

    b = jnp.cumsum(chunks(log_f), axis=3)
    causal = jnp.tril(jnp.ones((C, C), dtype=bool))

    def step(S, xs):
        qc, kc, vc, bc = xs
        inter = jnp.einsum('bhtd,bhde->bhte', qc * jnp.exp(bc), S)
        diff = bc[:, :, :, None, :] - bc[:, :, None, :, :]
        decay = jnp.exp(jnp.where(causal[:, :, None], diff, -jnp.inf))
        A = jnp.einsum('bhtd,bhsd,bhtsd->bhts', qc, kc, decay)
        intra = jnp.einsum('bhts,bhse->bhte', A, vc)
        b_last = bc[:, :, -1:, :]
        S = jnp.exp(b_last[:, :, 0, :])[..., None] * S + jnp.einsum(
            'bhsd,bhse->bhde', kc * jnp.exp(b_last - bc), vc)
        return S, inter + intra

    S0 = jnp.zeros((B, H, dk, dv), jnp.float32)
    _, o = lax.scan(step, S0, (chunks(q), chunks(k), chunks(v), b))
    return o.transpose(1, 0, 3, 2, 4).reshape(B, T, H, dv)


def setup_inputs(seed: int = 0) -> dict:
    key = jax.random.key(seed)
    ks = jax.random.split(key, 16)
    f32 = jnp.float32
    x = jax.random.normal(ks[0], (BATCH, SEQ, D_MODEL), f32)
    offset = jax.random.randint(ks[1], (BATCH, 1), 0, 4096, dtype=jnp.int32)
    positions = offset + jnp.arange(SEQ, dtype=jnp.int32)[None, :]
    res_scale = (2 * DEPTH) ** -0.5
    w_in = jax.random.normal(ks[2], (DEPTH, D_MODEL, D_IN), f32) * D_MODEL ** -0.5
    w_proj_attn = jax.random.normal(ks[3], (DEPTH, ATTN_WIDTH, D_MODEL), f32) * ATTN_WIDTH ** -0.5
    w_proj_hgrn = jax.random.normal(ks[4], (DEPTH, HGRN_WIDTH, D_MODEL), f32) * HGRN_WIDTH ** -0.5
    w_out = jax.random.normal(ks[5], (DEPTH, D_MODEL, D_MODEL), f32) * D_MODEL ** -0.5 * res_scale
    norm_mix = 1.0 + 0.02 * jax.random.normal(ks[6], (DEPTH, D_MODEL), f32)
    norm_ffn = 1.0 + 0.02 * jax.random.normal(ks[7], (DEPTH, D_MODEL), f32)
    q_norm = 1.0 + 0.02 * jax.random.normal(ks[8], (DEPTH, ATTN_HEAD_DIM), f32)
    k_norm = 1.0 + 0.02 * jax.random.normal(ks[9], (DEPTH, ATTN_HEAD_DIM), f32)
    hgrn_norm = 1.0 + 0.02 * jax.random.normal(ks[10], (DEPTH, HGRN_VAL_DIM), f32)
    hgrn_lower_bound = 0.5 * jax.random.normal(ks[11], (DEPTH, HGRN_F_WIDTH), f32)
    w_ffn_in = jax.random.normal(ks[12], (DEPTH, D_MODEL, 2 * D_FF), f32) * D_MODEL ** -0.5
    w_ffn_out = jax.random.normal(ks[13], (DEPTH, D_FF, D_MODEL), f32) * D_FF ** -0.5 * res_scale
    return {"x": x, "positions": positions, "w_in": w_in, "w_proj_attn": w_proj_attn,
            "w_proj_hgrn": w_proj_hgrn, "w_out": w_out, "norm_mix": norm_mix, "norm_ffn": norm_ffn,
            "q_norm": q_norm, "k_norm": k_norm, "hgrn_norm": hgrn_norm,
            "hgrn_lower_bound": hgrn_lower_bound, "w_ffn_in": w_ffn_in, "w_ffn_out": w_ffn_out}


def reference(x, positions, w_in, w_proj_attn, w_proj_hgrn, w_out, norm_mix, norm_ffn,
              q_norm, k_norm, hgrn_norm, hgrn_lower_bound, w_ffn_in, w_ffn_out):
    B, T, _ = x.shape
    cos, sin = rope_tables(positions, ATTN_HEAD_DIM)
    split_points = list(np.cumsum(IN_WIDTHS)[:-1])
    lb_all = jnp.cumsum(jax.nn.softmax(hgrn_lower_bound.astype(jnp.float32), axis=0), axis=0)
    lb_all = lb_all - lb_all[:1]
    for l in range(DEPTH):
        h = rmsnorm(x, norm_mix[l])
        proj = h @ w_in[l]
        aq, ak, av, iq, ik, iw, hq, hf, hi, hg, ga, gb = jnp.split(proj, split_points, axis=-1)
        aq = apply_rope(rmsnorm(aq.reshape(B, T, ATTN_HEADS, ATTN_HEAD_DIM), q_norm[l]), cos, sin)
        ak = apply_rope(rmsnorm(ak.reshape(B, T, ATTN_HEADS, ATTN_HEAD_DIM), k_norm[l]), cos, sin)
        av = av.reshape(B, T, ATTN_HEADS, ATTN_HEAD_DIM)
        iq = apply_rope(iq.reshape(B, T, IDX_HEADS, IDX_HEAD_DIM), cos, sin) * (IDX_HEAD_DIM ** -0.5)
        ik = apply_rope(ik[:, :, None, :], cos, sin)[:, :, 0, :]
        iw = iw * (IDX_HEADS ** -0.5)
        y_attn = dsa_attention(aq, ak, av, iq, ik, iw)
        lb = lb_all[l].reshape(HGRN_HEADS, HGRN_KEY_DIM)
        hf32 = hf.astype(jnp.float32).reshape(B, T, HGRN_HEADS, HGRN_KEY_DIM)
        log_f = jnp.logaddexp(jnp.log(lb), jnp.log1p(-lb) + jax.nn.log_sigmoid(hf32))
        k_in = -jnp.expm1(log_f)
        q_h = jax.nn.silu(hq.astype(jnp.float32)).reshape(B, T, HGRN_HEADS, HGRN_KEY_DIM)
        v_h = hi.astype(jnp.float32).reshape(B, T, HGRN_HEADS, HGRN_VAL_DIM)
        o = hgrn2_chunked(q_h, k_in, v_h, log_f).astype(x.dtype)
        o = rmsnorm(o, hgrn_norm[l]) * jax.nn.silu(hg.reshape(B, T, HGRN_HEADS, HGRN_VAL_DIM))
        y_hgrn = o.reshape(B, T, HGRN_WIDTH)
        merged = jax.nn.sigmoid(ga) * (y_attn @ w_proj_attn[l]) + jax.nn.sigmoid(gb) * (y_hgrn @ w_proj_hgrn[l])
        x = x + merged @ w_out[l]
        h = rmsnorm(x, norm_ffn[l])
        g, u = jnp.split(h @ w_ffn_in[l], 2, axis=-1)
        x = x + (jax.nn.silu(g) * u) @ w_ffn_out[l]
    return x
```

```cpp
#include <hip/hip_runtime.h>
#include <hip/hip_cooperative_groups.h>
#include <stdint.h>
#include <stdio.h>
namespace cg = cooperative_groups;

#ifndef COOP_MODE
#define COOP_MODE 1
#endif

typedef unsigned short u16;
typedef unsigned int u32;
typedef unsigned long long u64;
typedef __attribute__((ext_vector_type(8))) short bf16x8;
typedef __attribute__((ext_vector_type(16))) float f32x16;
typedef __attribute__((ext_vector_type(4))) u32 u32x4;
typedef __attribute__((ext_vector_type(2))) u32 u32x2;
typedef __attribute__((ext_vector_type(2))) unsigned short u16x2;

constexpr int NTOK = 16384, SEQ = 8192, DEPTH = 4;
constexpr int DFF = 2816;
constexpr float EPS = 1e-6f;
constexpr size_t MiB = (size_t)1 << 20;
constexpr size_t OFF_WIN = 0, OFF_WGATE = 8 * MiB, OFF_WPA = 12 * MiB, OFF_WPH = 13 * MiB, OFF_WOUT = 14 * MiB,
                 OFF_WFFI = 16 * MiB, OFF_WFFO = 27 * MiB, OFF_AQ = 33 * MiB, OFF_AK = 49 * MiB, OFF_AVT = 65 * MiB,
                 OFF_IQ = 81 * MiB, OFF_IK = 89 * MiB, OFF_IW = 91 * MiB, OFF_HQ = 92 * MiB, OFF_HVT = 108 * MiB,
                 OFF_HG = 124 * MiB, OFF_LOGF = 140 * MiB, OFF_XB = 172 * MiB, OFF_YH = 204 * MiB, OFF_MASK = 220 * MiB,
                 OFF_ROWSS = 236 * MiB, OFF_CODES = 238 * MiB, OFF_YA = OFF_CODES, OFF_US = OFF_CODES + 16 * MiB,
                 OFF_GDEC = OFF_CODES + 48 * MiB, OFF_MERGED = OFF_AQ, OFF_ACT = OFF_AQ, OFF_BAR = 32 * MiB + 768 * 1024, WS_END = 368 * MiB;
constexpr size_t CODES_PER_BATCH = (size_t)16384 * 2080;

struct P {
  const float* x; const int* pos; const float* w_in; const float* w_pa; const float* w_ph; const float* w_out;
  const float* nmix; const float* nffn; const float* qn; const float* kn; const float* hn; const float* hlb;
  const float* w_ffi; const float* w_ffo; float* out; char* ws;
};

__device__ __forceinline__ u16 f2bf(float f) {
  u32 u = __float_as_uint(f);
  u += 0x7FFFu + ((u >> 16) & 1u);
  return (u16)(u >> 16);
}
__device__ __forceinline__ float bf2f(u16 v) { return __uint_as_float(((u32)v) << 16); }
__device__ __forceinline__ u32 pack2(float a, float b) { u32 r; asm("v_cvt_pk_bf16_f32 %0, %1, %2" : "=v"(r) : "v"(a), "v"(b)); return r; }
__device__ __forceinline__ float wave_sum(float v) {
#pragma unroll
  for (int o = 32; o >= 1; o >>= 1) v += __shfl_xor(v, o);
  return v;
}
__device__ __forceinline__ float sigmoidf_(float x) { return 1.f / (1.f + __expf(-x)); }
__device__ __forceinline__ float siluf_(float x) { return x / (1.f + __expf(-x)); }

template <int ROWS>
__device__ __forceinline__ void g2r(u32x4 (&r)[ROWS / 32], const u16* g, size_t ld, int tid) {
  const int c = tid & 7, row = tid >> 3;
#pragma unroll
  for (int i = 0; i < ROWS / 32; ++i) r[i] = *(const u32x4*)(g + (size_t)(row + 32 * i) * ld + c * 8);
}
template <int ROWS>
__device__ __forceinline__ void r2s(const u32x4 (&r)[ROWS / 32], char* s, int tid) {
  const int c = tid & 7, row = tid >> 3;
#pragma unroll
  for (int i = 0; i < ROWS / 32; ++i) {
    const int rr = row + 32 * i;
    *(u32x4*)(s + rr * 128 + ((c ^ ((rr >> 1) & 7)) << 4)) = r[i];
  }
}
__device__ __forceinline__ bf16x8 lds_frag(const char* s, int row, int kc) {
  return *(const bf16x8*)(s + row * 128 + ((kc ^ ((row >> 1) & 7)) << 4));
}
__device__ __forceinline__ int rowof(int reg, int lane) { return (reg & 3) + 8 * (reg >> 2) + 4 * (lane >> 5); }

template <int MI, int NI>
__device__ __forceinline__ void mma_tile(f32x16 (&acc)[MI][NI], const char* xs, int xrow0, const char* ys, int yrow0,
                                         int lane) {
  const int r = lane & 31, h = lane >> 5;
  bf16x8 a[2][MI], b[2][NI];
#pragma unroll
  for (int mi = 0; mi < MI; ++mi) a[0][mi] = lds_frag(xs, xrow0 + mi * 32 + r, h);
#pragma unroll
  for (int ni = 0; ni < NI; ++ni) b[0][ni] = lds_frag(ys, yrow0 + ni * 32 + r, h);
#pragma unroll
  for (int ks = 0; ks < 4; ++ks) {
    const int c = ks & 1, n = c ^ 1;
    if (ks < 3) {
#pragma unroll
      for (int mi = 0; mi < MI; ++mi) a[n][mi] = lds_frag(xs, xrow0 + mi * 32 + r, (ks + 1) * 2 + h);
#pragma unroll
      for (int ni = 0; ni < NI; ++ni) b[n][ni] = lds_frag(ys, yrow0 + ni * 32 + r, (ks + 1) * 2 + h);
    }
    __builtin_amdgcn_sched_barrier(0);
#pragma unroll
    for (int mi = 0; mi < MI; ++mi)
#pragma unroll
      for (int ni = 0; ni < NI; ++ni)
        acc[mi][ni] = __builtin_amdgcn_mfma_f32_32x32x16_bf16(a[c][mi], b[c][ni], acc[mi][ni], 0, 0, 0);
    __builtin_amdgcn_sched_barrier(0);
  }
}

template <int YR, int NI>
__device__ __forceinline__ void gemm_loop_shallow(f32x16 (&acc)[2][NI], const u16* X, size_t ldx, const u16* Y, size_t ldy,
                                          int KT, char* smem, int tid) {
  const int lane = tid & 63, w = tid >> 6, wm = w & 1, wn = w >> 1;
  char* xs = smem;
  char* ys = smem + 32768;
  u32x4 xr[4], yr[YR / 32];
  g2r<128>(xr, X, ldx, tid);
  g2r<YR>(yr, Y, ldy, tid);
  r2s<128>(xr, xs, tid);
  r2s<YR>(yr, ys, tid);
  __syncthreads();
#pragma unroll 1
  for (int kt = 0; kt < KT; ++kt) {
    const int cur = kt & 1;
    if (kt + 1 < KT) {
      g2r<128>(xr, X + (size_t)(kt + 1) * 64, ldx, tid);
      g2r<YR>(yr, Y + (size_t)(kt + 1) * 64, ldy, tid);
    }
    mma_tile<2, NI>(acc, xs + cur * 16384, wm * 64, ys + cur * (YR * 128), wn * 32 * NI, lane);
    if (kt + 1 < KT) {
      r2s<128>(xr, xs + (cur ^ 1) * 16384, tid);
      r2s<YR>(yr, ys + (cur ^ 1) * (YR * 128), tid);
    }
    __syncthreads();
  }
}
template <int YR, int NI>
__device__ __forceinline__ void gemm_loop_deep(f32x16 (&acc)[2][NI], const u16* X, size_t ldx, const u16* Y, size_t ldy,
                                          int KT, char* smem, int tid) {
  const int lane = tid & 63, w = tid >> 6, wm = w & 1, wn = w >> 1;
  char* xs = smem;
  char* ys = smem + 32768;
  u32x4 xa[4], ya[YR / 32], xb[4], yb[YR / 32];
  g2r<128>(xa, X, ldx, tid);
  g2r<YR>(ya, Y, ldy, tid);
  g2r<128>(xb, X + 64, ldx, tid);
  g2r<YR>(yb, Y + 64, ldy, tid);
  r2s<128>(xa, xs, tid);
  r2s<YR>(ya, ys, tid);
  __syncthreads();
#pragma unroll 1
  for (int kt = 0; kt < KT; kt += 2) {
    if (kt + 2 < KT) {
      g2r<128>(xa, X + (size_t)(kt + 2) * 64, ldx, tid);
      g2r<YR>(ya, Y + (size_t)(kt + 2) * 64, ldy, tid);
    }
    mma_tile<2, NI>(acc, xs, wm * 64, ys, wn * 32 * NI, lane);
    r2s<128>(xb, xs + 16384, tid);
    r2s<YR>(yb, ys + YR * 128, tid);
    __syncthreads();
    if (kt + 3 < KT) {
      g2r<128>(xb, X + (size_t)(kt + 3) * 64, ldx, tid);
      g2r<YR>(yb, Y + (size_t)(kt + 3) * 64, ldy, tid);
    }
    mma_tile<2, NI>(acc, xs + 16384, wm * 64, ys + YR * 128, wn * 32 * NI, lane);
    if (kt + 2 < KT) {
      r2s<128>(xa, xs, tid);
      r2s<YR>(ya, ys, tid);
    }
    __syncthreads();
  }
}
template <int YR, int NI>
__device__ __forceinline__ void gemm_loop(f32x16 (&acc)[2][NI], const u16* X, size_t ldx, const u16* Y, size_t ldy,
                                          int KT, char* smem, int tid) {
  if constexpr (YR == 128) gemm_loop_deep<YR, NI>(acc, X, ldx, Y, ldy, KT, smem, tid);
  else gemm_loop_shallow<YR, NI>(acc, X, ldx, Y, ldy, KT, smem, tid);
}
template <int NI>
__device__ __forceinline__ void zero_acc(f32x16 (&acc)[2][NI]) {
#pragma unroll
  for (int mi = 0; mi < 2; ++mi)
#pragma unroll
    for (int ni = 0; ni < NI; ++ni)
#pragma unroll
      for (int r = 0; r < 16; ++r) acc[mi][ni][r] = 0.f;
}

__device__ __forceinline__ int conv_map(int mode, int n) {
  if (mode == 0) return n < 1860 ? n : (n < 1920 ? -1 : n - 60);
  if (mode == 1) {
    const int tile = n >> 7, r = n & 127, sub = r >> 5;
    return 3908 + (sub & 1) * 1024 + tile * 64 + (sub >> 1) * 32 + (r & 31);
  }
  if (mode == 3) {
    const int tile = n >> 7, r = n & 127, sub = r >> 5;
    const int j = tile * 64 + (sub >> 1) * 32 + (r & 31);
    return (sub & 1) ? DFF + j : j;
  }
  return n;
}
__device__ __forceinline__ void conv_tile(const float* src, int ld, int K, int mode, const float* scale, u16* dst, int tile, float* lds,
                          int tid) {
  const int ktiles = K >> 6;
  const int ntile = tile / ktiles, ktile = tile - ntile * ktiles;
  const int n0 = ntile * 64, k0 = ktile * 64;
  const int nl = tid & 63, kg = tid >> 6;
  const int col = conv_map(mode, n0 + nl);
#pragma unroll 4
  for (int i = 0; i < 16; ++i) {
    const int k = i * 4 + kg;
    float v = 0.f;
    if (col >= 0) v = src[(size_t)(k0 + k) * ld + col];
    if (scale) v *= scale[k0 + k];
    lds[k * 65 + nl] = v;
  }
  __syncthreads();
  const int nr = tid >> 2, part = tid & 3;
  u32 o[8];
#pragma unroll
  for (int i = 0; i < 8; ++i)
    o[i] = pack2(lds[(part * 16 + 2 * i) * 65 + nr], lds[(part * 16 + 2 * i + 1) * 65 + nr]);
  u32x4* d = (u32x4*)(dst + (size_t)(n0 + nr) * K + k0 + part * 16);
  d[0] = u32x4{o[0], o[1], o[2], o[3]};
  d[1] = u32x4{o[4], o[5], o[6], o[7]};
}
__device__ __forceinline__ void conv_item(const P& p, int l, int c, char* smem, int tid) {
  const float* src; int ld, K, mode; const float* scale = nullptr; u16* dst;
  if (c < 992) { src = p.w_in + (size_t)l * 1024 * 5956; ld = 5956; K = 1024; mode = 0; scale = p.nmix + l * 1024; dst = (u16*)(p.ws + OFF_WIN); }
  else if (c < 1504) { c -= 992; src = p.w_in + (size_t)l * 1024 * 5956; ld = 5956; K = 1024; mode = 1; scale = p.nmix + l * 1024; dst = (u16*)(p.ws + OFF_WGATE); }
  else if (c < 1632) { c -= 1504; src = p.w_pa + (size_t)l * 512 * 1024; ld = 1024; K = 512; mode = 2; dst = (u16*)(p.ws + OFF_WPA); }
  else if (c < 1760) { c -= 1632; src = p.w_ph + (size_t)l * 512 * 1024; ld = 1024; K = 512; mode = 2; dst = (u16*)(p.ws + OFF_WPH); }
  else if (c < 2016) { c -= 1760; src = p.w_out + (size_t)l * 1024 * 1024; ld = 1024; K = 1024; mode = 2; dst = (u16*)(p.ws + OFF_WOUT); }
  else if (c < 3424) { c -= 2016; src = p.w_ffi + (size_t)l * 1024 * 5632; ld = 5632; K = 1024; mode = 3; scale = p.nffn + l * 1024; dst = (u16*)(p.ws + OFF_WFFI); }
  else { c -= 3424; src = p.w_ffo + (size_t)l * DFF * 1024; ld = 1024; K = DFF; mode = 2; dst = (u16*)(p.ws + OFF_WFFO); }
  conv_tile(src, ld, K, mode, scale, dst, c, (float*)smem, tid);
}

__device__ __forceinline__ void p0_rows(const P& p, int item, int tid) {
  const int lane = tid & 63, w = tid >> 6;
  const int tok = item * 4 + w;
  const float4* xr = (const float4*)(p.x + (size_t)tok * 1024);
  float4* orow = (float4*)(p.out + (size_t)tok * 1024);
  u32x2* xb = (u32x2*)(p.ws + OFF_XB + (size_t)tok * 2048);
  float ss = 0.f;
#pragma unroll
  for (int i = 0; i < 4; ++i) {
    float4 v = xr[lane + 64 * i];
    ss += v.x * v.x + v.y * v.y + v.z * v.z + v.w * v.w;
    orow[lane + 64 * i] = v;
    xb[lane + 64 * i] = u32x2{pack2(v.x, v.y), pack2(v.z, v.w)};
  }
  ss = wave_sum(ss);
  float* rowss = (float*)(p.ws + OFF_ROWSS);
  if (lane < 16) rowss[(size_t)tok * 16 + lane] = lane == 0 ? ss : 0.f;
}


__device__ __forceinline__ float row_rstd(const float* part, int tok) {
  const float4* q = (const float4*)(part + (size_t)tok * 16);
  const float4 a = q[0], b = q[1], c = q[2], d = q[3];
  const float ss = ((a.x + a.y) + (a.z + a.w)) + ((b.x + b.y) + (b.z + b.w)) + ((c.x + c.y) + (c.z + c.w)) + ((d.x + d.y) + (d.z + d.w));
  return rsqrtf(ss * (1.f / 1024.f) + EPS);
}
__device__ __forceinline__ void rope_cs(int pos, int d1, float& c, float& s) {
  const float inv = exp2f(-(float)d1 * (13.287712379549449f / 32.f));
  const float ang = (float)pos * inv;
  double rv = (double)ang * 0.15915494309189535;
  rv -= floor(rv);
  const float r = (float)rv;
  c = __builtin_amdgcn_cosf(r);
  s = __builtin_amdgcn_sinf(r);
}

__device__ __forceinline__ void phaseA_tile(const P& p, int l, int mt, int nt, char* smem, int tid) {
  const int lane = tid & 63, w = tid >> 6, wm = w & 1, wn = w >> 1, h = lane >> 5, lr = lane & 31;
  const int m0 = mt * 128;
  float* rs = (float*)(smem + 65536);
  const float* rowss = (const float*)(p.ws + OFF_ROWSS);
  if (tid < 128) rs[tid] = row_rstd(rowss, m0 + tid);
  const u16* XB = (const u16*)(p.ws + OFF_XB) + (size_t)m0 * 1024;
  const u16* W = (const u16*)(p.ws + OFF_WIN) + (size_t)nt * 128 * 1024;
  const bool fr = (nt < 15) || (nt >= 23 && nt < 27);
  f32x16 acc[2][2];
  zero_acc<2>(acc);
  if (fr) gemm_loop<128, 2>(acc, W, 1024, XB, 1024, 16, smem, tid);
  else gemm_loop<128, 2>(acc, XB, 1024, W, 1024, 16, smem, tid);

  if (fr) {
    if (nt < 8 || (nt >= 12 && nt < 15)) {
      const bool isidx = nt >= 12;
      const int fbase = isidx ? (nt - 12) * 128 + wm * 64 : nt * 128 + wm * 64;
      if (isidx && nt == 14 && wm == 1) {
#pragma unroll
        for (int ni = 0; ni < 2; ++ni) {
          const int tl = wn * 64 + ni * 32 + lr;
          const float rstd = rs[tl] * 0.5f;
          if (h == 0) {
            float4 o = {acc[0][ni][0] * rstd, acc[0][ni][1] * rstd, acc[0][ni][2] * rstd, acc[0][ni][3] * rstd};
            *(float4*)(p.ws + OFF_IW + (size_t)(m0 + tl) * 16) = o;
          }
        }
        return;
      }
      const bool isk = (!isidx) && fbase >= 512;
      const int head = isidx ? (nt == 14 ? 0 : (fbase >> 6)) : ((fbase & 511) >> 6);
      const float* nw = isidx ? nullptr : (isk ? p.kn + l * 64 : p.qn + l * 64);
      u16* dst; int dld;
      float oscale = 1.f;
      if (!isidx) { dst = (u16*)(p.ws + (isk ? OFF_AK : OFF_AQ)); dld = 512; if (!isk) oscale = 0.125f * 1.4426950408889634f; }
      else if (nt < 14) { dst = (u16*)(p.ws + OFF_IQ); dld = 256; oscale = 0.125f; }
      else { dst = (u16*)(p.ws + OFF_IK); dld = 64; }
#pragma unroll
      for (int ni = 0; ni < 2; ++ni) {
        const int tl = wn * 64 + ni * 32 + lr;
        const int tok = m0 + tl;
        const float rstd = rs[tl];
        const int pos = p.pos[tok];
        float rn = rstd;
        if (!isidx) {
          float ss = 0.f;
#pragma unroll
          for (int mi = 0; mi < 2; ++mi)
#pragma unroll
            for (int r = 0; r < 16; ++r) { const float v = acc[mi][ni][r] * rstd; ss += v * v; }
          ss += __shfl_xor(ss, 32);
          rn = rstd * rsqrtf(ss * (1.f / 64.f) + EPS);
        }
        u16* drow = dst + (size_t)tok * dld + head * 64;
#pragma unroll
        for (int rg = 0; rg < 4; ++rg) {
          float o1[4], o2[4];
#pragma unroll
          for (int j = 0; j < 4; ++j) {
            const int r = rg * 4 + j;
            const int d1 = j + 8 * rg + 4 * h;
            float x1 = acc[0][ni][r] * rn, x2 = acc[1][ni][r] * rn;
            if (!isidx) { x1 *= nw[d1]; x2 *= nw[d1 + 32]; }
            float c, s;
            rope_cs(pos, d1, c, s);
            o1[j] = (x1 * c - x2 * s) * oscale;
            o2[j] = (x2 * c + x1 * s) * oscale;
          }
          const int d1b = 8 * rg + 4 * h;
          *(u32x2*)(drow + d1b) = u32x2{pack2(o1[0], o1[1]), pack2(o1[2], o1[3])};
          *(u32x2*)(drow + d1b + 32) = u32x2{pack2(o2[0], o2[1]), pack2(o2[2], o2[3])};
          __builtin_amdgcn_sched_barrier(0);
        }
      }
    } else {
      const bool isav = nt < 12;
      u16* dst = (u16*)(p.ws + (isav ? OFF_AVT : OFF_HVT));
#pragma unroll
      for (int ni = 0; ni < 2; ++ni) {
        const int tl = wn * 64 + ni * 32 + lr;
        const int tok = m0 + tl;
        const float rstd = rs[tl];
        const int b = tok >> 13, t = tok & 8191;
#pragma unroll
        for (int mi = 0; mi < 2; ++mi)
#pragma unroll
          for (int r = 0; r < 16; ++r) {
            const int f = (isav ? (nt - 8) : (nt - 23)) * 128 + wm * 64 + mi * 32 + rowof(r, lane);
            dst[((size_t)(b * 512 + f)) * 8192 + t] = f2bf(acc[mi][ni][r] * rstd);
            if ((r & 3) == 3) __builtin_amdgcn_sched_barrier(0);
          }
      }
    }
  } else {
    const int seg = (nt - 15) >> 2;
    const int fb = ((nt - 15) & 3) * 128 + wn * 64;
#pragma unroll
    for (int ni = 0; ni < 2; ++ni) {
      const int f = fb + ni * 32 + lr;
      float lb = 0.f;
      if (seg == 1) {
        float e[4], mx = -1e30f;
#pragma unroll
        for (int i = 0; i < 4; ++i) { e[i] = p.hlb[i * 512 + f]; mx = fmaxf(mx, e[i]); }
        float tot = 0.f, part = 0.f;
#pragma unroll
        for (int i = 0; i < 4; ++i) { e[i] = __expf(e[i] - mx); tot += e[i]; if (i >= 1 && i <= l) part += e[i]; }
        lb = part / tot;
      }
#pragma unroll
      for (int mi = 0; mi < 2; ++mi)
#pragma unroll
        for (int r = 0; r < 16; ++r) {
          const int tl = wm * 64 + mi * 32 + rowof(r, lane);
          const float v = acc[mi][ni][r] * rs[tl];
          const size_t o = (size_t)(m0 + tl) * 512 + f;
          if (seg == 0) ((u16*)(p.ws + OFF_HQ))[o] = f2bf(siluf_(v));
          else if (seg == 3) ((u16*)(p.ws + OFF_HG))[o] = f2bf(siluf_(v));
          else {
            const float sg = 1.f / (1.f + __expf(-v));
            ((float*)(p.ws + OFF_LOGF))[o] = logf(lb + (1.f - lb) * sg);
          }
          if ((r & 3) == 3) __builtin_amdgcn_sched_barrier(0);
        }
    }
  }
}

__device__ __forceinline__ void hgrn_load_cumsum(const P& p, int tok0, int hh, int d, int hf, float (&lf)[32],
                                                 float (&cs)[32]) {
  const float* src = (const float*)(p.ws + OFF_LOGF) + (size_t)(tok0 + hf * 32) * 512 + hh * 128 + d;
#pragma unroll
  for (int i = 0; i < 32; ++i) lf[i] = src[(size_t)i * 512];
  float run = 0.f;
#pragma unroll
  for (int i = 0; i < 32; ++i) { run += lf[i]; cs[i] = run; }
}
__device__ __forceinline__ void put_td(char* base, int t, int d, float v) {
  const int kt = d >> 6, dd = d & 63;
  *(u16*)(base + kt * 8192 + t * 128 + (((dd >> 3) ^ ((t >> 1) & 7)) << 4) + (dd & 7) * 2) = f2bf(v);
}

__device__ __forceinline__ void h1_item(const P& p, int item, char* smem, int tid) {
  const int lane = tid & 63, w = tid >> 6, wm = w & 1, wn = w >> 1;
  const int b = item >> 9, hh = (item >> 7) & 3, c = item & 127;
  const int tok0 = b * SEQ + c * 64;
  const int d = tid & 127, hf = tid >> 7;
  char* vts = smem;
  char* kts = smem + 16384;
  float* tot = (float*)(smem + 65536);
  u32x4 vr[4];
  g2r<128>(vr, (const u16*)(p.ws + OFF_HVT) + ((size_t)(b * 512 + hh * 128)) * 8192 + c * 64, 8192, tid);
  float lf[32], cs[32];
  hgrn_load_cumsum(p, tok0, hh, d, hf, lf, cs);
  tot[hf * 128 + d] = cs[31];
  r2s<128>(vr, vts, tid);
  __syncthreads();
  const float after = hf ? 0.f : tot[128 + d];
  if (hf) ((float*)(p.ws + OFF_GDEC))[(size_t)item * 128 + d] = __expf(cs[31] + tot[d]);
#pragma unroll
  for (int ch = 0; ch < 4; ++ch) {
    u32 o[4];
#pragma unroll
    for (int j = 0; j < 4; ++j) {
      const int i0 = ch * 8 + 2 * j;
      const float k0 = (1.f - __expf(lf[i0])) * __expf(cs[31] - cs[i0] + after);
      const float k1 = (1.f - __expf(lf[i0 + 1])) * __expf(cs[31] - cs[i0 + 1] + after);
      o[j] = pack2(k0, k1);
    }
    const int chunk = hf * 4 + ch;
    *(u32x4*)(kts + d * 128 + ((chunk ^ ((d >> 1) & 7)) << 4)) = u32x4{o[0], o[1], o[2], o[3]};
  }
  __syncthreads();
  f32x16 acc[2][2];
  zero_acc<2>(acc);
  mma_tile<2, 2>(acc, vts, wm * 64, kts, wn * 64, lane);
  u16* us = (u16*)(p.ws + OFF_US) + (size_t)item * 16384;
#pragma unroll
  for (int mi = 0; mi < 2; ++mi)
#pragma unroll
    for (int ni = 0; ni < 2; ++ni)
#pragma unroll
      for (int r = 0; r < 16; ++r) {
        const int e = wm * 64 + mi * 32 + rowof(r, lane);
        const int dd = wn * 64 + ni * 32 + (lane & 31);
        us[e * 128 + dd] = f2bf(acc[mi][ni][r]);
      }
}

__device__ __forceinline__ void h2_item(const P& p, int item, int tid) {
  const int g = item * 256 + tid;
  const int bh = g >> 13, e = (g >> 6) & 127, dp = g & 63;
  float s0 = 0.f, s1 = 0.f;
  u32* us = (u32*)(p.ws + OFF_US) + (size_t)bh * 128 * 8192 + e * 64 + dp;
  const float2* gd = (const float2*)(p.ws + OFF_GDEC) + (size_t)bh * 128 * 64 + dp;
#pragma unroll 1
  for (int c0 = 0; c0 < 128; c0 += 16) {
    u32 u[16];
    float2 g2[16];
#pragma unroll
    for (int i = 0; i < 16; ++i) { u[i] = us[(size_t)(c0 + i) * 8192]; g2[i] = gd[(c0 + i) * 64]; }
#pragma unroll
    for (int i = 0; i < 16; ++i) {
      us[(size_t)(c0 + i) * 8192] = pack2(s0, s1);
      s0 = g2[i].x * s0 + bf2f((u16)(u[i] & 0xFFFF));
      s1 = g2[i].y * s1 + bf2f((u16)(u[i] >> 16));
    }
  }
}

__device__ __forceinline__ void h3_item(const P& p, int l, int item, char* smem, int tid) {
  const int lane = tid & 63, w = tid >> 6, h = lane >> 5, lr = lane & 31;
  const int b = item >> 9, hh = (item >> 7) & 3, c = item & 127;
  const int tok0 = b * SEQ + c * 64;
  const int d = tid & 127, hf = tid >> 7;
  char* R0 = smem;
  char* R1 = smem + 16384;
  char* R2 = smem + 32768;
  char* R3 = smem + 49152;
  float* tot = (float*)(smem + 65536);
  const u16* usb = (const u16*)(p.ws + OFF_US) + (size_t)item * 16384;
  u32x4 vr[4], s0r[4], s1r[4];
  g2r<128>(vr, (const u16*)(p.ws + OFF_HVT) + ((size_t)(b * 512 + hh * 128)) * 8192 + c * 64, 8192, tid);
  g2r<128>(s0r, usb, 128, tid);
  g2r<128>(s1r, usb + 64, 128, tid);
  float lf[32], cs[32], q[32];
  hgrn_load_cumsum(p, tok0, hh, d, hf, lf, cs);
  {
    const u16* qs = (const u16*)(p.ws + OFF_HQ) + (size_t)(tok0 + hf * 32) * 512 + hh * 128 + d;
#pragma unroll
    for (int i = 0; i < 32; ++i) q[i] = bf2f(qs[(size_t)i * 512]);
  }
  if (hf == 0) tot[d] = cs[31];
  r2s<128>(vr, R3, tid);
  r2s<128>(s0r, R2, tid);
  __syncthreads();
  const float t0 = tot[d];
#pragma unroll
  for (int i = 0; i < 32; ++i) {
    const int t = hf * 32 + i;
    const float rel = hf ? cs[i] : cs[i] - t0;
    put_td(R0, t, d, q[i] * __expf(rel));
    put_td(R1, t, d, (1.f - __expf(lf[i])) * __expf(-rel));
  }
  __syncthreads();
  {
    const int sb = w & 1, tb = w >> 1;
    f32x16 a1[1][1];
#pragma unroll
    for (int r = 0; r < 16; ++r) a1[0][0][r] = 0.f;
    if (sb <= tb) {
      mma_tile<1, 1>(a1, R1, sb * 32, R0, tb * 32, lane);
      mma_tile<1, 1>(a1, R1 + 8192, sb * 32, R0 + 8192, tb * 32, lane);
    }
    __syncthreads();
    const int t = tb * 32 + lr;
#pragma unroll
    for (int rg = 0; rg < 4; ++rg) {
      float v[4];
#pragma unroll
      for (int j = 0; j < 4; ++j) {
        const int s = sb * 32 + 8 * rg + 4 * h + j;
        v[j] = (s <= t) ? a1[0][0][rg * 4 + j] : 0.f;
      }
      const int s0 = sb * 32 + 8 * rg + 4 * h;
      *(u32x2*)(R1 + t * 128 + (((s0 >> 3) ^ ((t >> 1) & 7)) << 4) + (s0 & 7) * 2) =
          u32x2{pack2(v[0], v[1]), pack2(v[2], v[3])};
    }
#pragma unroll
    for (int i = 0; i < 32; ++i) {
      const int tt = hf * 32 + i;
      put_td(R0, tt, d, q[i] * __expf(hf ? cs[i] + t0 : cs[i]));
    }
  }
  __syncthreads();
  f32x16 o[1][2];
#pragma unroll
  for (int ni = 0; ni < 2; ++ni)
#pragma unroll
    for (int r = 0; r < 16; ++r) o[0][ni][r] = 0.f;
  mma_tile<1, 2>(o, R2, w * 32, R0, 0, lane);
  mma_tile<1, 2>(o, R3, w * 32, R1, 0, lane);
  __syncthreads();
  r2s<128>(s1r, R2, tid);
  __syncthreads();
  mma_tile<1, 2>(o, R2, w * 32, R0 + 8192, 0, lane);
  float* red = tot;
#pragma unroll
  for (int ni = 0; ni < 2; ++ni) {
    float ss = 0.f;
#pragma unroll
    for (int r = 0; r < 16; ++r) ss += o[0][ni][r] * o[0][ni][r];
    ss += __shfl_xor(ss, 32);
    if (h == 0) red[w * 64 + ni * 32 + lr] = ss;
  }
  __syncthreads();
#pragma unroll
  for (int ni = 0; ni < 2; ++ni) {
    const int t = ni * 32 + lr;
    const float ss = red[t] + red[64 + t] + red[128 + t] + red[192 + t];
    const float rn = rsqrtf(ss * (1.f / 128.f) + EPS);
    const size_t rowo = (size_t)(tok0 + t) * 512 + hh * 128;
#pragma unroll
    for (int rg = 0; rg < 4; ++rg) {
      const int e0 = w * 32 + 8 * rg + 4 * h;
      const u32x2 gg = *(const u32x2*)((const u16*)(p.ws + OFF_HG) + rowo + e0);
      const float4 nw = *(const float4*)(p.hn + l * 128 + e0);
      const float y0 = o[0][ni][rg * 4 + 0] * rn * nw.x * bf2f((u16)(gg.x & 0xFFFF));
      const float y1 = o[0][ni][rg * 4 + 1] * rn * nw.y * bf2f((u16)(gg.x >> 16));
      const float y2 = o[0][ni][rg * 4 + 2] * rn * nw.z * bf2f((u16)(gg.y & 0xFFFF));
      const float y3 = o[0][ni][rg * 4 + 3] * rn * nw.w * bf2f((u16)(gg.y >> 16));
      *(u32x2*)((u16*)(p.ws + OFF_YH) + rowo + e0) = u32x2{pack2(y0, y1), pack2(y2, y3)};
    }
  }
}

__device__ __forceinline__ size_t code_rowoff(int q) {
  const int g = q >> 7, r = q & 127;
  return (size_t)128 * ((size_t)64 * g * (g + 1) + (size_t)r * (g + 1));
}
__device__ __forceinline__ u32 tocode(float s) {
  u32 u = __float_as_uint(s);
  if ((u << 1) == 0) u = 0;
  u = (u & 0x80000000u) ? ~u : (u | 0x80000000u);
  u >>= 16;
  return u < 1 ? 1 : u;
}
__device__ __forceinline__ void b1_item(const P& p, int item, char* smem, int tid) {
  const int lane = tid & 63, w = tid >> 6, wm = w & 1, wn = w >> 1, lr = lane & 31;
  const int b = item >= 2080;
  int idx = item - b * 2080;
  int g = (int)((sqrtf(8.f * idx + 1.f) - 1.f) * 0.5f);
  while (g * (g + 1) / 2 > idx) --g;
  while ((g + 1) * (g + 2) / 2 <= idx) ++g;
  const int kt = idx - g * (g + 1) / 2;
  const int q0 = b * SEQ + g * 128, k0 = b * SEQ + kt * 128;
  char* ys = smem;
  char* xs = smem + 16384;
  float* wsm = (float*)(smem + 49152);
  const u16* IQ = (const u16*)(p.ws + OFF_IQ) + (size_t)q0 * 256;
  const u16* IK = (const u16*)(p.ws + OFF_IK) + (size_t)k0 * 64;
  u32x4 xr[4], yr[4];
  g2r<128>(yr, IK, 64, tid);
  g2r<128>(xr, IQ, 256, tid);
  if (tid < 128) *(float4*)(wsm + tid * 4) = *(const float4*)(p.ws + OFF_IW + (size_t)(q0 + tid) * 16);
  r2s<128>(yr, ys, tid);
  r2s<128>(xr, xs, tid);
  __syncthreads();
  f32x16 sc[2][2];
  zero_acc<2>(sc);
#pragma unroll 1
  for (int hd = 0; hd < 4; ++hd) {
    if (hd < 3) g2r<128>(xr, IQ + (hd + 1) * 64, 256, tid);
#pragma unroll
    for (int mi = 0; mi < 2; ++mi) {
      f32x16 acc[1][2];
#pragma unroll
      for (int ni = 0; ni < 2; ++ni)
#pragma unroll
        for (int r = 0; r < 16; ++r) acc[0][ni][r] = 0.f;
      mma_tile<1, 2>(acc, xs + (hd & 1) * 16384, wm * 64 + mi * 32, ys, wn * 64, lane);
#pragma unroll
      for (int r = 0; r < 16; ++r) {
        const float wv = wsm[(wm * 64 + mi * 32 + rowof(r, lane)) * 4 + hd];
#pragma unroll
        for (int ni = 0; ni < 2; ++ni) sc[mi][ni][r] += wv * fmaxf(acc[0][ni][r], 0.f);
      }
      __builtin_amdgcn_sched_barrier(0);
    }
    if (hd < 3) r2s<128>(xr, xs + ((hd + 1) & 1) * 16384, tid);
    __syncthreads();
  }
  u16* codes = (u16*)(p.ws + OFF_CODES) + (size_t)b * CODES_PER_BATCH;
  char* st = smem + 16384;
#pragma unroll
  for (int mi = 0; mi < 2; ++mi)
#pragma unroll
    for (int r = 0; r < 16; ++r) {
      const int ql = wm * 64 + mi * 32 + rowof(r, lane);
      const int q = g * 128 + ql;
#pragma unroll
      for (int ni = 0; ni < 2; ++ni) {
        const int kl = wn * 64 + ni * 32 + lr;
        const bool vis = (kt * 128 + kl) <= q;
        const u32 cd = vis ? tocode(sc[mi][ni][r]) : 0u;
        *(u16*)(st + ql * 256 + (2 * (ni * 32 + lr) + wn) * 2) = (u16)cd;
      }
    }
  __syncthreads();
  {
    u16* dst0 = codes + code_rowoff(g * 128) + kt * 128;
    const size_t rstride = (size_t)128 * (g + 1);
#pragma unroll
    for (int i = 0; i < 8; ++i) {
      const int cid = tid + 256 * i;
      const int row = cid >> 4, c = cid & 15;
      __builtin_nontemporal_store(*(const u32x4*)(st + row * 256 + c * 16), (u32x4*)(dst0 + (size_t)row * rstride + c * 8));
    }
  }
}

__device__ __forceinline__ int wave_isum(int c) {
#pragma unroll
  for (int o = 32; o >= 1; o >>= 1) c += __shfl_xor(c, o);
  return c;
}
__device__ __forceinline__ int count_ge(const u32 (&r)[64], int nj, u32 t) {
  const u16 tm1 = (u16)(t - 1);
  const u16x2 tv = {tm1, tm1};
  const u16x2 one = {1, 1};
  u16x2 acc = {0, 0};
#pragma unroll
  for (int jb = 0; jb < 8; ++jb) {
    if (jb * 8 < nj) {
#pragma unroll
      for (int jj = 0; jj < 8; ++jj) {
        u16x2 d = __builtin_elementwise_sub_sat(__builtin_bit_cast(u16x2, r[jb * 8 + jj]), tv);
        d = __builtin_elementwise_min(d, one);
        acc += d;
      }
    }
  }
  return wave_isum((int)acc.x + (int)acc.y);
}
__device__ __forceinline__ int snake_item(int k, int bid, int nb);
__device__ __forceinline__ void b2_load(const P& p, int item, int tid, u32 (&r)[64]) {
  const int lane = tid & 63, w = tid >> 6;
  const int Q = item * 4 + w;
  const int b = Q >> 13, q = Q & 8191;
  const int nj = (q >> 7) + 1;
  const u32* row = (const u32*)((const u16*)(p.ws + OFF_CODES) + (size_t)b * CODES_PER_BATCH + code_rowoff(q));
#pragma unroll
  for (int j = 0; j < 64; ++j) r[j] = (j < nj) ? __builtin_nontemporal_load(row + j * 64 + lane) : 0u;
}
__device__ __forceinline__ void b2_process(const P& p, int item, char* smem, int tid, const u32 (&r)[64]) {
  const int lane = tid & 63, w = tid >> 6;
  const int Q = item * 4 + w;
  const int q = Q & 8191;
  const int nj = (q >> 7) + 1;
  u16x2 m1 = {0, 0}, m2 = {0, 0};
#pragma unroll
  for (int jb = 0; jb < 8; ++jb) {
    if (jb * 8 < nj) {
#pragma unroll
      for (int jj = 0; jj < 8; ++jj) {
        const u16x2 x = __builtin_bit_cast(u16x2, r[jb * 8 + jj]);
        const u16x2 t = __builtin_elementwise_min(m1, x);
        m1 = __builtin_elementwise_max(m1, x);
        m2 = __builtin_elementwise_max(m2, t);
      }
    }
  }
  int L = min((int)m2.x, (int)m2.y), H = max((int)m1.x, (int)m1.y);
#pragma unroll
  for (int o = 32; o >= 1; o >>= 1) { L = min(L, __shfl_xor(L, o)); H = max(H, __shfl_xor(H, o)); }
  u32 T = 0;
  int need = 0;
  u32 lo = L < 1 ? 1u : (u32)L;
  if (lo > 1 || count_ge(r, nj, 1) >= 256) {
    const int R = H - (int)lo + 1;
    if (R <= 2048) {
      u32* hist = (u32*)(smem + w * 8192);
      const int nbl = (R + 63) >> 6;
      for (int i = 0; i < nbl; ++i) hist[i * 64 + lane] = 0u;
#pragma unroll
      for (int jb = 0; jb < 8; ++jb) {
        if (jb * 8 < nj) {
#pragma unroll
          for (int jj = 0; jj < 8; ++jj) {
            const u32 v = r[jb * 8 + jj];
            const u32 c0 = v & 0xFFFFu, c1 = v >> 16;
            if (c0 >= lo) atomicAdd(&hist[c0 - lo], 1u);
            if (c1 >= lo) atomicAdd(&hist[c1 - lo], 1u);
          }
        }
      }
      int sl = 0;
      for (int i = 0; i < nbl; ++i) sl += (int)hist[lane * nbl + i];
      int suf = sl;
#pragma unroll
      for (int d = 1; d <= 32; d <<= 1) {
        const int v = __shfl_down(suf, d);
        suf += (lane + d < 64) ? v : 0;
      }
      const u64 okm = __ballot(suf >= 256);
      const int istar = 63 - __builtin_clzll(okm);
      int cacc = suf - sl, tbin = 0, cgt = 0;
      bool found = false;
      for (int i = nbl - 1; i >= 0; --i) {
        const int hc = (int)hist[lane * nbl + i];
        if (!found && cacc + hc >= 256) { found = true; tbin = lane * nbl + i; cgt = cacc; }
        cacc += hc;
      }
      tbin = __shfl(tbin, istar);
      cgt = __shfl(cgt, istar);
      T = lo + (u32)tbin;
      need = 256 - cgt;
    } else {
      u32 hi = (u32)H + 1u;
      while (hi - lo > 1) {
        const u32 mid = (lo + hi) >> 1;
        if (count_ge(r, nj, mid) >= 256) lo = mid; else hi = mid;
      }
      T = lo;
      const int cgt = (T >= 65535u) ? 0 : count_ge(r, nj, T + 1);
      need = 256 - cgt;
    }
  }
  int mlo[2] = {0, 0}, mhi[2] = {0, 0};
  const u32 thi = (T << 16) | 0xFFFFu;
#pragma unroll
  for (int j = 0; j < 64; ++j) {
    if (j < nj) {
#pragma unroll
      for (int hfw = 0; hfw < 2; ++hfw) {
        const u32 cd = hfw ? (r[j] >> 16) : (r[j] & 0xFFFFu);
        u64 word = hfw ? __ballot(r[j] > thi) : __ballot(cd > T);
        if (T > 0 && need > 0) {
          const bool eq = cd == T;
          const u64 eqm = __ballot(eq);
          if (eqm != 0) {
            const int rank = __builtin_amdgcn_mbcnt_hi((u32)(eqm >> 32), __builtin_amdgcn_mbcnt_lo((u32)eqm, 0));
            word |= __ballot(eq && rank < need);
            need -= __popcll(eqm);
          }
        }
        const int widx = 2 * j + hfw;
        if (lane == (widx & 63)) { mlo[widx >> 6] = (int)(u32)word; mhi[widx >> 6] = (int)(u32)(word >> 32); }
      }
    }
  }
  u32x2* mrow = (u32x2*)(p.ws + OFF_MASK + (size_t)Q * 1024);
#pragma unroll
  for (int k = 0; k < 2; ++k)
    if (lane + 64 * k < 2 * nj) mrow[lane + 64 * k] = u32x2{(u32)mlo[k], (u32)mhi[k]};
}

__device__ __forceinline__ void b2_phase(const P& p, int bid, int nb, char* smem, int tid) {
  const int rounds = (4096 + nb - 1) / nb;
  u32 ra[64], rb[64];
  int ia = snake_item(0, bid, nb);
  if (ia < 4096) b2_load(p, ia, tid, ra);
#pragma unroll 1
  for (int k = 0; k < rounds; k += 2) {
    const int ib = (k + 1 < rounds) ? snake_item(k + 1, bid, nb) : 4096;
    if (ib < 4096) b2_load(p, ib, tid, rb);
    if (ia < 4096) b2_process(p, ia, smem, tid, ra);
    ia = (k + 2 < rounds) ? snake_item(k + 2, bid, nb) : 4096;
    if (ia < 4096) b2_load(p, ia, tid, ra);
    if (ib < 4096) b2_process(p, ib, smem, tid, rb);
  }
}

__device__ __forceinline__ void b3_item(const P& p, int l, int item, char* smem, int tid) {
  const int lane = tid & 63, w = tid >> 6, h = lane >> 5, lr = lane & 31;
  const int g = 63 - (item >> 4), rem = item & 15, b = rem >> 3, head = rem & 7;
  const int q0 = g * 128;
  const int nkt = 2 * g + 2;
  const u16* AK = (const u16*)(p.ws + OFF_AK) + (size_t)b * SEQ * 512 + head * 64;
  const u16* AVT = (const u16*)(p.ws + OFF_AVT) + ((size_t)(b * 512 + head * 64)) * 8192;
  const u64* MK = (const u64*)(p.ws + OFF_MASK) + (size_t)(b * SEQ + q0) * 128;
  bf16x8 qf[4];
  {
    const u16* qrow = (const u16*)(p.ws + OFF_AQ) + (size_t)(b * SEQ + q0 + w * 32 + lr) * 512 + head * 64;
#pragma unroll
    for (int ks = 0; ks < 4; ++ks) qf[ks] = *(const bf16x8*)(qrow + ks * 16 + 8 * h);
  }
  u32x4 kr[2], vr[2];
  u64 mr = 0;
  g2r<64>(kr, AK, 512, tid);
  g2r<64>(vr, AVT, 8192, tid);
  if (tid < 128) mr = MK[(size_t)tid * 128];
  r2s<64>(kr, smem, tid);
  r2s<64>(vr, smem + 8192, tid);
  if (tid < 128) *(u64*)(smem + 16384 + tid * 8) = mr;
  __syncthreads();
  f32x16 oacc[2];
#pragma unroll
  for (int i = 0; i < 2; ++i)
#pragma unroll
    for (int r = 0; r < 16; ++r) oacc[i][r] = 0.f;
  float mrun = -5e29f, lrun = 0.f;
  float mq = fabsf(p.qn[l * 64 + lane]), mk = fabsf(p.kn[l * 64 + lane]);
#pragma unroll
  for (int o = 32; o >= 1; o >>= 1) { mq = fmaxf(mq, __shfl_xor(mq, o)); mk = fmaxf(mk, __shfl_xor(mk, o)); }
  const bool fast = (0.125f * 1.4426950408889634f * 64.f * 1.03f) * mq * mk + 1.f < 60.f;
  for (int kt = 0; kt < nkt; ++kt) {
    const char* buf = smem + (kt & 1) * 17408;
    char* nbuf = smem + ((kt + 1) & 1) * 17408;
    if (kt + 1 < nkt) {
      g2r<64>(kr, AK + (size_t)(kt + 1) * 64 * 512, 512, tid);
      g2r<64>(vr, AVT + (kt + 1) * 64, 8192, tid);
      if (tid < 128) mr = MK[(size_t)tid * 128 + kt + 1];
    }
    const u64 m64 = *(const u64*)(buf + 16384 + (w * 32 + lr) * 8);
    const u64 msh = ~(m64 >> (4 * h));
    const int w0 = (int)(u32)msh, w1 = (int)(u32)(msh >> 32);
    f32x16 s[2];
#pragma unroll
    for (int kb = 0; kb < 2; ++kb) {
#pragma unroll
      for (int r = 0; r < 16; ++r)
        s[kb][r] = __int_as_float(__builtin_amdgcn_sbfe(kb ? w1 : w0, (r & 3) + 8 * (r >> 2), 1) & (int)0xF149F2CAu);
#pragma unroll
      for (int ks = 0; ks < 4; ++ks)
        s[kb] = __builtin_amdgcn_mfma_f32_32x32x16_bf16(lds_frag(buf, kb * 32 + lr, ks * 2 + h), qf[ks], s[kb], 0, 0, 0);
    }
    float psum = 0.f;
    if (fast) {
#pragma unroll
      for (int kb = 0; kb < 2; ++kb)
#pragma unroll
        for (int r = 0; r < 16; ++r) {
          const float pv = __builtin_amdgcn_exp2f(s[kb][r]);
          s[kb][r] = pv;
          psum += pv;
        }
    } else {
      float tmax = s[0][0];
#pragma unroll
      for (int kb = 0; kb < 2; ++kb)
#pragma unroll
        for (int r = 0; r < 16; ++r) tmax = fmaxf(tmax, s[kb][r]);
      tmax = fmaxf(tmax, __shfl_xor(tmax, 32));
      if (__any(tmax > mrun)) {
        const float mnew = fmaxf(mrun, tmax);
        const float alpha = __builtin_amdgcn_exp2f(mrun - mnew);
        mrun = mnew;
        lrun *= alpha;
#pragma unroll
        for (int i = 0; i < 2; ++i)
#pragma unroll
          for (int r = 0; r < 16; ++r) oacc[i][r] *= alpha;
      }
#pragma unroll
      for (int kb = 0; kb < 2; ++kb)
#pragma unroll
        for (int r = 0; r < 16; ++r) {
          const float pv = __builtin_amdgcn_exp2f(s[kb][r] - mrun);
          s[kb][r] = pv;
          psum += pv;
        }
    }
    lrun += psum;
    const char* vt = buf + 8192;
#pragma unroll
    for (int kb = 0; kb < 2; ++kb)
#pragma unroll
      for (int s2 = 0; s2 < 2; ++s2) {
        union { bf16x8 v; u32 u[4]; } pf;
#pragma unroll
        for (int j = 0; j < 4; ++j) pf.u[j] = pack2(s[kb][8 * s2 + 2 * j], s[kb][8 * s2 + 2 * j + 1]);
#pragma unroll
        for (int db = 0; db < 2; ++db) {
          const int drow = db * 32 + lr;
          const int ch = kb * 4 + 2 * s2;
          const int sw = (drow >> 1) & 7;
          union { bf16x8 v; u32x2 u[2]; } vf;
          vf.u[0] = *(const u32x2*)(vt + drow * 128 + ((ch ^ sw) << 4) + 8 * h);
          vf.u[1] = *(const u32x2*)(vt + drow * 128 + (((ch + 1) ^ sw) << 4) + 8 * h);
          oacc[db] = __builtin_amdgcn_mfma_f32_32x32x16_bf16(vf.v, pf.v, oacc[db], 0, 0, 0);
        }
      }
    if (kt + 1 < nkt) {
      r2s<64>(kr, nbuf, tid);
      r2s<64>(vr, nbuf + 8192, tid);
      if (tid < 128) *(u64*)(nbuf + 16384 + tid * 8) = mr;
    }
    __syncthreads();
  }
  lrun += __shfl_xor(lrun, 32);
  const float inv = 1.f / lrun;
  u16* yrow = (u16*)(p.ws + OFF_YA) + (size_t)(b * SEQ + q0 + w * 32 + lr) * 512 + head * 64;
#pragma unroll
  for (int db = 0; db < 2; ++db)
#pragma unroll
    for (int rg = 0; rg < 4; ++rg) {
      const int d0 = db * 32 + 8 * rg + 4 * h;
      *(u32x2*)(yrow + d0) = u32x2{pack2(oacc[db][rg * 4] * inv, oacc[db][rg * 4 + 1] * inv),
                                   pack2(oacc[db][rg * 4 + 2] * inv, oacc[db][rg * 4 + 3] * inv)};
    }
}

__device__ __forceinline__ void d1_item(const P& p, int l, int mt, int nt, char* smem, int tid) {
  const int lane = tid & 63, w = tid >> 6, wm = w & 1, wn = w >> 1, lr = lane & 31;
  const int m0 = mt * 128, n0 = nt * 64;
  float* rs = (float*)(smem + 65536);
  const float* rowss = (const float*)(p.ws + OFF_ROWSS);
  if (tid < 128) rs[tid] = row_rstd(rowss, m0 + tid);
  const u16* XB = (const u16*)(p.ws + OFF_XB) + (size_t)m0 * 1024;
  f32x16 ag[2][2];
  zero_acc<2>(ag);
  gemm_loop<128, 2>(ag, XB, 1024, (const u16*)(p.ws + OFF_WGATE) + (size_t)nt * 128 * 1024, 1024, 16, smem, tid);
#pragma unroll
  for (int mi = 0; mi < 2; ++mi)
#pragma unroll
    for (int r = 0; r < 16; ++r) {
      const float rstd = rs[wm * 64 + mi * 32 + rowof(r, lane)];
      ag[mi][0][r] = sigmoidf_(ag[mi][0][r] * rstd);
      ag[mi][1][r] = sigmoidf_(ag[mi][1][r] * rstd);
    }
  f32x16 res[2][1], ap[2][1];
#pragma unroll
  for (int br = 0; br < 2; ++br) {
    zero_acc<1>(ap);
    const u16* Y = (const u16*)(p.ws + (br ? OFF_YH : OFF_YA)) + (size_t)m0 * 512;
    const u16* WP = (const u16*)(p.ws + (br ? OFF_WPH : OFF_WPA)) + (size_t)n0 * 512;
    gemm_loop<64, 1>(ap, Y, 512, WP, 512, 8, smem, tid);
#pragma unroll
    for (int mi = 0; mi < 2; ++mi)
#pragma unroll
      for (int r = 0; r < 16; ++r) {
        const float v = ag[mi][br][r] * ap[mi][0][r];
        res[mi][0][r] = br ? res[mi][0][r] + v : v;
      }
  }
  u16* M = (u16*)(p.ws + OFF_MERGED);
#pragma unroll
  for (int mi = 0; mi < 2; ++mi)
#pragma unroll
    for (int r = 0; r < 16; ++r) {
      const int tok = m0 + wm * 64 + mi * 32 + rowof(r, lane);
      M[(size_t)tok * 1024 + n0 + wn * 32 + lr] = f2bf(res[mi][0][r]);
    }
}

__device__ __forceinline__ void resid_item(const P& p, const u16* A, int K, const u16* W, float* rowss_next, int mt, int nt, char* smem,
                           int tid) {
  const int lane = tid & 63, w = tid >> 6, wm = w & 1, wn = w >> 1, lr = lane & 31;
  const int m0 = mt * 128, n0 = nt * 128;
  f32x16 acc[2][2];
  zero_acc<2>(acc);
  gemm_loop<128, 2>(acc, A + (size_t)m0 * K, K, W + (size_t)n0 * K, K, K >> 6, smem, tid);
  u16* XB = (u16*)(p.ws + OFF_XB);
  float myss = 0.f;
  int mytok = 0;
#pragma unroll
  for (int mi = 0; mi < 2; ++mi)
#pragma unroll
    for (int r = 0; r < 16; ++r) {
      const int tok = m0 + wm * 64 + mi * 32 + rowof(r, lane);
      float ss = 0.f;
#pragma unroll
      for (int ni = 0; ni < 2; ++ni) {
        const size_t o = (size_t)tok * 1024 + n0 + wn * 64 + ni * 32 + lr;
        const float xn = p.out[o] + acc[mi][ni][r];
        p.out[o] = xn;
        XB[o] = f2bf(xn);
        ss += xn * xn;
      }
#pragma unroll
      for (int of = 16; of >= 1; of >>= 1) ss += __shfl_xor(ss, of);
      if (lr == mi * 16 + r) { myss = ss; mytok = tok; }
      __builtin_amdgcn_sched_barrier(0);
    }
  rowss_next[(size_t)mytok * 16 + nt * 2 + wn] = myss;
}

__device__ __forceinline__ void e_item(const P& p, int l, int mt, int nt, char* smem, int tid) {
  const int lane = tid & 63, w = tid >> 6, wm = w & 1, wn = w >> 1, lr = lane & 31;
  const int m0 = mt * 128;
  float* rs = (float*)(smem + 65536);
  const float* rowss = (const float*)(p.ws + OFF_ROWSS) + (size_t)NTOK * 16;
  if (tid < 128) rs[tid] = row_rstd(rowss, m0 + tid);
  f32x16 acc[2][2];
  zero_acc<2>(acc);
  gemm_loop<128, 2>(acc, (const u16*)(p.ws + OFF_XB) + (size_t)m0 * 1024, 1024,
                    (const u16*)(p.ws + OFF_WFFI) + (size_t)nt * 128 * 1024, 1024, 16, smem, tid);
  u16* ACT = (u16*)(p.ws + OFF_ACT);
#pragma unroll
  for (int mi = 0; mi < 2; ++mi)
#pragma unroll
    for (int r = 0; r < 16; ++r) {
      const int tl = wm * 64 + mi * 32 + rowof(r, lane);
      const float rstd = rs[tl];
      const float gv = acc[mi][0][r] * rstd, uv = acc[mi][1][r] * rstd;
      ACT[(size_t)(m0 + tl) * DFF + nt * 64 + wn * 32 + lr] = f2bf(siluf_(gv) * uv);
    }
}

constexpr int PPL = 10;
#ifndef ONLY_S
#define ONLY_S -1
#endif
#define EN(k) (ONLY_S < 0 || ONLY_S == (k))
template <class F>
__device__ __forceinline__ void for_tiles(int NT, int bid, int nb, F f) {
  if ((nb & 63) == 0) {
    const int vx = bid & 7, j = bid >> 3, JN = nb >> 6;
    const int jm = j & 7, jn = j >> 3;
    const int NG = (NT + JN - 1) / JN;
    const int wl = NT - (NG - 1) * JN;
    const bool fold = (wl * 2 == JN);
    const int NGF = fold ? NG - 1 : NG;
    for (int r = 0; r < 2 * NGF; ++r) {
      const int mh = r / NGF, ng = r - mh * NGF;
      const int mt = vx * 16 + mh * 8 + jm, nt = ng * JN + jn;
      if (nt < NT) f(mt, nt);
    }
    if (fold) f(vx * 16 + (jn / wl) * 8 + jm, (NG - 1) * JN + (jn % wl));
  } else {
    for (int it = bid; it < 128 * NT; it += nb) f(it / NT, it % NT);
  }
}
__device__ __forceinline__ int snake_item(int k, int bid, int nb) {
  return (k & 1) ? (((k + 1) * nb - 1 - bid) ^ 7) : (k * nb + bid);
}

__device__ __forceinline__ void run_phase(const P& p, int ph, char* smem) {
  int tid0 = threadIdx.x;
  asm volatile("" : "+v"(tid0));
  const int nb = gridDim.x;
  int bid = blockIdx.x;
  asm volatile("" : "+s"(bid));
#define LAUNDER int tid = tid0; asm volatile("" : "+v"(tid)); __syncthreads();
  if (ph == 0) {
    if (EN(11)) for (int it = bid; it < 4096 + 4128; it += nb) { LAUNDER
      if (it < 4096) p0_rows(p, it, tid); else conv_item(p, 0, it - 4096, smem, tid);
    }
    return;
  }
  const int l = (ph - 1) / PPL;
  const int smap[PPL] = {0, 4, 5, 6, 2, 3, 7, 8, 9, 10};
  const int s = smap[(ph - 1) % PPL];
  float* rowss = (float*)(p.ws + OFF_ROWSS);
  switch (s) {
    case 0: if (EN(0)) {
      const int par = (bid >> 8) & 1;
      if (l > 0 && par) for (int it = bid; it < 704; it += nb) { LAUNDER conv_item(p, l, 3424 + it, smem, tid); }
      for_tiles(31, bid, nb, [&](int mt, int nt) { LAUNDER phaseA_tile(p, l, mt, nt, smem, tid); });
      if (l > 0 && !par) for (int it = bid; it < 704; it += nb) { LAUNDER conv_item(p, l, 3424 + it, smem, tid); }
    } break;
    case 2: if (EN(2)) for (int it = bid; it < 256; it += nb) { LAUNDER h2_item(p, it, tid); } break;
    case 3: if (EN(3)) for (int it = bid; it < 1024; it += nb) { LAUNDER h3_item(p, l, it, smem, tid); } break;
    case 4: if (EN(4)) for (int it = bid; it < 4160; it += nb) { LAUNDER b1_item(p, it, smem, tid); } break;
    case 5: if (EN(5)) { int tid = tid0; asm volatile("" : "+v"(tid)); b2_phase(p, bid, nb, smem, tid); } break;
    case 6: if (EN(6)) {
      const int par = (bid >> 8) & 1;
      if (par) for (int it = bid; it < 1024; it += nb) { LAUNDER h1_item(p, it, smem, tid); }
      for (int k = 0; k * nb < 1024; ++k) { const int it = snake_item(k, bid, nb); if (it < 1024) { LAUNDER b3_item(p, l, it, smem, tid); } }
      if (!par) for (int it = bid; it < 1024; it += nb) { LAUNDER h1_item(p, it, smem, tid); }
    } break;
    case 7: if (EN(7)) for_tiles(16, bid, nb, [&](int mt, int nt) { LAUNDER d1_item(p, l, mt, nt, smem, tid); }); break;
    case 8:
      if (EN(8)) for_tiles(8, bid, nb, [&](int mt, int nt) { LAUNDER
        resid_item(p, (const u16*)(p.ws + OFF_MERGED), 1024, (const u16*)(p.ws + OFF_WOUT), rowss + (size_t)NTOK * 16, mt, nt, smem, tid); });
      break;
    case 9: if (EN(9)) for_tiles(44, bid, nb, [&](int mt, int nt) { LAUNDER e_item(p, l, mt, nt, smem, tid); }); break;
    case 10: if (EN(10)) {
      const int par = (bid >> 8) & 1;
      if (l < 3 && par) for (int it = bid; it < 3424; it += nb) { LAUNDER conv_item(p, l + 1, it, smem, tid); }
      for_tiles(8, bid, nb, [&](int mt, int nt) { LAUNDER
        resid_item(p, (const u16*)(p.ws + OFF_ACT), DFF, (const u16*)(p.ws + OFF_WFFO), rowss, mt, nt, smem, tid); });
      if (l < 3 && !par) for (int it = bid; it < 3424; it += nb) { LAUNDER conv_item(p, l + 1, it, smem, tid); }
    } break;
  }
#undef LAUNDER
}

constexpr int NPHASE = 1 + PPL * DEPTH;

#ifndef REP_MASK
#define REP_MASK 0
#endif
#define XB_TMO      128
#define XB_XCNT(j)  (256  + 64 * (j))
#define XB_XSUB(j)  (1280 + 64 * (j))
#define XB_XGEN(j)  (2304 + 64 * (j))
#define XB_TOP      3328
#define XB_TOPGEN   3392
#define XCD_BAR_WORDS 3456
#define XB_SPIN_CAP (1u << 18)
#define LAS __attribute__((address_space(3)))

__device__ __forceinline__ unsigned xb_ld(unsigned* p)              { return __hip_atomic_load(p, __ATOMIC_RELAXED, __HIP_MEMORY_SCOPE_AGENT); }
__device__ __forceinline__ unsigned xb_add(unsigned* p, unsigned v) { return __hip_atomic_fetch_add(p, v, __ATOMIC_RELAXED, __HIP_MEMORY_SCOPE_AGENT); }
__device__ __forceinline__ unsigned xb_xcc_id() { return (unsigned)__builtin_amdgcn_s_getreg((3 << 11) | 20) & 0xFu; }
#define XB_SPIN(cond, bar) do { unsigned _sp = 0; while (cond) { __builtin_amdgcn_s_sleep(1); \
    if ((++_sp & 255u) == 0u) { if (xb_ld(&(bar)[XB_TMO])) break; if (_sp > XB_SPIN_CAP) { atomicAdd(&(bar)[XB_TMO], 1u); break; } } } } while (0)

struct XcdBarrier {
    unsigned* bar; unsigned x;
    volatile LAS unsigned* st;
};

__device__ __forceinline__ XcdBarrier xcd_barrier_post(unsigned* bar, volatile LAS unsigned* st) {
    XcdBarrier b; b.bar = bar; b.x = xb_xcc_id(); b.st = st;
    if (threadIdx.x == 0) (void)xb_add(&bar[XB_XCNT(b.x)], 1u);
    return b;
}
__device__ __forceinline__ void xcd_barrier_complete(unsigned* bar, unsigned x, unsigned& nloc, unsigned& nx) {
    const unsigned G = gridDim.x * gridDim.y * gridDim.z;
    unsigned sum, cnt, mine, sp = 0u;
    for (;;) {
        sum = 0u; cnt = 0u; mine = 0u;
#pragma unroll
        for (unsigned j = 0; j < 16; ++j) { const unsigned c = xb_ld(&bar[XB_XCNT(j)]); sum += c; cnt += (c > 0u) ? 1u : 0u; mine = (j == x) ? c : mine; }
        if (sum == G) break;
        __builtin_amdgcn_s_sleep(1);
        if ((++sp & 255u) == 0u) { if (xb_ld(&bar[XB_TMO])) break; if (sp > XB_SPIN_CAP) { atomicAdd(&bar[XB_TMO], 1u); break; } }
    }
    nloc = mine > 0u ? mine : 1u; nx = cnt > 0u ? cnt : 1u;
}

__device__ __forceinline__ void xcd_barrier(const XcdBarrier& b) {
    asm volatile("s_waitcnt vmcnt(0)" ::: "memory");
    __syncthreads();
    if (threadIdx.x == 0) {
        unsigned* bar = b.bar;
        __builtin_amdgcn_s_waitcnt(0);
        unsigned nloc = b.st[0], nx = b.st[1];
        if (nloc == 0u) { xcd_barrier_complete(bar, b.x, nloc, nx); b.st[0] = nloc; b.st[1] = nx; }
        const unsigned old = xb_add(&bar[XB_XSUB(b.x)], 1u);
        const unsigned gen = old / nloc;
        if (old + 1u == (gen + 1u) * nloc) {
            __builtin_amdgcn_fence(__ATOMIC_RELEASE, "agent");
            asm volatile("s_waitcnt vmcnt(0)" ::: "memory");
            const unsigned og = xb_add(&bar[XB_TOP], 1u);
            const unsigned tg = og / nx;
            if (og + 1u == (tg + 1u) * nx) xb_add(&bar[XB_TOPGEN], 1u);
            else XB_SPIN(xb_ld(&bar[XB_TOPGEN]) == tg, bar);
            __builtin_amdgcn_fence(__ATOMIC_ACQUIRE, "agent");
            xb_add(&bar[XB_XGEN(b.x)], 1u);
            asm volatile("s_waitcnt vmcnt(0)" ::: "memory");
        } else {
            XB_SPIN(xb_ld(&bar[XB_XGEN(b.x)]) == gen, bar);
            __builtin_amdgcn_fence(__ATOMIC_ACQUIRE, "agent");
            asm volatile("s_waitcnt vmcnt(0)" ::: "memory");
        }
    }
    __syncthreads();
}


template <bool COOP>
__global__ void __launch_bounds__(256, 2) mega(P p, int ph0, int ph1) {
  __shared__ __attribute__((aligned(16))) char smem[66560];
  __shared__ uint4 xb_words;
  if (threadIdx.x == 0) xb_words = make_uint4(0u, 0u, 0u, 0u);
  __syncthreads();
  XcdBarrier xb = xcd_barrier_post((unsigned*)(p.ws + OFF_BAR), (volatile LAS unsigned*)&xb_words);
  for (int ph = ph0; ph < ph1; ++ph) {
    int reps = 1;
    if (REP_MASK != 0 && ph > 0 && ((REP_MASK >> ((ph - 1) % PPL)) & 1)) reps = 2;
    for (int rp = 0; rp < reps; ++rp) {
      run_phase(p, ph, smem);
      if (COOP) {
        if (ph + 1 < ph1 || rp + 1 < reps) {
          if (ph == 0) cg::this_grid().sync();
          else xcd_barrier(xb);
        }
      }
    }
  }
}

extern "C" void kernel_launch(void* const* d_in, const int* in_sizes, int n_in, void* d_out, int out_size, void* d_ws,
                              size_t ws_size, hipStream_t stream) {
  if (ws_size < WS_END) { fprintf(stderr, "workspace too small: %zu\n", ws_size); return; }
  P p{};
  p.x = (const float*)d_in[0]; p.pos = (const int*)d_in[1]; p.w_in = (const float*)d_in[2];
  p.w_pa = (const float*)d_in[3]; p.w_ph = (const float*)d_in[4]; p.w_out = (const float*)d_in[5];
  p.nmix = (const float*)d_in[6]; p.nffn = (const float*)d_in[7]; p.qn = (const float*)d_in[8];
  p.kn = (const float*)d_in[9]; p.hn = (const float*)d_in[10]; p.hlb = (const float*)d_in[11];
  p.w_ffi = (const float*)d_in[12]; p.w_ffo = (const float*)d_in[13];
  p.out = (float*)d_out; p.ws = (char*)d_ws;
#if COOP_MODE
  static int grid_blocks = 0;
  if (!grid_blocks) {
    int dev = 0, cus = 0, per_cu = 0;
    hipGetDevice(&dev);
    hipDeviceGetAttribute(&cus, hipDeviceAttributeMultiprocessorCount, dev);
    hipOccupancyMaxActiveBlocksPerMultiprocessor(&per_cu, mega<true>, 256, 0);
    if (per_cu > 2) per_cu = 2;
    grid_blocks = cus * per_cu;
  }
  int ph0 = 0, ph1 = NPHASE;
  hipMemsetAsync((char*)d_ws + OFF_BAR, 0, 16384, stream);
  void* args[] = {&p, &ph0, &ph1};
  hipError_t e = hipLaunchCooperativeKernel((void*)mega<true>, dim3(grid_blocks), dim3(256), args, 0, stream);
  if (e != hipSuccess) fprintf(stderr, "cooperative launch failed: %s (grid %d)\n", hipGetErrorString(e), grid_blocks);
#else
  for (int ph = 0; ph < NPHASE; ++ph) mega<false><<<dim3(512), dim3(256), 0, stream>>>(p, ph, ph + 1);
#endif
}
```

```cpp
#include <hip/hip_runtime.h>
#include <hip/hip_cooperative_groups.h>
#include <stdint.h>
#include <stdio.h>
namespace cg = cooperative_groups;

#ifndef COOP_MODE
#define COOP_MODE 1
#endif

typedef unsigned short u16;
typedef unsigned int u32;
typedef unsigned long long u64;
typedef __attribute__((ext_vector_type(8))) short bf16x8;
typedef __attribute__((ext_vector_type(16))) float f32x16;
typedef __attribute__((ext_vector_type(4))) u32 u32x4;
typedef __attribute__((ext_vector_type(2))) u32 u32x2;
typedef __attribute__((ext_vector_type(2))) unsigned short u16x2;

constexpr int NTOK = 16384, SEQ = 8192, DEPTH = 4;
constexpr int DFF = 2816;
constexpr float EPS = 1e-6f;
constexpr size_t MiB = (size_t)1 << 20;
constexpr size_t OFF_WIN = 0, OFF_WGATE = 8 * MiB, OFF_WPA = 12 * MiB, OFF_WPH = 13 * MiB, OFF_WOUT = 14 * MiB,
                 OFF_WFFI = 16 * MiB, OFF_WFFO = 27 * MiB, OFF_AQ = 33 * MiB, OFF_AK = 49 * MiB, OFF_AVT = 65 * MiB,
                 OFF_IQ = 81 * MiB, OFF_IK = 89 * MiB, OFF_IW = 91 * MiB, OFF_HQ = 92 * MiB, OFF_HVT = 108 * MiB,
                 OFF_HG = 124 * MiB, OFF_LOGF = 140 * MiB, OFF_XB = 172 * MiB, OFF_YH = 204 * MiB, OFF_MASK = 220 * MiB,
                 OFF_ROWSS = 236 * MiB, OFF_CODES = 238 * MiB, OFF_YA = OFF_CODES, OFF_US = OFF_CODES,
                 OFF_GDEC = OFF_CODES + 32 * MiB, OFF_MERGED = OFF_AQ, OFF_ACT = OFF_AQ, OFF_BAR = 32 * MiB + 768 * 1024, WS_END = 368 * MiB;
constexpr size_t CODES_PER_BATCH = (size_t)16384 * 2080;

struct P {
  const float* x; const int* pos; const float* w_in; const float* w_pa; const float* w_ph; const float* w_out;
  const float* nmix; const float* nffn; const float* qn; const float* kn; const float* hn; const float* hlb;
  const float* w_ffi; const float* w_ffo; float* out; char* ws;
};

__device__ __forceinline__ u16 f2bf(float f) {
  u32 u = __float_as_uint(f);
  u += 0x7FFFu + ((u >> 16) & 1u);
  return (u16)(u >> 16);
}
__device__ __forceinline__ float bf2f(u16 v) { return __uint_as_float(((u32)v) << 16); }
__device__ __forceinline__ u32 pack2(float a, float b) { u32 r; asm("v_cvt_pk_bf16_f32 %0, %1, %2" : "=v"(r) : "v"(a), "v"(b)); return r; }
__device__ __forceinline__ float wave_sum(float v) {
#pragma unroll
  for (int o = 32; o >= 1; o >>= 1) v += __shfl_xor(v, o);
  return v;
}
__device__ __forceinline__ float sigmoidf_(float x) { return 1.f / (1.f + __expf(-x)); }
__device__ __forceinline__ float siluf_(float x) { return x / (1.f + __expf(-x)); }

template <int ROWS>
__device__ __forceinline__ void g2r(u32x4 (&r)[ROWS / 32], const u16* g, size_t ld, int tid) {
  const int c = tid & 7, row = tid >> 3;
#pragma unroll
  for (int i = 0; i < ROWS / 32; ++i) r[i] = *(const u32x4*)(g + (size_t)(row + 32 * i) * ld + c * 8);
}
template <int ROWS>
__device__ __forceinline__ void r2s(const u32x4 (&r)[ROWS / 32], char* s, int tid) {
  const int c = tid & 7, row = tid >> 3;
#pragma unroll
  for (int i = 0; i < ROWS / 32; ++i) {
    const int rr = row + 32 * i;
    *(u32x4*)(s + rr * 128 + ((c ^ ((rr >> 1) & 7)) << 4)) = r[i];
  }
}
__device__ __forceinline__ bf16x8 lds_frag(const char* s, int row, int kc) {
  return *(const bf16x8*)(s + row * 128 + ((kc ^ ((row >> 1) & 7)) << 4));
}
__device__ __forceinline__ int rowof(int reg, int lane) { return (reg & 3) + 8 * (reg >> 2) + 4 * (lane >> 5); }

template <int MI, int NI, bool ZINIT = false>
__device__ __forceinline__ void mma_tile(f32x16 (&acc)[MI][NI], const char* xs, int xrow0, const char* ys, int yrow0,
                                         int lane) {
  const int r = lane & 31, h = lane >> 5;
  bf16x8 a[2][MI], b[2][NI];
#pragma unroll
  for (int mi = 0; mi < MI; ++mi) a[0][mi] = lds_frag(xs, xrow0 + mi * 32 + r, h);
#pragma unroll
  for (int ni = 0; ni < NI; ++ni) b[0][ni] = lds_frag(ys, yrow0 + ni * 32 + r, h);
#pragma unroll
  for (int ks = 0; ks < 4; ++ks) {
    const int c = ks & 1, n = c ^ 1;
    if (ks < 3) {
#pragma unroll
      for (int mi = 0; mi < MI; ++mi) a[n][mi] = lds_frag(xs, xrow0 + mi * 32 + r, (ks + 1) * 2 + h);
#pragma unroll
      for (int ni = 0; ni < NI; ++ni) b[n][ni] = lds_frag(ys, yrow0 + ni * 32 + r, (ks + 1) * 2 + h);
    }
    __builtin_amdgcn_sched_barrier(0);
#pragma unroll
    for (int mi = 0; mi < MI; ++mi)
#pragma unroll
      for (int ni = 0; ni < NI; ++ni)
      {
        if (ZINIT && ks == 0) {
          const f32x16 z = {0.f, 0.f, 0.f, 0.f, 0.f, 0.f, 0.f, 0.f, 0.f, 0.f, 0.f, 0.f, 0.f, 0.f, 0.f, 0.f};
          acc[mi][ni] = __builtin_amdgcn_mfma_f32_32x32x16_bf16(a[c][mi], b[c][ni], z, 0, 0, 0);
        } else {
          acc[mi][ni] = __builtin_amdgcn_mfma_f32_32x32x16_bf16(a[c][mi], b[c][ni], acc[mi][ni], 0, 0, 0);
        }
      }
    __builtin_amdgcn_sched_barrier(0);
  }
}

template <int YR, int NI>
__device__ __forceinline__ void gemm_loop_shallow(f32x16 (&acc)[2][NI], const u16* X, size_t ldx, const u16* Y, size_t ldy,
                                          int KT, char* smem, int tid) {
  const int lane = tid & 63, w = tid >> 6, wm = w & 1, wn = w >> 1;
  char* xs = smem;
  char* ys = smem + 32768;
  u32x4 xr[4], yr[YR / 32];
  g2r<128>(xr, X, ldx, tid);
  g2r<YR>(yr, Y, ldy, tid);
  r2s<128>(xr, xs, tid);
  r2s<YR>(yr, ys, tid);
  __syncthreads();
#pragma unroll 1
  for (int kt = 0; kt < KT; ++kt) {
    const int cur = kt & 1;
    if (kt + 1 < KT) {
      g2r<128>(xr, X + (size_t)(kt + 1) * 64, ldx, tid);
      g2r<YR>(yr, Y + (size_t)(kt + 1) * 64, ldy, tid);
    }
    mma_tile<2, NI>(acc, xs + cur * 16384, wm * 64, ys + cur * (YR * 128), wn * 32 * NI, lane);
    if (kt + 1 < KT) {
      r2s<128>(xr, xs + (cur ^ 1) * 16384, tid);
      r2s<YR>(yr, ys + (cur ^ 1) * (YR * 128), tid);
    }
    __syncthreads();
  }
}
template <int YR, int NI>
__device__ __forceinline__ void gemm_loop_deep(f32x16 (&acc)[2][NI], const u16* X, size_t ldx, const u16* Y, size_t ldy,
                                          int KT, char* smem, int tid) {
  const int lane = tid & 63, w = tid >> 6, wm = w & 1, wn = w >> 1;
  char* xs = smem;
  char* ys = smem + 32768;
  u32x4 xa[4], ya[YR / 32], xb[4], yb[YR / 32];
  g2r<128>(xa, X, ldx, tid);
  g2r<YR>(ya, Y, ldy, tid);
  g2r<128>(xb, X + 64, ldx, tid);
  g2r<YR>(yb, Y + 64, ldy, tid);
  r2s<128>(xa, xs, tid);
  r2s<YR>(ya, ys, tid);
  __syncthreads();
#pragma unroll 1
  for (int kt = 0; kt < KT; kt += 2) {
    if (kt + 2 < KT) {
      g2r<128>(xa, X + (size_t)(kt + 2) * 64, ldx, tid);
      g2r<YR>(ya, Y + (size_t)(kt + 2) * 64, ldy, tid);
    }
    mma_tile<2, NI>(acc, xs, wm * 64, ys, wn * 32 * NI, lane);
    r2s<128>(xb, xs + 16384, tid);
    r2s<YR>(yb, ys + YR * 128, tid);
    __syncthreads();
    if (kt + 3 < KT) {
      g2r<128>(xb, X + (size_t)(kt + 3) * 64, ldx, tid);
      g2r<YR>(yb, Y + (size_t)(kt + 3) * 64, ldy, tid);
    }
    mma_tile<2, NI>(acc, xs + 16384, wm * 64, ys + YR * 128, wn * 32 * NI, lane);
    if (kt + 2 < KT) {
      r2s<128>(xa, xs, tid);
      r2s<YR>(ya, ys, tid);
    }
    __syncthreads();
  }
}
template <int YR, int NI>
__device__ __forceinline__ void gemm_loop(f32x16 (&acc)[2][NI], const u16* X, size_t ldx, const u16* Y, size_t ldy,
                                          int KT, char* smem, int tid) {
  if constexpr (YR == 128) gemm_loop_deep<YR, NI>(acc, X, ldx, Y, ldy, KT, smem, tid);
  else gemm_loop_shallow<YR, NI>(acc, X, ldx, Y, ldy, KT, smem, tid);
}
template <int NI>
__device__ __forceinline__ void zero_acc(f32x16 (&acc)[2][NI]) {
#pragma unroll
  for (int mi = 0; mi < 2; ++mi)
#pragma unroll
    for (int ni = 0; ni < NI; ++ni)
#pragma unroll
      for (int r = 0; r < 16; ++r) acc[mi][ni][r] = 0.f;
}

__device__ __forceinline__ int conv_map(int mode, int n) {
  if (mode == 0) return n < 1860 ? n : (n < 1920 ? -1 : n - 60);
  if (mode == 1) {
    const int tile = n >> 7, r = n & 127, sub = r >> 5;
    return 3908 + (sub & 1) * 1024 + tile * 64 + (sub >> 1) * 32 + (r & 31);
  }
  if (mode == 3) {
    const int tile = n >> 7, r = n & 127, sub = r >> 5;
    const int j = tile * 64 + (sub >> 1) * 32 + (r & 31);
    return (sub & 1) ? DFF + j : j;
  }
  return n;
}
__device__ __forceinline__ void conv_tile(const float* src, int ld, int K, int mode, const float* scale, u16* dst, int tile, float* lds,
                          int tid) {
  const int ktiles = K >> 6;
  const int ntile = tile / ktiles, ktile = tile - ntile * ktiles;
  const int n0 = ntile * 64, k0 = ktile * 64;
  const int nl = tid & 63, kg = tid >> 6;
  const int col = conv_map(mode, n0 + nl);
#pragma unroll 4
  for (int i = 0; i < 16; ++i) {
    const int k = i * 4 + kg;
    float v = 0.f;
    if (col >= 0) v = src[(size_t)(k0 + k) * ld + col];
    if (scale) v *= scale[k0 + k];
    lds[k * 65 + nl] = v;
  }
  __syncthreads();
  const int nr = tid >> 2, part = tid & 3;
  u32 o[8];
#pragma unroll
  for (int i = 0; i < 8; ++i)
    o[i] = pack2(lds[(part * 16 + 2 * i) * 65 + nr], lds[(part * 16 + 2 * i + 1) * 65 + nr]);
  u32x4* d = (u32x4*)(dst + (size_t)(n0 + nr) * K + k0 + part * 16);
  d[0] = u32x4{o[0], o[1], o[2], o[3]};
  d[1] = u32x4{o[4], o[5], o[6], o[7]};
}
__device__ __forceinline__ void conv_item(const P& p, int l, int c, char* smem, int tid) {
  const float* src; int ld, K, mode; const float* scale = nullptr; u16* dst;
  if (c < 992) { src = p.w_in + (size_t)l * 1024 * 5956; ld = 5956; K = 1024; mode = 0; scale = p.nmix + l * 1024; dst = (u16*)(p.ws + OFF_WIN); }
  else if (c < 1504) { c -= 992; src = p.w_in + (size_t)l * 1024 * 5956; ld = 5956; K = 1024; mode = 1; scale = p.nmix + l * 1024; dst = (u16*)(p.ws + OFF_WGATE); }
  else if (c < 1632) { c -= 1504; src = p.w_pa + (size_t)l * 512 * 1024; ld = 1024; K = 512; mode = 2; dst = (u16*)(p.ws + OFF_WPA); }
  else if (c < 1760) { c -= 1632; src = p.w_ph + (size_t)l * 512 * 1024; ld = 1024; K = 512; mode = 2; dst = (u16*)(p.ws + OFF_WPH); }
  else if (c < 2016) { c -= 1760; src = p.w_out + (size_t)l * 1024 * 1024; ld = 1024; K = 1024; mode = 2; dst = (u16*)(p.ws + OFF_WOUT); }
  else if (c < 3424) { c -= 2016; src = p.w_ffi + (size_t)l * 1024 * 5632; ld = 5632; K = 1024; mode = 3; scale = p.nffn + l * 1024; dst = (u16*)(p.ws + OFF_WFFI); }
  else { c -= 3424; src = p.w_ffo + (size_t)l * DFF * 1024; ld = 1024; K = DFF; mode = 2; dst = (u16*)(p.ws + OFF_WFFO); }
  conv_tile(src, ld, K, mode, scale, dst, c, (float*)smem, tid);
}

__device__ __forceinline__ void p0_rows(const P& p, int item, int tid) {
  const int lane = tid & 63, w = tid >> 6;
  const int tok = item * 4 + w;
  const float4* xr = (const float4*)(p.x + (size_t)tok * 1024);
  float4* orow = (float4*)(p.out + (size_t)tok * 1024);
  u32x2* xb = (u32x2*)(p.ws + OFF_XB + (size_t)tok * 2048);
  float ss = 0.f;
#pragma unroll
  for (int i = 0; i < 4; ++i) {
    float4 v = xr[lane + 64 * i];
    ss += v.x * v.x + v.y * v.y + v.z * v.z + v.w * v.w;
    orow[lane + 64 * i] = v;
    xb[lane + 64 * i] = u32x2{pack2(v.x, v.y), pack2(v.z, v.w)};
  }
  ss = wave_sum(ss);
  float* rowss = (float*)(p.ws + OFF_ROWSS);
  if (lane < 16) rowss[(size_t)tok * 16 + lane] = lane == 0 ? ss : 0.f;
}


__device__ __forceinline__ float row_rstd(const float* part, int tok) {
  const float4* q = (const float4*)(part + (size_t)tok * 16);
  const float4 a = q[0], b = q[1], c = q[2], d = q[3];
  const float ss = ((a.x + a.y) + (a.z + a.w)) + ((b.x + b.y) + (b.z + b.w)) + ((c.x + c.y) + (c.z + c.w)) + ((d.x + d.y) + (d.z + d.w));
  return rsqrtf(ss * (1.f / 1024.f) + EPS);
}
__device__ __forceinline__ void rope_cs(int pos, int d1, float& c, float& s) {
  const float inv = exp2f(-(float)d1 * (13.287712379549449f / 32.f));
  const float ang = (float)pos * inv;
  double rv = (double)ang * 0.15915494309189535;
  rv -= floor(rv);
  const float r = (float)rv;
  c = __builtin_amdgcn_cosf(r);
  s = __builtin_amdgcn_sinf(r);
}

__device__ __forceinline__ void phaseA_tile(const P& p, int l, int mt, int nt, char* smem, int tid) {
  const int lane = tid & 63, w = tid >> 6, wm = w & 1, wn = w >> 1, h = lane >> 5, lr = lane & 31;
  const int m0 = mt * 128;
  float* rs = (float*)(smem + 65536);
  const float* rowss = (const float*)(p.ws + OFF_ROWSS);
  if (tid < 128) rs[tid] = row_rstd(rowss, m0 + tid);
  const u16* XB = (const u16*)(p.ws + OFF_XB) + (size_t)m0 * 1024;
  const u16* W = (const u16*)(p.ws + OFF_WIN) + (size_t)nt * 128 * 1024;
  const bool fr = (nt < 15) || (nt >= 23 && nt < 27);
  f32x16 acc[2][2];
  zero_acc<2>(acc);
  if (fr) gemm_loop<128, 2>(acc, W, 1024, XB, 1024, 16, smem, tid);
  else gemm_loop<128, 2>(acc, XB, 1024, W, 1024, 16, smem, tid);

  if (fr) {
    if (nt < 8 || (nt >= 12 && nt < 15)) {
      const bool isidx = nt >= 12;
      const int fbase = isidx ? (nt - 12) * 128 + wm * 64 : nt * 128 + wm * 64;
      if (isidx && nt == 14 && wm == 1) {
#pragma unroll
        for (int ni = 0; ni < 2; ++ni) {
          const int tl = wn * 64 + ni * 32 + lr;
          const float rstd = rs[tl] * 0.5f;
          if (h == 0) {
            float4 o = {acc[0][ni][0] * rstd, acc[0][ni][1] * rstd, acc[0][ni][2] * rstd, acc[0][ni][3] * rstd};
            *(float4*)(p.ws + OFF_IW + (size_t)(m0 + tl) * 16) = o;
          }
        }
        return;
      }
      const bool isk = (!isidx) && fbase >= 512;
      const int head = isidx ? (nt == 14 ? 0 : (fbase >> 6)) : ((fbase & 511) >> 6);
      const float* nw = isidx ? nullptr : (isk ? p.kn + l * 64 : p.qn + l * 64);
      u16* dst; int dld;
      float oscale = 1.f;
      if (!isidx) { dst = (u16*)(p.ws + (isk ? OFF_AK : OFF_AQ)); dld = 512; if (!isk) oscale = 0.125f * 1.4426950408889634f; }
      else if (nt < 14) { dst = (u16*)(p.ws + OFF_IQ); dld = 256; oscale = 0.125f; }
      else { dst = (u16*)(p.ws + OFF_IK); dld = 64; }
#pragma unroll
      for (int ni = 0; ni < 2; ++ni) {
        const int tl = wn * 64 + ni * 32 + lr;
        const int tok = m0 + tl;
        const float rstd = rs[tl];
        const int pos = p.pos[tok];
        float rn = rstd;
        if (!isidx) {
          float ss = 0.f;
#pragma unroll
          for (int mi = 0; mi < 2; ++mi)
#pragma unroll
            for (int r = 0; r < 16; ++r) { const float v = acc[mi][ni][r] * rstd; ss += v * v; }
          ss += __shfl_xor(ss, 32);
          rn = rstd * rsqrtf(ss * (1.f / 64.f) + EPS);
        }
        u16* drow = dst + (size_t)tok * dld + head * 64;
#pragma unroll
        for (int rg = 0; rg < 4; ++rg) {
          float o1[4], o2[4];
#pragma unroll
          for (int j = 0; j < 4; ++j) {
            const int r = rg * 4 + j;
            const int d1 = j + 8 * rg + 4 * h;
            float x1 = acc[0][ni][r] * rn, x2 = acc[1][ni][r] * rn;
            if (!isidx) { x1 *= nw[d1]; x2 *= nw[d1 + 32]; }
            float c, s;
            rope_cs(pos, d1, c, s);
            o1[j] = (x1 * c - x2 * s) * oscale;
            o2[j] = (x2 * c + x1 * s) * oscale;
          }
          const int d1b = 8 * rg + 4 * h;
          *(u32x2*)(drow + d1b) = u32x2{pack2(o1[0], o1[1]), pack2(o1[2], o1[3])};
          *(u32x2*)(drow + d1b + 32) = u32x2{pack2(o2[0], o2[1]), pack2(o2[2], o2[3])};
          __builtin_amdgcn_sched_barrier(0);
        }
      }
    } else {
      const bool isav = nt < 12;
      u16* dst = (u16*)(p.ws + (isav ? OFF_AVT : OFF_HVT));
#pragma unroll
      for (int ni = 0; ni < 2; ++ni) {
        const int tl = wn * 64 + ni * 32 + lr;
        const int tok = m0 + tl;
        const float rstd = rs[tl];
        const int b = tok >> 13, t = tok & 8191;
#pragma unroll
        for (int mi = 0; mi < 2; ++mi)
#pragma unroll
          for (int r = 0; r < 16; ++r) {
            const int f = (isav ? (nt - 8) : (nt - 23)) * 128 + wm * 64 + mi * 32 + rowof(r, lane);
            dst[((size_t)(b * 512 + f)) * 8192 + t] = f2bf(acc[mi][ni][r] * rstd);
            if ((r & 3) == 3) __builtin_amdgcn_sched_barrier(0);
          }
      }
    }
  } else {
    const int seg = (nt - 15) >> 2;
    const int fb = ((nt - 15) & 3) * 128 + wn * 64;
#pragma unroll
    for (int ni = 0; ni < 2; ++ni) {
      const int f = fb + ni * 32 + lr;
      float lb = 0.f;
      if (seg == 1) {
        float e[4], mx = -1e30f;
#pragma unroll
        for (int i = 0; i < 4; ++i) { e[i] = p.hlb[i * 512 + f]; mx = fmaxf(mx, e[i]); }
        float tot = 0.f, part = 0.f;
#pragma unroll
        for (int i = 0; i < 4; ++i) { e[i] = __expf(e[i] - mx); tot += e[i]; if (i >= 1 && i <= l) part += e[i]; }
        lb = part / tot;
      }
#pragma unroll
      for (int mi = 0; mi < 2; ++mi)
#pragma unroll
        for (int r = 0; r < 16; ++r) {
          const int tl = wm * 64 + mi * 32 + rowof(r, lane);
          const float v = acc[mi][ni][r] * rs[tl];
          const size_t o = (size_t)(m0 + tl) * 512 + f;
          if (seg == 0) ((u16*)(p.ws + OFF_HQ))[o] = f2bf(siluf_(v));
          else if (seg == 3) ((u16*)(p.ws + OFF_HG))[o] = f2bf(siluf_(v));
          else {
            const float sg = 1.f / (1.f + __expf(-v));
            ((float*)(p.ws + OFF_LOGF))[o] = logf(lb + (1.f - lb) * sg);
          }
          if ((r & 3) == 3) __builtin_amdgcn_sched_barrier(0);
        }
    }
  }
}

__device__ __forceinline__ void hgrn_load_cumsum(const P& p, int tok0, int hh, int d, int hf, float (&lf)[32],
                                                 float (&cs)[32]) {
  const float* src = (const float*)(p.ws + OFF_LOGF) + (size_t)(tok0 + hf * 32) * 512 + hh * 128 + d;
#pragma unroll
  for (int i = 0; i < 32; ++i) lf[i] = src[(size_t)i * 512];
  float run = 0.f;
#pragma unroll
  for (int i = 0; i < 32; ++i) { run += lf[i]; cs[i] = run; }
}
__device__ __forceinline__ void put_td(char* base, int t, int d, float v) {
  const int kt = d >> 6, dd = d & 63;
  *(u16*)(base + kt * 8192 + t * 128 + (((dd >> 3) ^ ((t >> 1) & 7)) << 4) + (dd & 7) * 2) = f2bf(v);
}

__device__ __forceinline__ void h1_item(const P& p, int item, char* smem, int tid) {
  const int lane = tid & 63, w = tid >> 6, wm = w & 1, wn = w >> 1;
  const int b = item >> 9, hh = (item >> 7) & 3, c = item & 127;
  const int tok0 = b * SEQ + c * 64;
  const int d = tid & 127, hf = tid >> 7;
  char* vts = smem;
  char* kts = smem + 16384;
  float* tot = (float*)(smem + 65536);
  u32x4 vr[4];
  g2r<128>(vr, (const u16*)(p.ws + OFF_HVT) + ((size_t)(b * 512 + hh * 128)) * 8192 + c * 64, 8192, tid);
  float lf[32], cs[32];
  hgrn_load_cumsum(p, tok0, hh, d, hf, lf, cs);
  tot[hf * 128 + d] = cs[31];
  r2s<128>(vr, vts, tid);
  __syncthreads();
  const float after = hf ? 0.f : tot[128 + d];
  if (hf) ((float*)(p.ws + OFF_GDEC))[(size_t)item * 128 + d] = __expf(cs[31] + tot[d]);
#pragma unroll
  for (int ch = 0; ch < 4; ++ch) {
    u32 o[4];
#pragma unroll
    for (int j = 0; j < 4; ++j) {
      const int i0 = ch * 8 + 2 * j;
      const float k0 = (1.f - __expf(lf[i0])) * __expf(cs[31] - cs[i0] + after);
      const float k1 = (1.f - __expf(lf[i0 + 1])) * __expf(cs[31] - cs[i0 + 1] + after);
      o[j] = pack2(k0, k1);
    }
    const int chunk = hf * 4 + ch;
    *(u32x4*)(kts + d * 128 + ((chunk ^ ((d >> 1) & 7)) << 4)) = u32x4{o[0], o[1], o[2], o[3]};
  }
  __syncthreads();
  f32x16 acc[2][2];
  zero_acc<2>(acc);
  mma_tile<2, 2>(acc, vts, wm * 64, kts, wn * 64, lane);
  u16* us = (u16*)(p.ws + OFF_US) + (size_t)item * 16384;
#pragma unroll
  for (int mi = 0; mi < 2; ++mi)
#pragma unroll
    for (int ni = 0; ni < 2; ++ni)
#pragma unroll
      for (int r = 0; r < 16; ++r) {
        const int e = wm * 64 + mi * 32 + rowof(r, lane);
        const int dd = wn * 64 + ni * 32 + (lane & 31);
        us[e * 128 + dd] = f2bf(acc[mi][ni][r]);
      }
}

__device__ __forceinline__ void h2_item(const P& p, int item, int tid) {
  const int g = item * 256 + tid;
  const int bh = g >> 13, e = (g >> 6) & 127, dp = g & 63;
  float s0 = 0.f, s1 = 0.f;
  u32* us = (u32*)(p.ws + OFF_US) + (size_t)bh * 128 * 8192 + e * 64 + dp;
  const float2* gd = (const float2*)(p.ws + OFF_GDEC) + (size_t)bh * 128 * 64 + dp;
#pragma unroll 1
  for (int c0 = 0; c0 < 128; c0 += 16) {
    u32 u[16];
    float2 g2[16];
#pragma unroll
    for (int i = 0; i < 16; ++i) { u[i] = us[(size_t)(c0 + i) * 8192]; g2[i] = gd[(c0 + i) * 64]; }
#pragma unroll
    for (int i = 0; i < 16; ++i) {
      us[(size_t)(c0 + i) * 8192] = pack2(s0, s1);
      s0 = g2[i].x * s0 + bf2f((u16)(u[i] & 0xFFFF));
      s1 = g2[i].y * s1 + bf2f((u16)(u[i] >> 16));
    }
  }
}

__device__ __forceinline__ void h3_item(const P& p, int l, int item, char* smem, int tid) {
  const int lane = tid & 63, w = tid >> 6, h = lane >> 5, lr = lane & 31;
  const int b = item >> 9, hh = (item >> 7) & 3, c = item & 127;
  const int tok0 = b * SEQ + c * 64;
  const int d = tid & 127, hf = tid >> 7;
  char* R0 = smem;
  char* R1 = smem + 16384;
  char* R2 = smem + 32768;
  char* R3 = smem + 49152;
  float* tot = (float*)(smem + 65536);
  const u16* usb = (const u16*)(p.ws + OFF_US) + (size_t)item * 16384;
  u32x4 vr[4], s0r[4], s1r[4];
  g2r<128>(vr, (const u16*)(p.ws + OFF_HVT) + ((size_t)(b * 512 + hh * 128)) * 8192 + c * 64, 8192, tid);
  g2r<128>(s0r, usb, 128, tid);
  g2r<128>(s1r, usb + 64, 128, tid);
  float lf[32], cs[32], q[32];
  hgrn_load_cumsum(p, tok0, hh, d, hf, lf, cs);
  {
    const u16* qs = (const u16*)(p.ws + OFF_HQ) + (size_t)(tok0 + hf * 32) * 512 + hh * 128 + d;
#pragma unroll
    for (int i = 0; i < 32; ++i) q[i] = bf2f(qs[(size_t)i * 512]);
  }
  if (hf == 0) tot[d] = cs[31];
  r2s<128>(vr, R3, tid);
  r2s<128>(s0r, R2, tid);
  __syncthreads();
  const float t0 = tot[d];
#pragma unroll
  for (int i = 0; i < 32; ++i) {
    const int t = hf * 32 + i;
    const float rel = hf ? cs[i] : cs[i] - t0;
    put_td(R0, t, d, q[i] * __expf(rel));
    put_td(R1, t, d, (1.f - __expf(lf[i])) * __expf(-rel));
  }
  __syncthreads();
  {
    const int sb = w & 1, tb = w >> 1;
    f32x16 a1[1][1];
#pragma unroll
    for (int r = 0; r < 16; ++r) a1[0][0][r] = 0.f;
    if (sb <= tb) {
      mma_tile<1, 1>(a1, R1, sb * 32, R0, tb * 32, lane);
      mma_tile<1, 1>(a1, R1 + 8192, sb * 32, R0 + 8192, tb * 32, lane);
    }
    __syncthreads();
    const int t = tb * 32 + lr;
#pragma unroll
    for (int rg = 0; rg < 4; ++rg) {
      float v[4];
#pragma unroll
      for (int j = 0; j < 4; ++j) {
        const int s = sb * 32 + 8 * rg + 4 * h + j;
        v[j] = (s <= t) ? a1[0][0][rg * 4 + j] : 0.f;
      }
      const int s0 = sb * 32 + 8 * rg + 4 * h;
      *(u32x2*)(R1 + t * 128 + (((s0 >> 3) ^ ((t >> 1) & 7)) << 4) + (s0 & 7) * 2) =
          u32x2{pack2(v[0], v[1]), pack2(v[2], v[3])};
    }
#pragma unroll
    for (int i = 0; i < 32; ++i) {
      const int tt = hf * 32 + i;
      put_td(R0, tt, d, q[i] * __expf(hf ? cs[i] + t0 : cs[i]));
    }
  }
  __syncthreads();
  f32x16 o[1][2];
#pragma unroll
  for (int ni = 0; ni < 2; ++ni)
#pragma unroll
    for (int r = 0; r < 16; ++r) o[0][ni][r] = 0.f;
  mma_tile<1, 2>(o, R2, w * 32, R0, 0, lane);
  mma_tile<1, 2>(o, R3, w * 32, R1, 0, lane);
  __syncthreads();
  r2s<128>(s1r, R2, tid);
  __syncthreads();
  mma_tile<1, 2>(o, R2, w * 32, R0 + 8192, 0, lane);
  float* red = tot;
#pragma unroll
  for (int ni = 0; ni < 2; ++ni) {
    float ss = 0.f;
#pragma unroll
    for (int r = 0; r < 16; ++r) ss += o[0][ni][r] * o[0][ni][r];
    ss += __shfl_xor(ss, 32);
    if (h == 0) red[w * 64 + ni * 32 + lr] = ss;
  }
  __syncthreads();
#pragma unroll
  for (int ni = 0; ni < 2; ++ni) {
    const int t = ni * 32 + lr;
    const float ss = red[t] + red[64 + t] + red[128 + t] + red[192 + t];
    const float rn = rsqrtf(ss * (1.f / 128.f) + EPS);
    const size_t rowo = (size_t)(tok0 + t) * 512 + hh * 128;
#pragma unroll
    for (int rg = 0; rg < 4; ++rg) {
      const int e0 = w * 32 + 8 * rg + 4 * h;
      const u32x2 gg = *(const u32x2*)((const u16*)(p.ws + OFF_HG) + rowo + e0);
      const float4 nw = *(const float4*)(p.hn + l * 128 + e0);
      const float y0 = o[0][ni][rg * 4 + 0] * rn * nw.x * bf2f((u16)(gg.x & 0xFFFF));
      const float y1 = o[0][ni][rg * 4 + 1] * rn * nw.y * bf2f((u16)(gg.x >> 16));
      const float y2 = o[0][ni][rg * 4 + 2] * rn * nw.z * bf2f((u16)(gg.y & 0xFFFF));
      const float y3 = o[0][ni][rg * 4 + 3] * rn * nw.w * bf2f((u16)(gg.y >> 16));
      *(u32x2*)((u16*)(p.ws + OFF_YH) + rowo + e0) = u32x2{pack2(y0, y1), pack2(y2, y3)};
    }
  }
}

__device__ __forceinline__ size_t code_rowoff(int q) {
  const int g = q >> 7, r = q & 127;
  return (size_t)128 * ((size_t)64 * g * (g + 1) + (size_t)r * (g + 1));
}
__device__ __forceinline__ u32 tocode(float s) {
  u32 u = __float_as_uint(s);
  if ((u << 1) == 0) u = 0;
  u = (u & 0x80000000u) ? ~u : (u | 0x80000000u);
  u >>= 16;
  return u < 1 ? 1 : u;
}
__device__ __forceinline__ void b1_item(const P& p, int item, char* smem, int tid) {
  const int lane = tid & 63, w = tid >> 6, wm = w & 1, wn = w >> 1, lr = lane & 31;
  const int b = item >= 2080;
  int idx = item - b * 2080;
  int g = (int)((sqrtf(8.f * idx + 1.f) - 1.f) * 0.5f);
  while (g * (g + 1) / 2 > idx) --g;
  while ((g + 1) * (g + 2) / 2 <= idx) ++g;
  const int kt = idx - g * (g + 1) / 2;
  const int q0 = b * SEQ + g * 128, k0 = b * SEQ + kt * 128;
  char* ys = smem;
  char* xs = smem + 16384;
  float* wsm = (float*)(smem + 49152);
  const u16* IQ = (const u16*)(p.ws + OFF_IQ) + (size_t)q0 * 256;
  const u16* IK = (const u16*)(p.ws + OFF_IK) + (size_t)k0 * 64;
  u32x4 xr[4], yr[4];
  g2r<128>(yr, IK, 64, tid);
  g2r<128>(xr, IQ, 256, tid);
  if (tid < 128) *(float4*)(wsm + tid * 4) = *(const float4*)(p.ws + OFF_IW + (size_t)(q0 + tid) * 16);
  r2s<128>(yr, ys, tid);
  r2s<128>(xr, xs, tid);
  __syncthreads();
  f32x16 sc[2][2];
  zero_acc<2>(sc);
#pragma unroll 1
  for (int hd = 0; hd < 4; ++hd) {
    if (hd < 3) g2r<128>(xr, IQ + (hd + 1) * 64, 256, tid);
#pragma unroll
    for (int mi = 0; mi < 2; ++mi) {
      f32x16 acc[1][2];
      mma_tile<1, 2, true>(acc, xs + (hd & 1) * 16384, wm * 64 + mi * 32, ys, wn * 64, lane);
#pragma unroll
      for (int r = 0; r < 16; ++r) {
        const float wv = wsm[(wm * 64 + mi * 32 + rowof(r, lane)) * 4 + hd];
#pragma unroll
        for (int ni = 0; ni < 2; ++ni) sc[mi][ni][r] += wv * fmaxf(acc[0][ni][r], 0.f);
      }
      __builtin_amdgcn_sched_barrier(0);
    }
    if (hd < 3) r2s<128>(xr, xs + ((hd + 1) & 1) * 16384, tid);
    __syncthreads();
  }
  u16* codes = (u16*)(p.ws + OFF_CODES) + (size_t)b * CODES_PER_BATCH;
  char* st = smem + 16384;
#pragma unroll
  for (int mi = 0; mi < 2; ++mi)
#pragma unroll
    for (int r = 0; r < 16; ++r) {
      const int ql = wm * 64 + mi * 32 + rowof(r, lane);
      const int q = g * 128 + ql;
#pragma unroll
      for (int ni = 0; ni < 2; ++ni) {
        const int kl = wn * 64 + ni * 32 + lr;
        const bool vis = (kt * 128 + kl) <= q;
        const u32 cd = vis ? tocode(sc[mi][ni][r]) : 0u;
        *(u16*)(st + ql * 256 + (2 * (ni * 32 + lr) + wn) * 2) = (u16)cd;
      }
    }
  __syncthreads();
  {
    u16* dst0 = codes + code_rowoff(g * 128) + kt * 128;
    const size_t rstride = (size_t)128 * (g + 1);
#pragma unroll
    for (int i = 0; i < 8; ++i) {
      const int cid = tid + 256 * i;
      const int row = cid >> 4, c = cid & 15;
      __builtin_nontemporal_store(*(const u32x4*)(st + row * 256 + c * 16), (u32x4*)(dst0 + (size_t)row * rstride + c * 8));
    }
  }
}

__device__ __forceinline__ int wave_isum(int c) {
#pragma unroll
  for (int o = 32; o >= 1; o >>= 1) c += __shfl_xor(c, o);
  return c;
}
__device__ __forceinline__ int count_ge(const u32 (&r)[64], int nj, u32 t) {
  const u16 tm1 = (u16)(t - 1);
  const u16x2 tv = {tm1, tm1};
  const u16x2 one = {1, 1};
  u16x2 acc = {0, 0};
#pragma unroll
  for (int jb = 0; jb < 8; ++jb) {
    if (jb * 8 < nj) {
#pragma unroll
      for (int jj = 0; jj < 8; ++jj) {
        u16x2 d = __builtin_elementwise_sub_sat(__builtin_bit_cast(u16x2, r[jb * 8 + jj]), tv);
        d = __builtin_elementwise_min(d, one);
        acc += d;
      }
    }
  }
  return wave_isum((int)acc.x + (int)acc.y);
}
__device__ __forceinline__ int snake_item(int k, int bid, int nb);
__device__ __forceinline__ void b2_load(const P& p, int item, int tid, u32 (&r)[64]) {
  const int lane = tid & 63, w = tid >> 6;
  const int Q = item * 4 + w;
  const int b = Q >> 13, q = Q & 8191;
  const int nj = (q >> 7) + 1;
  const u32* row = (const u32*)((const u16*)(p.ws + OFF_CODES) + (size_t)b * CODES_PER_BATCH + code_rowoff(q));
#pragma unroll
  for (int j = 0; j < 64; ++j) r[j] = (j < nj) ? __builtin_nontemporal_load(row + j * 64 + lane) : 0u;
}
__device__ __forceinline__ void b2_process(const P& p, int item, char* smem, int tid, const u32 (&r)[64]) {
  const int lane = tid & 63, w = tid >> 6;
  const int Q = item * 4 + w;
  const int q = Q & 8191;
  const int nj = (q >> 7) + 1;
  u16x2 m1 = {0, 0}, m2 = {0, 0};
#pragma unroll
  for (int jb = 0; jb < 8; ++jb) {
    if (jb * 8 < nj) {
#pragma unroll
      for (int jj = 0; jj < 8; ++jj) {
        const u16x2 x = __builtin_bit_cast(u16x2, r[jb * 8 + jj]);
        const u16x2 t = __builtin_elementwise_min(m1, x);
        m1 = __builtin_elementwise_max(m1, x);
        m2 = __builtin_elementwise_max(m2, t);
      }
    }
  }
  int L = min((int)m2.x, (int)m2.y), H = max((int)m1.x, (int)m1.y);
#pragma unroll
  for (int o = 32; o >= 1; o >>= 1) { L = min(L, __shfl_xor(L, o)); H = max(H, __shfl_xor(H, o)); }
  u32 T = 0;
  int need = 0;
  u32 lo = L < 1 ? 1u : (u32)L;
  if (lo > 1 || count_ge(r, nj, 1) >= 256) {
    const int R = H - (int)lo + 1;
    if (R <= 2048) {
      u32* hist = (u32*)(smem + w * 8192);
      const int nbl = (R + 63) >> 6;
      for (int i = 0; i < nbl; ++i) hist[i * 64 + lane] = 0u;
#pragma unroll
      for (int jb = 0; jb < 8; ++jb) {
        if (jb * 8 < nj) {
#pragma unroll
          for (int jj = 0; jj < 8; ++jj) {
            const u32 v = r[jb * 8 + jj];
            const u32 c0 = v & 0xFFFFu, c1 = v >> 16;
            if (c0 >= lo) atomicAdd(&hist[c0 - lo], 1u);
            if (c1 >= lo) atomicAdd(&hist[c1 - lo], 1u);
          }
        }
      }
      int sl = 0;
      for (int i = 0; i < nbl; ++i) sl += (int)hist[lane * nbl + i];
      int suf = sl;
#pragma unroll
      for (int d = 1; d <= 32; d <<= 1) {
        const int v = __shfl_down(suf, d);
        suf += (lane + d < 64) ? v : 0;
      }
      const u64 okm = __ballot(suf >= 256);
      const int istar = 63 - __builtin_clzll(okm);
      int cacc = suf - sl, tbin = 0, cgt = 0;
      bool found = false;
      for (int i = nbl - 1; i >= 0; --i) {
        const int hc = (int)hist[lane * nbl + i];
        if (!found && cacc + hc >= 256) { found = true; tbin = lane * nbl + i; cgt = cacc; }
        cacc += hc;
      }
      tbin = __shfl(tbin, istar);
      cgt = __shfl(cgt, istar);
      T = lo + (u32)tbin;
      need = 256 - cgt;
    } else {
      u32 hi = (u32)H + 1u;
      while (hi - lo > 1) {
        const u32 mid = (lo + hi) >> 1;
        if (count_ge(r, nj, mid) >= 256) lo = mid; else hi = mid;
      }
      T = lo;
      const int cgt = (T >= 65535u) ? 0 : count_ge(r, nj, T + 1);
      need = 256 - cgt;
    }
  }
  int mlo[2] = {0, 0}, mhi[2] = {0, 0};
  const u32 thi = (T << 16) | 0xFFFFu;
#pragma unroll
  for (int j = 0; j < 64; ++j) {
    if (j < nj) {
#pragma unroll
      for (int hfw = 0; hfw < 2; ++hfw) {
        const u32 cd = hfw ? (r[j] >> 16) : (r[j] & 0xFFFFu);
        u64 word = hfw ? __ballot(r[j] > thi) : __ballot(cd > T);
        if (T > 0 && need > 0) {
          const bool eq = cd == T;
          const u64 eqm = __ballot(eq);
          if (eqm != 0) {
            const int rank = __builtin_amdgcn_mbcnt_hi((u32)(eqm >> 32), __builtin_amdgcn_mbcnt_lo((u32)eqm, 0));
            word |= __ballot(eq && rank < need);
            need -= __popcll(eqm);
          }
        }
        const int widx = 2 * j + hfw;
        if (lane == (widx & 63)) { mlo[widx >> 6] = (int)(u32)word; mhi[widx >> 6] = (int)(u32)(word >> 32); }
      }
    }
  }
  u32x2* mrow = (u32x2*)(p.ws + OFF_MASK + (size_t)Q * 1024);
#pragma unroll
  for (int k = 0; k < 2; ++k)
    if (lane + 64 * k < 2 * nj) mrow[lane + 64 * k] = u32x2{(u32)mlo[k], (u32)mhi[k]};
}

__device__ __forceinline__ void b2_phase(const P& p, int bid, int nb, char* smem, int tid) {
  const int rounds = (4096 + nb - 1) / nb;
  u32 ra[64], rb[64];
  int ia = snake_item(0, bid, nb);
  if (ia < 4096) b2_load(p, ia, tid, ra);
#pragma unroll 1
  for (int k = 0; k < rounds; k += 2) {
    const int ib = (k + 1 < rounds) ? snake_item(k + 1, bid, nb) : 4096;
    if (ib < 4096) b2_load(p, ib, tid, rb);
    if (ia < 4096) b2_process(p, ia, smem, tid, ra);
    ia = (k + 2 < rounds) ? snake_item(k + 2, bid, nb) : 4096;
    if (ia < 4096) b2_load(p, ia, tid, ra);
    if (ib < 4096) b2_process(p, ib, smem, tid, rb);
  }
}

__device__ __forceinline__ void b3_item(const P& p, int l, int item, char* smem, int tid) {
  const int lane = tid & 63, w = tid >> 6, h = lane >> 5, lr = lane & 31;
  const int g = 63 - (item >> 4), rem = item & 15, b = rem >> 3, head = rem & 7;
  const int q0 = g * 128;
  const int nkt = 2 * g + 2;
  const u16* AK = (const u16*)(p.ws + OFF_AK) + (size_t)b * SEQ * 512 + head * 64;
  const u16* AVT = (const u16*)(p.ws + OFF_AVT) + ((size_t)(b * 512 + head * 64)) * 8192;
  const u64* MK = (const u64*)(p.ws + OFF_MASK) + (size_t)(b * SEQ + q0) * 128;
  bf16x8 qf[4];
  {
    const u16* qrow = (const u16*)(p.ws + OFF_AQ) + (size_t)(b * SEQ + q0 + w * 32 + lr) * 512 + head * 64;
#pragma unroll
    for (int ks = 0; ks < 4; ++ks) qf[ks] = *(const bf16x8*)(qrow + ks * 16 + 8 * h);
  }
  u32x4 kr[2], vr[2];
  u64 mr = 0;
  g2r<64>(kr, AK, 512, tid);
  g2r<64>(vr, AVT, 8192, tid);
  if (tid < 128) mr = MK[(size_t)tid * 128];
  r2s<64>(kr, smem, tid);
  r2s<64>(vr, smem + 8192, tid);
  if (tid < 128) *(u64*)(smem + 16384 + tid * 8) = mr;
  __syncthreads();
  f32x16 oacc[2];
#pragma unroll
  for (int i = 0; i < 2; ++i)
#pragma unroll
    for (int r = 0; r < 16; ++r) oacc[i][r] = 0.f;
  float mrun = -5e29f, lrun = 0.f;
  float mq = fabsf(p.qn[l * 64 + lane]), mk = fabsf(p.kn[l * 64 + lane]);
#pragma unroll
  for (int o = 32; o >= 1; o >>= 1) { mq = fmaxf(mq, __shfl_xor(mq, o)); mk = fmaxf(mk, __shfl_xor(mk, o)); }
  const bool fast = (0.125f * 1.4426950408889634f * 64.f * 1.03f) * mq * mk + 1.f < 60.f;
  for (int kt = 0; kt < nkt; ++kt) {
    const char* buf = smem + (kt & 1) * 17408;
    char* nbuf = smem + ((kt + 1) & 1) * 17408;
    if (kt + 1 < nkt) {
      g2r<64>(kr, AK + (size_t)(kt + 1) * 64 * 512, 512, tid);
      g2r<64>(vr, AVT + (kt + 1) * 64, 8192, tid);
      if (tid < 128) mr = MK[(size_t)tid * 128 + kt + 1];
    }
    const u64 m64 = *(const u64*)(buf + 16384 + (w * 32 + lr) * 8);
    const u64 msh = ~(m64 >> (4 * h));
    const int w0 = (int)(u32)msh, w1 = (int)(u32)(msh >> 32);
    f32x16 s[2];
#pragma unroll
    for (int kb = 0; kb < 2; ++kb) {
#pragma unroll
      for (int r = 0; r < 16; ++r)
        s[kb][r] = __int_as_float(__builtin_amdgcn_sbfe(kb ? w1 : w0, (r & 3) + 8 * (r >> 2), 1) & (int)0xF149F2CAu);
#pragma unroll
      for (int ks = 0; ks < 4; ++ks)
        s[kb] = __builtin_amdgcn_mfma_f32_32x32x16_bf16(lds_frag(buf, kb * 32 + lr, ks * 2 + h), qf[ks], s[kb], 0, 0, 0);
    }
    float psum = 0.f;
    if (fast) {
#pragma unroll
      for (int kb = 0; kb < 2; ++kb)
#pragma unroll
        for (int r = 0; r < 16; ++r) {
          const float pv = __builtin_amdgcn_exp2f(s[kb][r]);
          s[kb][r] = pv;
          psum += pv;
        }
    } else {
      float tmax = s[0][0];
#pragma unroll
      for (int kb = 0; kb < 2; ++kb)
#pragma unroll
        for (int r = 0; r < 16; ++r) tmax = fmaxf(tmax, s[kb][r]);
      tmax = fmaxf(tmax, __shfl_xor(tmax, 32));
      if (__any(tmax > mrun)) {
        const float mnew = fmaxf(mrun, tmax);
        const float alpha = __builtin_amdgcn_exp2f(mrun - mnew);
        mrun = mnew;
        lrun *= alpha;
#pragma unroll
        for (int i = 0; i < 2; ++i)
#pragma unroll
          for (int r = 0; r < 16; ++r) oacc[i][r] *= alpha;
      }
#pragma unroll
      for (int kb = 0; kb < 2; ++kb)
#pragma unroll
        for (int r = 0; r < 16; ++r) {
          const float pv = __builtin_amdgcn_exp2f(s[kb][r] - mrun);
          s[kb][r] = pv;
          psum += pv;
        }
    }
    lrun += psum;
    const char* vt = buf + 8192;
#pragma unroll
    for (int kb = 0; kb < 2; ++kb)
#pragma unroll
      for (int s2 = 0; s2 < 2; ++s2) {
        union { bf16x8 v; u32 u[4]; } pf;
#pragma unroll
        for (int j = 0; j < 4; ++j) pf.u[j] = pack2(s[kb][8 * s2 + 2 * j], s[kb][8 * s2 + 2 * j + 1]);
#pragma unroll
        for (int db = 0; db < 2; ++db) {
          const int drow = db * 32 + lr;
          const int ch = kb * 4 + 2 * s2;
          const int sw = (drow >> 1) & 7;
          union { bf16x8 v; u32x2 u[2]; } vf;
          vf.u[0] = *(const u32x2*)(vt + drow * 128 + ((ch ^ sw) << 4) + 8 * h);
          vf.u[1] = *(const u32x2*)(vt + drow * 128 + (((ch + 1) ^ sw) << 4) + 8 * h);
          oacc[db] = __builtin_amdgcn_mfma_f32_32x32x16_bf16(vf.v, pf.v, oacc[db], 0, 0, 0);
        }
      }
    if (kt + 1 < nkt) {
      r2s<64>(kr, nbuf, tid);
      r2s<64>(vr, nbuf + 8192, tid);
      if (tid < 128) *(u64*)(nbuf + 16384 + tid * 8) = mr;
    }
    __syncthreads();
  }
  lrun += __shfl_xor(lrun, 32);
  const float inv = 1.f / lrun;
  u16* yrow = (u16*)(p.ws + OFF_YA) + (size_t)(b * SEQ + q0 + w * 32 + lr) * 512 + head * 64;
#pragma unroll
  for (int db = 0; db < 2; ++db)
#pragma unroll
    for (int rg = 0; rg < 4; ++rg) {
      const int d0 = db * 32 + 8 * rg + 4 * h;
      *(u32x2*)(yrow + d0) = u32x2{pack2(oacc[db][rg * 4] * inv, oacc[db][rg * 4 + 1] * inv),
                                   pack2(oacc[db][rg * 4 + 2] * inv, oacc[db][rg * 4 + 3] * inv)};
    }
}

__device__ __forceinline__ void d1_item(const P& p, int l, int mt, int nt, char* smem, int tid) {
  const int lane = tid & 63, w = tid >> 6, wm = w & 1, wn = w >> 1, lr = lane & 31;
  const int m0 = mt * 128, n0 = nt * 64;
  float* rs = (float*)(smem + 65536);
  const float* rowss = (const float*)(p.ws + OFF_ROWSS);
  if (tid < 128) rs[tid] = row_rstd(rowss, m0 + tid);
  const u16* XB = (const u16*)(p.ws + OFF_XB) + (size_t)m0 * 1024;
  f32x16 ag[2][2];
  zero_acc<2>(ag);
  gemm_loop<128, 2>(ag, XB, 1024, (const u16*)(p.ws + OFF_WGATE) + (size_t)nt * 128 * 1024, 1024, 16, smem, tid);
#pragma unroll
  for (int mi = 0; mi < 2; ++mi)
#pragma unroll
    for (int r = 0; r < 16; ++r) {
      const float rstd = rs[wm * 64 + mi * 32 + rowof(r, lane)];
      ag[mi][0][r] = sigmoidf_(ag[mi][0][r] * rstd);
      ag[mi][1][r] = sigmoidf_(ag[mi][1][r] * rstd);
    }
  f32x16 res[2][1], ap[2][1];
#pragma unroll
  for (int br = 0; br < 2; ++br) {
    zero_acc<1>(ap);
    const u16* Y = (const u16*)(p.ws + (br ? OFF_YH : OFF_YA)) + (size_t)m0 * 512;
    const u16* WP = (const u16*)(p.ws + (br ? OFF_WPH : OFF_WPA)) + (size_t)n0 * 512;
    gemm_loop<64, 1>(ap, Y, 512, WP, 512, 8, smem, tid);
#pragma unroll
    for (int mi = 0; mi < 2; ++mi)
#pragma unroll
      for (int r = 0; r < 16; ++r) {
        const float v = ag[mi][br][r] * ap[mi][0][r];
        res[mi][0][r] = br ? res[mi][0][r] + v : v;
      }
  }
  u16* M = (u16*)(p.ws + OFF_MERGED);
#pragma unroll
  for (int mi = 0; mi < 2; ++mi)
#pragma unroll
    for (int r = 0; r < 16; ++r) {
      const int tok = m0 + wm * 64 + mi * 32 + rowof(r, lane);
      M[(size_t)tok * 1024 + n0 + wn * 32 + lr] = f2bf(res[mi][0][r]);
    }
}

__device__ __forceinline__ void resid_item(const P& p, const u16* A, int K, const u16* W, float* rowss_next, int mt, int nt, char* smem,
                           int tid) {
  const int lane = tid & 63, w = tid >> 6, wm = w & 1, wn = w >> 1, lr = lane & 31;
  const int m0 = mt * 128, n0 = nt * 128;
  f32x16 acc[2][2];
  zero_acc<2>(acc);
  gemm_loop<128, 2>(acc, A + (size_t)m0 * K, K, W + (size_t)n0 * K, K, K >> 6, smem, tid);
  u16* XB = (u16*)(p.ws + OFF_XB);
  float myss = 0.f;
  int mytok = 0;
#pragma unroll
  for (int mi = 0; mi < 2; ++mi)
#pragma unroll
    for (int r = 0; r < 16; ++r) {
      const int tok = m0 + wm * 64 + mi * 32 + rowof(r, lane);
      float ss = 0.f;
#pragma unroll
      for (int ni = 0; ni < 2; ++ni) {
        const size_t o = (size_t)tok * 1024 + n0 + wn * 64 + ni * 32 + lr;
        const float xn = p.out[o] + acc[mi][ni][r];
        p.out[o] = xn;
        XB[o] = f2bf(xn);
        ss += xn * xn;
      }
#pragma unroll
      for (int of = 16; of >= 1; of >>= 1) ss += __shfl_xor(ss, of);
      if (lr == mi * 16 + r) { myss = ss; mytok = tok; }
      __builtin_amdgcn_sched_barrier(0);
    }
  rowss_next[(size_t)mytok * 16 + nt * 2 + wn] = myss;
}

__device__ __forceinline__ void e_item(const P& p, int l, int mt, int nt, char* smem, int tid) {
  const int lane = tid & 63, w = tid >> 6, wm = w & 1, wn = w >> 1, lr = lane & 31;
  const int m0 = mt * 128;
  float* rs = (float*)(smem + 65536);
  const float* rowss = (const float*)(p.ws + OFF_ROWSS) + (size_t)NTOK * 16;
  if (tid < 128) rs[tid] = row_rstd(rowss, m0 + tid);
  f32x16 acc[2][2];
  zero_acc<2>(acc);
  gemm_loop<128, 2>(acc, (const u16*)(p.ws + OFF_XB) + (size_t)m0 * 1024, 1024,
                    (const u16*)(p.ws + OFF_WFFI) + (size_t)nt * 128 * 1024, 1024, 16, smem, tid);
  u16* ACT = (u16*)(p.ws + OFF_ACT);
#pragma unroll
  for (int mi = 0; mi < 2; ++mi)
#pragma unroll
    for (int r = 0; r < 16; ++r) {
      const int tl = wm * 64 + mi * 32 + rowof(r, lane);
      const float rstd = rs[tl];
      const float gv = acc[mi][0][r] * rstd, uv = acc[mi][1][r] * rstd;
      ACT[(size_t)(m0 + tl) * DFF + nt * 64 + wn * 32 + lr] = f2bf(siluf_(gv) * uv);
    }
}

#ifndef ONLY_S
#define ONLY_S -1
#endif
#define EN(k) (ONLY_S < 0 || ONLY_S == (k))
template <class F>
__device__ __forceinline__ void for_tiles(int NT, int bid, int nb, F f) {
  if ((nb & 63) == 0) {
    const int vx = bid & 7, j = bid >> 3, JN = nb >> 6;
    const int jm = j & 7, jn = j >> 3;
    const int NG = (NT + JN - 1) / JN;
    const int wl = NT - (NG - 1) * JN;
    const bool fold = (wl * 2 == JN);
    const int NGF = fold ? NG - 1 : NG;
    for (int r = 0; r < 2 * NGF; ++r) {
      const int mh = r / NGF, ng = r - mh * NGF;
      const int mt = vx * 16 + mh * 8 + jm, nt = ng * JN + jn;
      if (nt < NT) f(mt, nt);
    }
    if (fold) f(vx * 16 + (jn / wl) * 8 + jm, (NG - 1) * JN + (jn % wl));
  } else {
    for (int it = bid; it < 128 * NT; it += nb) f(it / NT, it % NT);
  }
}
__device__ __forceinline__ int snake_item(int k, int bid, int nb) {
  return (k & 1) ? (((k + 1) * nb - 1 - bid) ^ 7) : (k * nb + bid);
}

__device__ __forceinline__ void run_phase(const P& p, int ph, char* smem) {
  int tid0 = threadIdx.x;
  asm volatile("" : "+v"(tid0));
  const int nb = gridDim.x;
  int bid = blockIdx.x;
  asm volatile("" : "+s"(bid));
#define LAUNDER int tid = tid0; asm volatile("" : "+v"(tid)); __syncthreads();
  if (ph == 0) {
    if (EN(11)) for (int it = bid; it < 4096 + 4128; it += nb) { LAUNDER
      if (it < 4096) p0_rows(p, it, tid); else conv_item(p, 0, it - 4096, smem, tid);
    }
    return;
  }
  const int l = (ph - 1) / 11, s = (ph - 1) % 11;
  float* rowss = (float*)(p.ws + OFF_ROWSS);
  switch (s) {
    case 0: if (EN(0)) {
      for_tiles(31, bid, nb, [&](int mt, int nt) { LAUNDER phaseA_tile(p, l, mt, nt, smem, tid); });
      if (l > 0) for (int it = bid; it < 704; it += nb) { LAUNDER conv_item(p, l, 3424 + it, smem, tid); }
    } break;
    case 1: if (EN(1)) for (int it = bid; it < 1024; it += nb) { LAUNDER h1_item(p, it, smem, tid); } break;
    case 2: if (EN(2)) for (int it = bid; it < 256; it += nb) { LAUNDER h2_item(p, it, tid); } break;
    case 3: if (EN(3)) for (int it = bid; it < 1024; it += nb) { LAUNDER h3_item(p, l, it, smem, tid); } break;
    case 4: if (EN(4)) for (int it = bid; it < 4160; it += nb) { LAUNDER b1_item(p, it, smem, tid); } break;
    case 5: if (EN(5)) { int tid = tid0; asm volatile("" : "+v"(tid)); b2_phase(p, bid, nb, smem, tid); } break;
    case 6: if (EN(6)) for (int k = 0; k * nb < 1024; ++k) { const int it = snake_item(k, bid, nb); if (it < 1024) { LAUNDER b3_item(p, l, it, smem, tid); } } break;
    case 7: if (EN(7)) for_tiles(16, bid, nb, [&](int mt, int nt) { LAUNDER d1_item(p, l, mt, nt, smem, tid); }); break;
    case 8:
      if (EN(8)) for_tiles(8, bid, nb, [&](int mt, int nt) { LAUNDER
        resid_item(p, (const u16*)(p.ws + OFF_MERGED), 1024, (const u16*)(p.ws + OFF_WOUT), rowss + (size_t)NTOK * 16, mt, nt, smem, tid); });
      break;
    case 9: if (EN(9)) for_tiles(44, bid, nb, [&](int mt, int nt) { LAUNDER e_item(p, l, mt, nt, smem, tid); }); break;
    case 10: if (EN(10)) {
      for_tiles(8, bid, nb, [&](int mt, int nt) { LAUNDER
        resid_item(p, (const u16*)(p.ws + OFF_ACT), DFF, (const u16*)(p.ws + OFF_WFFO), rowss, mt, nt, smem, tid); });
      if (l < 3) for (int it = bid; it < 3424; it += nb) { LAUNDER conv_item(p, l + 1, it, smem, tid); }
    } break;
  }
#undef LAUNDER
}

constexpr int NPHASE = 1 + 11 * DEPTH;

#ifndef REP_MASK
#define REP_MASK 0
#endif
#define XB_TMO      128
#define XB_XCNT(j)  (256  + 64 * (j))
#define XB_XSUB(j)  (1280 + 64 * (j))
#define XB_XGEN(j)  (2304 + 64 * (j))
#define XB_TOP      3328
#define XB_TOPGEN   3392
#define XCD_BAR_WORDS 3456
#define XB_SPIN_CAP (1u << 18)
#define LAS __attribute__((address_space(3)))

__device__ __forceinline__ unsigned xb_ld(unsigned* p)              { return __hip_atomic_load(p, __ATOMIC_RELAXED, __HIP_MEMORY_SCOPE_AGENT); }
__device__ __forceinline__ unsigned xb_add(unsigned* p, unsigned v) { return __hip_atomic_fetch_add(p, v, __ATOMIC_RELAXED, __HIP_MEMORY_SCOPE_AGENT); }
__device__ __forceinline__ unsigned xb_xcc_id() { return (unsigned)__builtin_amdgcn_s_getreg((3 << 11) | 20) & 0xFu; }
#define XB_SPIN(cond, bar) do { unsigned _sp = 0; while (cond) { __builtin_amdgcn_s_sleep(1); \
    if ((++_sp & 255u) == 0u) { if (xb_ld(&(bar)[XB_TMO])) break; if (_sp > XB_SPIN_CAP) { atomicAdd(&(bar)[XB_TMO], 1u); break; } } } } while (0)

struct XcdBarrier {
    unsigned* bar; unsigned x;
    volatile LAS unsigned* st;
};

__device__ __forceinline__ XcdBarrier xcd_barrier_post(unsigned* bar, volatile LAS unsigned* st) {
    XcdBarrier b; b.bar = bar; b.x = xb_xcc_id(); b.st = st;
    if (threadIdx.x == 0) (void)xb_add(&bar[XB_XCNT(b.x)], 1u);
    return b;
}
__device__ __forceinline__ void xcd_barrier_complete(unsigned* bar, unsigned x, unsigned& nloc, unsigned& nx) {
    const unsigned G = gridDim.x * gridDim.y * gridDim.z;
    unsigned sum, cnt, mine, sp = 0u;
    for (;;) {
        sum = 0u; cnt = 0u; mine = 0u;
#pragma unroll
        for (unsigned j = 0; j < 16; ++j) { const unsigned c = xb_ld(&bar[XB_XCNT(j)]); sum += c; cnt += (c > 0u) ? 1u : 0u; mine = (j == x) ? c : mine; }
        if (sum == G) break;
        __builtin_amdgcn_s_sleep(1);
        if ((++sp & 255u) == 0u) { if (xb_ld(&bar[XB_TMO])) break; if (sp > XB_SPIN_CAP) { atomicAdd(&bar[XB_TMO], 1u); break; } }
    }
    nloc = mine > 0u ? mine : 1u; nx = cnt > 0u ? cnt : 1u;
}

__device__ __forceinline__ void xcd_barrier(const XcdBarrier& b) {
    asm volatile("s_waitcnt vmcnt(0)" ::: "memory");
    __syncthreads();
    if (threadIdx.x == 0) {
        unsigned* bar = b.bar;
        __builtin_amdgcn_s_waitcnt(0);
        unsigned nloc = b.st[0], nx = b.st[1];
        if (nloc == 0u) { xcd_barrier_complete(bar, b.x, nloc, nx); b.st[0] = nloc; b.st[1] = nx; }
        const unsigned old = xb_add(&bar[XB_XSUB(b.x)], 1u);
        const unsigned gen = old / nloc;
        if (old + 1u == (gen + 1u) * nloc) {
            __builtin_amdgcn_fence(__ATOMIC_RELEASE, "agent");
            asm volatile("s_waitcnt vmcnt(0)" ::: "memory");
            const unsigned og = xb_add(&bar[XB_TOP], 1u);
            const unsigned tg = og / nx;
            if (og + 1u == (tg + 1u) * nx) xb_add(&bar[XB_TOPGEN], 1u);
            else XB_SPIN(xb_ld(&bar[XB_TOPGEN]) == tg, bar);
            __builtin_amdgcn_fence(__ATOMIC_ACQUIRE, "agent");
            xb_add(&bar[XB_XGEN(b.x)], 1u);
            asm volatile("s_waitcnt vmcnt(0)" ::: "memory");
        } else {
            XB_SPIN(xb_ld(&bar[XB_XGEN(b.x)]) == gen, bar);
            __builtin_amdgcn_fence(__ATOMIC_ACQUIRE, "agent");
            asm volatile("s_waitcnt vmcnt(0)" ::: "memory");
        }
    }
    __syncthreads();
}


template <bool COOP>
__global__ void __launch_bounds__(256, 2) mega(P p, int ph0, int ph1) {
  __shared__ __attribute__((aligned(16))) char smem[66560];
  __shared__ uint4 xb_words;
  if (threadIdx.x == 0) xb_words = make_uint4(0u, 0u, 0u, 0u);
  __syncthreads();
  XcdBarrier xb = xcd_barrier_post((unsigned*)(p.ws + OFF_BAR), (volatile LAS unsigned*)&xb_words);
  for (int ph = ph0; ph < ph1; ++ph) {
    int reps = 1;
    if (REP_MASK != 0 && ph > 0 && ((REP_MASK >> ((ph - 1) % 11)) & 1)) reps = 2;
    for (int rp = 0; rp < reps; ++rp) {
      run_phase(p, ph, smem);
      if (COOP) {
        if (ph + 1 < ph1 || rp + 1 < reps) {
          if (ph == 0) cg::this_grid().sync();
          else xcd_barrier(xb);
        }
      }
    }
  }
}

extern "C" void kernel_launch(void* const* d_in, const int* in_sizes, int n_in, void* d_out, int out_size, void* d_ws,
                              size_t ws_size, hipStream_t stream) {
  if (ws_size < WS_END) { fprintf(stderr, "workspace too small: %zu\n", ws_size); return; }
  P p{};
  p.x = (const float*)d_in[0]; p.pos = (const int*)d_in[1]; p.w_in = (const float*)d_in[2];
  p.w_pa = (const float*)d_in[3]; p.w_ph = (const float*)d_in[4]; p.w_out = (const float*)d_in[5];
  p.nmix = (const float*)d_in[6]; p.nffn = (const float*)d_in[7]; p.qn = (const float*)d_in[8];
  p.kn = (const float*)d_in[9]; p.hn = (const float*)d_in[10]; p.hlb = (const float*)d_in[11];
  p.w_ffi = (const float*)d_in[12]; p.w_ffo = (const float*)d_in[13];
  p.out = (float*)d_out; p.ws = (char*)d_ws;
#if COOP_MODE
  static int grid_blocks = 0;
  if (!grid_blocks) {
    int dev = 0, cus = 0, per_cu = 0;
    hipGetDevice(&dev);
    hipDeviceGetAttribute(&cus, hipDeviceAttributeMultiprocessorCount, dev);
    hipOccupancyMaxActiveBlocksPerMultiprocessor(&per_cu, mega<true>, 256, 0);
    if (per_cu > 2) per_cu = 2;
    grid_blocks = cus * per_cu;
  }
  int ph0 = 0, ph1 = NPHASE;
  hipMemsetAsync((char*)d_ws + OFF_BAR, 0, 16384, stream);
  void* args[] = {&p, &ph0, &ph1};
  hipError_t e = hipLaunchCooperativeKernel((void*)mega<true>, dim3(grid_blocks), dim3(256), args, 0, stream);
  if (e != hipSuccess) fprintf(stderr, "cooperative launch failed: %s (grid %d)\n", hipGetErrorString(e), grid_blocks);
#else
  for (int ph = 0; ph < NPHASE; ++ph) mega<false><<<dim3(512), dim3(256), 0, stream>>>(p, ph, ph + 1);
#endif
}
```

```cpp
#include <hip/hip_runtime.h>
#include <hip/hip_cooperative_groups.h>
#include <stdint.h>
#include <stdio.h>
namespace cg = cooperative_groups;

#ifndef COOP_MODE
#define COOP_MODE 1
#endif

typedef unsigned short u16;
typedef unsigned int u32;
typedef unsigned long long u64;
typedef __attribute__((ext_vector_type(8))) short bf16x8;
typedef __attribute__((ext_vector_type(16))) float f32x16;
typedef __attribute__((ext_vector_type(4))) u32 u32x4;
typedef __attribute__((ext_vector_type(2))) u32 u32x2;
typedef __attribute__((ext_vector_type(2))) unsigned short u16x2;

constexpr int NTOK = 16384, SEQ = 8192, DEPTH = 4;
constexpr int DFF = 2816;
constexpr float EPS = 1e-6f;
constexpr size_t MiB = (size_t)1 << 20;
constexpr size_t OFF_WIN = 0, OFF_WGATE = 8 * MiB, OFF_WPA = 12 * MiB, OFF_WPH = 13 * MiB, OFF_WOUT = 14 * MiB,
                 OFF_WFFI = 16 * MiB, OFF_WFFO = 27 * MiB, OFF_AQ = 33 * MiB, OFF_AK = 49 * MiB, OFF_AVT = 65 * MiB,
                 OFF_IQ = 81 * MiB, OFF_IK = 89 * MiB, OFF_IW = 91 * MiB, OFF_HQ = 92 * MiB, OFF_HVT = 108 * MiB,
                 OFF_HG = 124 * MiB, OFF_LOGF = 140 * MiB, OFF_XB = 172 * MiB, OFF_YH = 204 * MiB, OFF_MASK = 220 * MiB,
                 OFF_ROWSS = 236 * MiB, OFF_CODES = 238 * MiB, OFF_YA = OFF_CODES, OFF_US = OFF_CODES,
                 OFF_GDEC = OFF_CODES + 32 * MiB, OFF_MERGED = OFF_AQ, OFF_ACT = OFF_AQ, OFF_BAR = 32 * MiB + 768 * 1024, WS_END = 368 * MiB;
constexpr size_t CODES_PER_BATCH = (size_t)16384 * 2080;

struct P {
  const float* x; const int* pos; const float* w_in; const float* w_pa; const float* w_ph; const float* w_out;
  const float* nmix; const float* nffn; const float* qn; const float* kn; const float* hn; const float* hlb;
  const float* w_ffi; const float* w_ffo; float* out; char* ws;
};

__device__ __forceinline__ u16 f2bf(float f) {
  u32 u = __float_as_uint(f);
  u += 0x7FFFu + ((u >> 16) & 1u);
  return (u16)(u >> 16);
}
__device__ __forceinline__ float bf2f(u16 v) { return __uint_as_float(((u32)v) << 16); }
__device__ __forceinline__ u32 pack2(float a, float b) { u32 r; asm("v_cvt_pk_bf16_f32 %0, %1, %2" : "=v"(r) : "v"(a), "v"(b)); return r; }
__device__ __forceinline__ float wave_sum(float v) {
#pragma unroll
  for (int o = 32; o >= 1; o >>= 1) v += __shfl_xor(v, o);
  return v;
}
__device__ __forceinline__ float sigmoidf_(float x) { return 1.f / (1.f + __expf(-x)); }
__device__ __forceinline__ float siluf_(float x) { return x / (1.f + __expf(-x)); }

template <int ROWS>
__device__ __forceinline__ void g2r(u32x4 (&r)[ROWS / 32], const u16* g, size_t ld, int tid) {
  const int c = tid & 7, row = tid >> 3;
#pragma unroll
  for (int i = 0; i < ROWS / 32; ++i) r[i] = *(const u32x4*)(g + (size_t)(row + 32 * i) * ld + c * 8);
}
template <int ROWS>
__device__ __forceinline__ void r2s(const u32x4 (&r)[ROWS / 32], char* s, int tid) {
  const int c = tid & 7, row = tid >> 3;
#pragma unroll
  for (int i = 0; i < ROWS / 32; ++i) {
    const int rr = row + 32 * i;
    *(u32x4*)(s + rr * 128 + ((c ^ ((rr >> 1) & 7)) << 4)) = r[i];
  }
}
__device__ __forceinline__ bf16x8 lds_frag(const char* s, int row, int kc) {
  return *(const bf16x8*)(s + row * 128 + ((kc ^ ((row >> 1) & 7)) << 4));
}
__device__ __forceinline__ int rowof(int reg, int lane) { return (reg & 3) + 8 * (reg >> 2) + 4 * (lane >> 5); }

template <int MI, int NI>
__device__ __forceinline__ void mma_tile(f32x16 (&acc)[MI][NI], const char* xs, int xrow0, const char* ys, int yrow0,
                                         int lane) {
  const int r = lane & 31, h = lane >> 5;
  bf16x8 a[2][MI], b[2][NI];
#pragma unroll
  for (int mi = 0; mi < MI; ++mi) a[0][mi] = lds_frag(xs, xrow0 + mi * 32 + r, h);
#pragma unroll
  for (int ni = 0; ni < NI; ++ni) b[0][ni] = lds_frag(ys, yrow0 + ni * 32 + r, h);
#pragma unroll
  for (int ks = 0; ks < 4; ++ks) {
    const int c = ks & 1, n = c ^ 1;
    if (ks < 3) {
#pragma unroll
      for (int mi = 0; mi < MI; ++mi) a[n][mi] = lds_frag(xs, xrow0 + mi * 32 + r, (ks + 1) * 2 + h);
#pragma unroll
      for (int ni = 0; ni < NI; ++ni) b[n][ni] = lds_frag(ys, yrow0 + ni * 32 + r, (ks + 1) * 2 + h);
    }
    __builtin_amdgcn_sched_barrier(0);
#pragma unroll
    for (int mi = 0; mi < MI; ++mi)
#pragma unroll
      for (int ni = 0; ni < NI; ++ni)
        acc[mi][ni] = __builtin_amdgcn_mfma_f32_32x32x16_bf16(a[c][mi], b[c][ni], acc[mi][ni], 0, 0, 0);
    __builtin_amdgcn_sched_barrier(0);
  }
}

template <int YR, int NI>
__device__ __forceinline__ void gemm_loop_shallow(f32x16 (&acc)[2][NI], const u16* X, size_t ldx, const u16* Y, size_t ldy,
                                          int KT, char* smem, int tid) {
  const int lane = tid & 63, w = tid >> 6, wm = w & 1, wn = w >> 1;
  char* xs = smem;
  char* ys = smem + 32768;
  u32x4 xr[4], yr[YR / 32];
  g2r<128>(xr, X, ldx, tid);
  g2r<YR>(yr, Y, ldy, tid);
  r2s<128>(xr, xs, tid);
  r2s<YR>(yr, ys, tid);
  __syncthreads();
#pragma unroll 1
  for (int kt = 0; kt < KT; ++kt) {
    const int cur = kt & 1;
    if (kt + 1 < KT) {
      g2r<128>(xr, X + (size_t)(kt + 1) * 64, ldx, tid);
      g2r<YR>(yr, Y + (size_t)(kt + 1) * 64, ldy, tid);
    }
    mma_tile<2, NI>(acc, xs + cur * 16384, wm * 64, ys + cur * (YR * 128), wn * 32 * NI, lane);
    if (kt + 1 < KT) {
      r2s<128>(xr, xs + (cur ^ 1) * 16384, tid);
      r2s<YR>(yr, ys + (cur ^ 1) * (YR * 128), tid);
    }
    __syncthreads();
  }
}
template <int YR, int NI>
__device__ __forceinline__ void gemm_loop_deep(f32x16 (&acc)[2][NI], const u16* X, size_t ldx, const u16* Y, size_t ldy,
                                          int KT, char* smem, int tid) {
  const int lane = tid & 63, w = tid >> 6, wm = w & 1, wn = w >> 1;
  char* xs = smem;
  char* ys = smem + 32768;
  u32x4 xa[4], ya[YR / 32], xb[4], yb[YR / 32];
  g2r<128>(xa, X, ldx, tid);
  g2r<YR>(ya, Y, ldy, tid);
  g2r<128>(xb, X + 64, ldx, tid);
  g2r<YR>(yb, Y + 64, ldy, tid);
  r2s<128>(xa, xs, tid);
  r2s<YR>(ya, ys, tid);
  __syncthreads();
#pragma unroll 1
  for (int kt = 0; kt < KT; kt += 2) {
    if (kt + 2 < KT) {
      g2r<128>(xa, X + (size_t)(kt + 2) * 64, ldx, tid);
      g2r<YR>(ya, Y + (size_t)(kt + 2) * 64, ldy, tid);
    }
    mma_tile<2, NI>(acc, xs, wm * 64, ys, wn * 32 * NI, lane);
    r2s<128>(xb, xs + 16384, tid);
    r2s<YR>(yb, ys + YR * 128, tid);
    __syncthreads();
    if (kt + 3 < KT) {
      g2r<128>(xb, X + (size_t)(kt + 3) * 64, ldx, tid);
      g2r<YR>(yb, Y + (size_t)(kt + 3) * 64, ldy, tid);
    }
    mma_tile<2, NI>(acc, xs + 16384, wm * 64, ys + YR * 128, wn * 32 * NI, lane);
    if (kt + 2 < KT) {
      r2s<128>(xa, xs, tid);
      r2s<YR>(ya, ys, tid);
    }
    __syncthreads();
  }
}
template <int YR, int NI>
__device__ __forceinline__ void gemm_loop(f32x16 (&acc)[2][NI], const u16* X, size_t ldx, const u16* Y, size_t ldy,
                                          int KT, char* smem, int tid) {
  if constexpr (YR == 128) gemm_loop_deep<YR, NI>(acc, X, ldx, Y, ldy, KT, smem, tid);
  else gemm_loop_shallow<YR, NI>(acc, X, ldx, Y, ldy, KT, smem, tid);
}
template <int NI>
__device__ __forceinline__ void zero_acc(f32x16 (&acc)[2][NI]) {
#pragma unroll
  for (int mi = 0; mi < 2; ++mi)
#pragma unroll
    for (int ni = 0; ni < NI; ++ni)
#pragma unroll
      for (int r = 0; r < 16; ++r) acc[mi][ni][r] = 0.f;
}

__device__ __forceinline__ int conv_map(int mode, int n) {
  if (mode == 0) return n < 1860 ? n : (n < 1920 ? -1 : n - 60);
  if (mode == 1) {
    const int tile = n >> 7, r = n & 127, sub = r >> 5;
    return 3908 + (sub & 1) * 1024 + tile * 64 + (sub >> 1) * 32 + (r & 31);
  }
  if (mode == 3) {
    const int tile = n >> 7, r = n & 127, sub = r >> 5;
    const int j = tile * 64 + (sub >> 1) * 32 + (r & 31);
    return (sub & 1) ? DFF + j : j;
  }
  return n;
}
__device__ __forceinline__ void conv_tile(const float* src, int ld, int K, int mode, const float* scale, u16* dst, int tile, float* lds,
                          int tid) {
  const int ktiles = K >> 6;
  const int ntile = tile / ktiles, ktile = tile - ntile * ktiles;
  const int n0 = ntile * 64, k0 = ktile * 64;
  const int nl = tid & 63, kg = tid >> 6;
  const int col = conv_map(mode, n0 + nl);
  float vv[16];
#pragma unroll
  for (int i = 0; i < 16; ++i) {
    const int k = i * 4 + kg;
    vv[i] = (col >= 0) ? src[(size_t)(k0 + k) * ld + col] : 0.f;
    if (scale) vv[i] *= scale[k0 + k];
  }
#pragma unroll
  for (int i = 0; i < 16; ++i) lds[(i * 4 + kg) * 65 + nl] = vv[i];
  __syncthreads();
  const int nr = tid >> 2, part = tid & 3;
  u32 o[8];
#pragma unroll
  for (int i = 0; i < 8; ++i)
    o[i] = pack2(lds[(part * 16 + 2 * i) * 65 + nr], lds[(part * 16 + 2 * i + 1) * 65 + nr]);
  u32x4* d = (u32x4*)(dst + (size_t)(n0 + nr) * K + k0 + part * 16);
  d[0] = u32x4{o[0], o[1], o[2], o[3]};
  d[1] = u32x4{o[4], o[5], o[6], o[7]};
}
__device__ __forceinline__ void conv_item(const P& p, int l, int c, char* smem, int tid) {
  const float* src; int ld, K, mode; const float* scale = nullptr; u16* dst;
  if (c < 992) { src = p.w_in + (size_t)l * 1024 * 5956; ld = 5956; K = 1024; mode = 0; scale = p.nmix + l * 1024; dst = (u16*)(p.ws + OFF_WIN); }
  else if (c < 1504) { c -= 992; src = p.w_in + (size_t)l * 1024 * 5956; ld = 5956; K = 1024; mode = 1; scale = p.nmix + l * 1024; dst = (u16*)(p.ws + OFF_WGATE); }
  else if (c < 1632) { c -= 1504; src = p.w_pa + (size_t)l * 512 * 1024; ld = 1024; K = 512; mode = 2; dst = (u16*)(p.ws + OFF_WPA); }
  else if (c < 1760) { c -= 1632; src = p.w_ph + (size_t)l * 512 * 1024; ld = 1024; K = 512; mode = 2; dst = (u16*)(p.ws + OFF_WPH); }
  else if (c < 2016) { c -= 1760; src = p.w_out + (size_t)l * 1024 * 1024; ld = 1024; K = 1024; mode = 2; dst = (u16*)(p.ws + OFF_WOUT); }
  else if (c < 3424) { c -= 2016; src = p.w_ffi + (size_t)l * 1024 * 5632; ld = 5632; K = 1024; mode = 3; scale = p.nffn + l * 1024; dst = (u16*)(p.ws + OFF_WFFI); }
  else { c -= 3424; src = p.w_ffo + (size_t)l * DFF * 1024; ld = 1024; K = DFF; mode = 2; dst = (u16*)(p.ws + OFF_WFFO); }
  conv_tile(src, ld, K, mode, scale, dst, c, (float*)smem, tid);
}

__device__ __forceinline__ void p0_rows(const P& p, int item, int tid) {
  const int lane = tid & 63, w = tid >> 6;
  const int tok = item * 4 + w;
  const float4* xr = (const float4*)(p.x + (size_t)tok * 1024);
  float4* orow = (float4*)(p.out + (size_t)tok * 1024);
  u32x2* xb = (u32x2*)(p.ws + OFF_XB + (size_t)tok * 2048);
  float ss = 0.f;
#pragma unroll
  for (int i = 0; i < 4; ++i) {
    float4 v = xr[lane + 64 * i];
    ss += v.x * v.x + v.y * v.y + v.z * v.z + v.w * v.w;
    orow[lane + 64 * i] = v;
    xb[lane + 64 * i] = u32x2{pack2(v.x, v.y), pack2(v.z, v.w)};
  }
  ss = wave_sum(ss);
  float* rowss = (float*)(p.ws + OFF_ROWSS);
  if (lane < 16) rowss[(size_t)tok * 16 + lane] = lane == 0 ? ss : 0.f;
}


__device__ __forceinline__ float row_rstd(const float* part, int tok) {
  const float4* q = (const float4*)(part + (size_t)tok * 16);
  const float4 a = q[0], b = q[1], c = q[2], d = q[3];
  const float ss = ((a.x + a.y) + (a.z + a.w)) + ((b.x + b.y) + (b.z + b.w)) + ((c.x + c.y) + (c.z + c.w)) + ((d.x + d.y) + (d.z + d.w));
  return rsqrtf(ss * (1.f / 1024.f) + EPS);
}
__device__ __forceinline__ void rope_cs(int pos, int d1, float& c, float& s) {
  const float inv = exp2f(-(float)d1 * (13.287712379549449f / 32.f));
  const float ang = (float)pos * inv;
  double rv = (double)ang * 0.15915494309189535;
  rv -= floor(rv);
  const float r = (float)rv;
  c = __builtin_amdgcn_cosf(r);
  s = __builtin_amdgcn_sinf(r);
}

__device__ __forceinline__ void phaseA_tile(const P& p, int l, int mt, int nt, char* smem, int tid) {
  const int lane = tid & 63, w = tid >> 6, wm = w & 1, wn = w >> 1, h = lane >> 5, lr = lane & 31;
  const int m0 = mt * 128;
  float* rs = (float*)(smem + 65536);
  const float* rowss = (const float*)(p.ws + OFF_ROWSS);
  if (tid < 128) rs[tid] = row_rstd(rowss, m0 + tid);
  const u16* XB = (const u16*)(p.ws + OFF_XB) + (size_t)m0 * 1024;
  const u16* W = (const u16*)(p.ws + OFF_WIN) + (size_t)nt * 128 * 1024;
  const bool fr = (nt < 15) || (nt >= 23 && nt < 27);
  f32x16 acc[2][2];
  zero_acc<2>(acc);
  if (fr) gemm_loop<128, 2>(acc, W, 1024, XB, 1024, 16, smem, tid);
  else gemm_loop<128, 2>(acc, XB, 1024, W, 1024, 16, smem, tid);

  if (fr) {
    if (nt < 8 || (nt >= 12 && nt < 15)) {
      const bool isidx = nt >= 12;
      const int fbase = isidx ? (nt - 12) * 128 + wm * 64 : nt * 128 + wm * 64;
      if (isidx && nt == 14 && wm == 1) {
#pragma unroll
        for (int ni = 0; ni < 2; ++ni) {
          const int tl = wn * 64 + ni * 32 + lr;
          const float rstd = rs[tl] * 0.5f;
          if (h == 0) {
            float4 o = {acc[0][ni][0] * rstd, acc[0][ni][1] * rstd, acc[0][ni][2] * rstd, acc[0][ni][3] * rstd};
            *(float4*)(p.ws + OFF_IW + (size_t)(m0 + tl) * 16) = o;
          }
        }
        return;
      }
      const bool isk = (!isidx) && fbase >= 512;
      const int head = isidx ? (nt == 14 ? 0 : (fbase >> 6)) : ((fbase & 511) >> 6);
      const float* nw = isidx ? nullptr : (isk ? p.kn + l * 64 : p.qn + l * 64);
      u16* dst; int dld;
      float oscale = 1.f;
      if (!isidx) { dst = (u16*)(p.ws + (isk ? OFF_AK : OFF_AQ)); dld = 512; if (!isk) oscale = 0.125f * 1.4426950408889634f; }
      else if (nt < 14) { dst = (u16*)(p.ws + OFF_IQ); dld = 256; oscale = 0.125f; }
      else { dst = (u16*)(p.ws + OFF_IK); dld = 64; }
#pragma unroll
      for (int ni = 0; ni < 2; ++ni) {
        const int tl = wn * 64 + ni * 32 + lr;
        const int tok = m0 + tl;
        const float rstd = rs[tl];
        const int pos = p.pos[tok];
        float rn = rstd;
        if (!isidx) {
          float ss = 0.f;
#pragma unroll
          for (int mi = 0; mi < 2; ++mi)
#pragma unroll
            for (int r = 0; r < 16; ++r) { const float v = acc[mi][ni][r] * rstd; ss += v * v; }
          ss += __shfl_xor(ss, 32);
          rn = rstd * rsqrtf(ss * (1.f / 64.f) + EPS);
        }
        u16* drow = dst + (size_t)tok * dld + head * 64;
#pragma unroll
        for (int rg = 0; rg < 4; ++rg) {
          float o1[4], o2[4];
#pragma unroll
          for (int j = 0; j < 4; ++j) {
            const int r = rg * 4 + j;
            const int d1 = j + 8 * rg + 4 * h;
            float x1 = acc[0][ni][r] * rn, x2 = acc[1][ni][r] * rn;
            if (!isidx) { x1 *= nw[d1]; x2 *= nw[d1 + 32]; }
            float c, s;
            rope_cs(pos, d1, c, s);
            o1[j] = (x1 * c - x2 * s) * oscale;
            o2[j] = (x2 * c + x1 * s) * oscale;
          }
          const int d1b = 8 * rg + 4 * h;
          *(u32x2*)(drow + d1b) = u32x2{pack2(o1[0], o1[1]), pack2(o1[2], o1[3])};
          *(u32x2*)(drow + d1b + 32) = u32x2{pack2(o2[0], o2[1]), pack2(o2[2], o2[3])};
          __builtin_amdgcn_sched_barrier(0);
        }
      }
    } else {
      const bool isav = nt < 12;
      u16* dst = (u16*)(p.ws + (isav ? OFF_AVT : OFF_HVT));
#pragma unroll
      for (int ni = 0; ni < 2; ++ni) {
        const int tl = wn * 64 + ni * 32 + lr;
        const int tok = m0 + tl;
        const float rstd = rs[tl];
        const int b = tok >> 13, t = tok & 8191;
#pragma unroll
        for (int mi = 0; mi < 2; ++mi)
#pragma unroll
          for (int r = 0; r < 16; ++r) {
            const int f = (isav ? (nt - 8) : (nt - 23)) * 128 + wm * 64 + mi * 32 + rowof(r, lane);
            dst[((size_t)(b * 512 + f)) * 8192 + t] = f2bf(acc[mi][ni][r] * rstd);
            if ((r & 3) == 3) __builtin_amdgcn_sched_barrier(0);
          }
      }
    }
  } else {
    const int seg = (nt - 15) >> 2;
    const int fb = ((nt - 15) & 3) * 128 + wn * 64;
#pragma unroll
    for (int ni = 0; ni < 2; ++ni) {
      const int f = fb + ni * 32 + lr;
      float lb = 0.f;
      if (seg == 1) {
        float e[4], mx = -1e30f;
#pragma unroll
        for (int i = 0; i < 4; ++i) { e[i] = p.hlb[i * 512 + f]; mx = fmaxf(mx, e[i]); }
        float tot = 0.f, part = 0.f;
#pragma unroll
        for (int i = 0; i < 4; ++i) { e[i] = __expf(e[i] - mx); tot += e[i]; if (i >= 1 && i <= l) part += e[i]; }
        lb = part / tot;
      }
#pragma unroll
      for (int mi = 0; mi < 2; ++mi)
#pragma unroll
        for (int r = 0; r < 16; ++r) {
          const int tl = wm * 64 + mi * 32 + rowof(r, lane);
          const float v = acc[mi][ni][r] * rs[tl];
          const size_t o = (size_t)(m0 + tl) * 512 + f;
          if (seg == 0) ((u16*)(p.ws + OFF_HQ))[o] = f2bf(siluf_(v));
          else if (seg == 3) ((u16*)(p.ws + OFF_HG))[o] = f2bf(siluf_(v));
          else {
            const float sg = 1.f / (1.f + __expf(-v));
            ((float*)(p.ws + OFF_LOGF))[o] = logf(lb + (1.f - lb) * sg);
          }
          if ((r & 3) == 3) __builtin_amdgcn_sched_barrier(0);
        }
    }
  }
}

__device__ __forceinline__ void hgrn_load_cumsum(const P& p, int tok0, int hh, int d, int hf, float (&lf)[32],
                                                 float (&cs)[32]) {
  const float* src = (const float*)(p.ws + OFF_LOGF) + (size_t)(tok0 + hf * 32) * 512 + hh * 128 + d;
#pragma unroll
  for (int i = 0; i < 32; ++i) lf[i] = src[(size_t)i * 512];
  float run = 0.f;
#pragma unroll
  for (int i = 0; i < 32; ++i) { run += lf[i]; cs[i] = run; }
}
__device__ __forceinline__ void put_td(char* base, int t, int d, float v) {
  const int kt = d >> 6, dd = d & 63;
  *(u16*)(base + kt * 8192 + t * 128 + (((dd >> 3) ^ ((t >> 1) & 7)) << 4) + (dd & 7) * 2) = f2bf(v);
}

__device__ __forceinline__ void h1_item(const P& p, int item, char* smem, int tid) {
  const int lane = tid & 63, w = tid >> 6, wm = w & 1, wn = w >> 1;
  const int b = item >> 9, hh = (item >> 7) & 3, c = item & 127;
  const int tok0 = b * SEQ + c * 64;
  const int d = tid & 127, hf = tid >> 7;
  char* vts = smem;
  char* kts = smem + 16384;
  float* tot = (float*)(smem + 65536);
  u32x4 vr[4];
  g2r<128>(vr, (const u16*)(p.ws + OFF_HVT) + ((size_t)(b * 512 + hh * 128)) * 8192 + c * 64, 8192, tid);
  float lf[32], cs[32];
  hgrn_load_cumsum(p, tok0, hh, d, hf, lf, cs);
  tot[hf * 128 + d] = cs[31];
  r2s<128>(vr, vts, tid);
  __syncthreads();
  const float after = hf ? 0.f : tot[128 + d];
  if (hf) ((float*)(p.ws + OFF_GDEC))[(size_t)item * 128 + d] = __expf(cs[31] + tot[d]);
#pragma unroll
  for (int ch = 0; ch < 4; ++ch) {
    u32 o[4];
#pragma unroll
    for (int j = 0; j < 4; ++j) {
      const int i0 = ch * 8 + 2 * j;
      const float k0 = (1.f - __expf(lf[i0])) * __expf(cs[31] - cs[i0] + after);
      const float k1 = (1.f - __expf(lf[i0 + 1])) * __expf(cs[31] - cs[i0 + 1] + after);
      o[j] = pack2(k0, k1);
    }
    const int chunk = hf * 4 + ch;
    *(u32x4*)(kts + d * 128 + ((chunk ^ ((d >> 1) & 7)) << 4)) = u32x4{o[0], o[1], o[2], o[3]};
  }
  __syncthreads();
  f32x16 acc[2][2];
  zero_acc<2>(acc);
  mma_tile<2, 2>(acc, vts, wm * 64, kts, wn * 64, lane);
  u16* us = (u16*)(p.ws + OFF_US) + (size_t)item * 16384;
#pragma unroll
  for (int mi = 0; mi < 2; ++mi)
#pragma unroll
    for (int ni = 0; ni < 2; ++ni)
#pragma unroll
      for (int r = 0; r < 16; ++r) {
        const int e = wm * 64 + mi * 32 + rowof(r, lane);
        const int dd = wn * 64 + ni * 32 + (lane & 31);
        us[e * 128 + dd] = f2bf(acc[mi][ni][r]);
      }
}

__device__ __forceinline__ void h2_item(const P& p, int item, int tid) {
  const int g = item * 256 + tid;
  const int bh = g >> 13, e = (g >> 6) & 127, dp = g & 63;
  float s0 = 0.f, s1 = 0.f;
  u32* us = (u32*)(p.ws + OFF_US) + (size_t)bh * 128 * 8192 + e * 64 + dp;
  const float2* gd = (const float2*)(p.ws + OFF_GDEC) + (size_t)bh * 128 * 64 + dp;
#pragma unroll 1
  for (int c0 = 0; c0 < 128; c0 += 16) {
    u32 u[16];
    float2 g2[16];
#pragma unroll
    for (int i = 0; i < 16; ++i) { u[i] = us[(size_t)(c0 + i) * 8192]; g2[i] = gd[(c0 + i) * 64]; }
#pragma unroll
    for (int i = 0; i < 16; ++i) {
      us[(size_t)(c0 + i) * 8192] = pack2(s0, s1);
      s0 = g2[i].x * s0 + bf2f((u16)(u[i] & 0xFFFF));
      s1 = g2[i].y * s1 + bf2f((u16)(u[i] >> 16));
    }
  }
}

__device__ __forceinline__ void h3_item(const P& p, int l, int item, char* smem, int tid) {
  const int lane = tid & 63, w = tid >> 6, h = lane >> 5, lr = lane & 31;
  const int b = item >> 9, hh = (item >> 7) & 3, c = item & 127;
  const int tok0 = b * SEQ + c * 64;
  const int d = tid & 127, hf = tid >> 7;
  char* R0 = smem;
  char* R1 = smem + 16384;
  char* R2 = smem + 32768;
  char* R3 = smem + 49152;
  float* tot = (float*)(smem + 65536);
  const u16* usb = (const u16*)(p.ws + OFF_US) + (size_t)item * 16384;
  u32x4 vr[4], s0r[4], s1r[4];
  g2r<128>(vr, (const u16*)(p.ws + OFF_HVT) + ((size_t)(b * 512 + hh * 128)) * 8192 + c * 64, 8192, tid);
  g2r<128>(s0r, usb, 128, tid);
  g2r<128>(s1r, usb + 64, 128, tid);
  float lf[32], cs[32], q[32];
  hgrn_load_cumsum(p, tok0, hh, d, hf, lf, cs);
  {
    const u16* qs = (const u16*)(p.ws + OFF_HQ) + (size_t)(tok0 + hf * 32) * 512 + hh * 128 + d;
#pragma unroll
    for (int i = 0; i < 32; ++i) q[i] = bf2f(qs[(size_t)i * 512]);
  }
  if (hf == 0) tot[d] = cs[31];
  r2s<128>(vr, R3, tid);
  r2s<128>(s0r, R2, tid);
  __syncthreads();
  const float t0 = tot[d];
#pragma unroll
  for (int i = 0; i < 32; ++i) {
    const int t = hf * 32 + i;
    const float rel = hf ? cs[i] : cs[i] - t0;
    put_td(R0, t, d, q[i] * __expf(rel));
    put_td(R1, t, d, (1.f - __expf(lf[i])) * __expf(-rel));
  }
  __syncthreads();
  {
    const int sb = w & 1, tb = w >> 1;
    f32x16 a1[1][1];
#pragma unroll
    for (int r = 0; r < 16; ++r) a1[0][0][r] = 0.f;
    if (sb <= tb) {
      mma_tile<1, 1>(a1, R1, sb * 32, R0, tb * 32, lane);
      mma_tile<1, 1>(a1, R1 + 8192, sb * 32, R0 + 8192, tb * 32, lane);
    }
    __syncthreads();
    const int t = tb * 32 + lr;
#pragma unroll
    for (int rg = 0; rg < 4; ++rg) {
      float v[4];
#pragma unroll
      for (int j = 0; j < 4; ++j) {
        const int s = sb * 32 + 8 * rg + 4 * h + j;
        v[j] = (s <= t) ? a1[0][0][rg * 4 + j] : 0.f;
      }
      const int s0 = sb * 32 + 8 * rg + 4 * h;
      *(u32x2*)(R1 + t * 128 + (((s0 >> 3) ^ ((t >> 1) & 7)) << 4) + (s0 & 7) * 2) =
          u32x2{pack2(v[0], v[1]), pack2(v[2], v[3])};
    }
#pragma unroll
    for (int i = 0; i < 32; ++i) {
      const int tt = hf * 32 + i;
      put_td(R0, tt, d, q[i] * __expf(hf ? cs[i] + t0 : cs[i]));
    }
  }
  __syncthreads();
  f32x16 o[1][2];
#pragma unroll
  for (int ni = 0; ni < 2; ++ni)
#pragma unroll
    for (int r = 0; r < 16; ++r) o[0][ni][r] = 0.f;
  mma_tile<1, 2>(o, R2, w * 32, R0, 0, lane);
  mma_tile<1, 2>(o, R3, w * 32, R1, 0, lane);
  __syncthreads();
  r2s<128>(s1r, R2, tid);
  __syncthreads();
  mma_tile<1, 2>(o, R2, w * 32, R0 + 8192, 0, lane);
  float* red = tot;
#pragma unroll
  for (int ni = 0; ni < 2; ++ni) {
    float ss = 0.f;
#pragma unroll
    for (int r = 0; r < 16; ++r) ss += o[0][ni][r] * o[0][ni][r];
    ss += __shfl_xor(ss, 32);
    if (h == 0) red[w * 64 + ni * 32 + lr] = ss;
  }
  __syncthreads();
#pragma unroll
  for (int ni = 0; ni < 2; ++ni) {
    const int t = ni * 32 + lr;
    const float ss = red[t] + red[64 + t] + red[128 + t] + red[192 + t];
    const float rn = rsqrtf(ss * (1.f / 128.f) + EPS);
    const size_t rowo = (size_t)(tok0 + t) * 512 + hh * 128;
#pragma unroll
    for (int rg = 0; rg < 4; ++rg) {
      const int e0 = w * 32 + 8 * rg + 4 * h;
      const u32x2 gg = *(const u32x2*)((const u16*)(p.ws + OFF_HG) + rowo + e0);
      const float4 nw = *(const float4*)(p.hn + l * 128 + e0);
      const float y0 = o[0][ni][rg * 4 + 0] * rn * nw.x * bf2f((u16)(gg.x & 0xFFFF));
      const float y1 = o[0][ni][rg * 4 + 1] * rn * nw.y * bf2f((u16)(gg.x >> 16));
      const float y2 = o[0][ni][rg * 4 + 2] * rn * nw.z * bf2f((u16)(gg.y & 0xFFFF));
      const float y3 = o[0][ni][rg * 4 + 3] * rn * nw.w * bf2f((u16)(gg.y >> 16));
      *(u32x2*)((u16*)(p.ws + OFF_YH) + rowo + e0) = u32x2{pack2(y0, y1), pack2(y2, y3)};
    }
  }
}

__device__ __forceinline__ size_t code_rowoff(int q) {
  const int g = q >> 7, r = q & 127;
  return (size_t)128 * ((size_t)64 * g * (g + 1) + (size_t)r * (g + 1));
}
__device__ __forceinline__ u32 tocode(float s) {
  u32 u = __float_as_uint(s);
  if ((u << 1) == 0) u = 0;
  u = (u & 0x80000000u) ? ~u : (u | 0x80000000u);
  u >>= 16;
  return u < 1 ? 1 : u;
}
__device__ __forceinline__ void b1_item(const P& p, int item, char* smem, int tid) {
  const int lane = tid & 63, w = tid >> 6, wm = w & 1, wn = w >> 1, lr = lane & 31;
  const int b = item >= 2080;
  int idx = item - b * 2080;
  int g = (int)((sqrtf(8.f * idx + 1.f) - 1.f) * 0.5f);
  while (g * (g + 1) / 2 > idx) --g;
  while ((g + 1) * (g + 2) / 2 <= idx) ++g;
  const int kt = idx - g * (g + 1) / 2;
  const int q0 = b * SEQ + g * 128, k0 = b * SEQ + kt * 128;
  char* ys = smem;
  char* xs = smem + 16384;
  float* wsm = (float*)(smem + 49152);
  const u16* IQ = (const u16*)(p.ws + OFF_IQ) + (size_t)q0 * 256;
  const u16* IK = (const u16*)(p.ws + OFF_IK) + (size_t)k0 * 64;
  u32x4 xr[4], yr[4];
  g2r<128>(yr, IK, 64, tid);
  g2r<128>(xr, IQ, 256, tid);
  if (tid < 128) *(float4*)(wsm + tid * 4) = *(const float4*)(p.ws + OFF_IW + (size_t)(q0 + tid) * 16);
  r2s<128>(yr, ys, tid);
  r2s<128>(xr, xs, tid);
  __syncthreads();
  f32x16 sc[2][2];
  zero_acc<2>(sc);
#pragma unroll 1
  for (int hd = 0; hd < 4; ++hd) {
    if (hd < 3) g2r<128>(xr, IQ + (hd + 1) * 64, 256, tid);
#pragma unroll
    for (int mi = 0; mi < 2; ++mi) {
      f32x16 acc[1][2];
#pragma unroll
      for (int ni = 0; ni < 2; ++ni)
#pragma unroll
        for (int r = 0; r < 16; ++r) acc[0][ni][r] = 0.f;
      mma_tile<1, 2>(acc, xs + (hd & 1) * 16384, wm * 64 + mi * 32, ys, wn * 64, lane);
#pragma unroll
      for (int r = 0; r < 16; ++r) {
        const float wv = wsm[(wm * 64 + mi * 32 + rowof(r, lane)) * 4 + hd];
#pragma unroll
        for (int ni = 0; ni < 2; ++ni) sc[mi][ni][r] += wv * fmaxf(acc[0][ni][r], 0.f);
      }
      __builtin_amdgcn_sched_barrier(0);
    }
    if (hd < 3) r2s<128>(xr, xs + ((hd + 1) & 1) * 16384, tid);
    __syncthreads();
  }
  u16* codes = (u16*)(p.ws + OFF_CODES) + (size_t)b * CODES_PER_BATCH;
  char* st = smem + 16384;
#pragma unroll
  for (int mi = 0; mi < 2; ++mi)
#pragma unroll
    for (int r = 0; r < 16; ++r) {
      const int ql = wm * 64 + mi * 32 + rowof(r, lane);
      const int q = g * 128 + ql;
#pragma unroll
      for (int ni = 0; ni < 2; ++ni) {
        const int kl = wn * 64 + ni * 32 + lr;
        const bool vis = (kt * 128 + kl) <= q;
        const u32 cd = vis ? tocode(sc[mi][ni][r]) : 0u;
        *(u16*)(st + ql * 256 + (2 * (ni * 32 + lr) + wn) * 2) = (u16)cd;
      }
    }
  __syncthreads();
  {
    u16* dst0 = codes + code_rowoff(g * 128) + kt * 128;
    const size_t rstride = (size_t)128 * (g + 1);
#pragma unroll
    for (int i = 0; i < 8; ++i) {
      const int cid = tid + 256 * i;
      const int row = cid >> 4, c = cid & 15;
      __builtin_nontemporal_store(*(const u32x4*)(st + row * 256 + c * 16), (u32x4*)(dst0 + (size_t)row * rstride + c * 8));
    }
  }
}

__device__ __forceinline__ int wave_isum(int c) {
#pragma unroll
  for (int o = 32; o >= 1; o >>= 1) c += __shfl_xor(c, o);
  return c;
}
__device__ __forceinline__ int count_ge(const u32 (&r)[64], int nj, u32 t) {
  const u16 tm1 = (u16)(t - 1);
  const u16x2 tv = {tm1, tm1};
  const u16x2 one = {1, 1};
  u16x2 acc = {0, 0};
#pragma unroll
  for (int jb = 0; jb < 8; ++jb) {
    if (jb * 8 < nj) {
#pragma unroll
      for (int jj = 0; jj < 8; ++jj) {
        u16x2 d = __builtin_elementwise_sub_sat(__builtin_bit_cast(u16x2, r[jb * 8 + jj]), tv);
        d = __builtin_elementwise_min(d, one);
        acc += d;
      }
    }
  }
  return wave_isum((int)acc.x + (int)acc.y);
}
__device__ __forceinline__ int snake_item(int k, int bid, int nb);
__device__ __forceinline__ void b2_load(const P& p, int item, int tid, u32 (&r)[64]) {
  const int lane = tid & 63, w = tid >> 6;
  const int Q = item * 4 + w;
  const int b = Q >> 13, q = Q & 8191;
  const int nj = (q >> 7) + 1;
  const u32* row = (const u32*)((const u16*)(p.ws + OFF_CODES) + (size_t)b * CODES_PER_BATCH + code_rowoff(q));
#pragma unroll
  for (int j = 0; j < 64; ++j) r[j] = (j < nj) ? __builtin_nontemporal_load(row + j * 64 + lane) : 0u;
}
__device__ __forceinline__ void b2_process(const P& p, int item, char* smem, int tid, const u32 (&r)[64]) {
  const int lane = tid & 63, w = tid >> 6;
  const int Q = item * 4 + w;
  const int q = Q & 8191;
  const int nj = (q >> 7) + 1;
  u16x2 m1 = {0, 0}, m2 = {0, 0};
#pragma unroll
  for (int jb = 0; jb < 8; ++jb) {
    if (jb * 8 < nj) {
#pragma unroll
      for (int jj = 0; jj < 8; ++jj) {
        const u16x2 x = __builtin_bit_cast(u16x2, r[jb * 8 + jj]);
        const u16x2 t = __builtin_elementwise_min(m1, x);
        m1 = __builtin_elementwise_max(m1, x);
        m2 = __builtin_elementwise_max(m2, t);
      }
    }
  }
  int L = min((int)m2.x, (int)m2.y), H = max((int)m1.x, (int)m1.y);
#pragma unroll
  for (int o = 32; o >= 1; o >>= 1) { L = min(L, __shfl_xor(L, o)); H = max(H, __shfl_xor(H, o)); }
  u32 T = 0;
  int need = 0;
  u32 lo = L < 1 ? 1u : (u32)L;
  if (lo > 1 || count_ge(r, nj, 1) >= 256) {
    const int R = H - (int)lo + 1;
    if (R <= 2048) {
      u32* hist = (u32*)(smem + w * 8192);
      const int nbl = (R + 63) >> 6;
      for (int i = 0; i < nbl; ++i) hist[i * 64 + lane] = 0u;
#pragma unroll
      for (int jb = 0; jb < 8; ++jb) {
        if (jb * 8 < nj) {
#pragma unroll
          for (int jj = 0; jj < 8; ++jj) {
            const u32 v = r[jb * 8 + jj];
            const u32 c0 = v & 0xFFFFu, c1 = v >> 16;
            if (c0 >= lo) atomicAdd(&hist[c0 - lo], 1u);
            if (c1 >= lo) atomicAdd(&hist[c1 - lo], 1u);
          }
        }
      }
      int sl = 0;
      for (int i = 0; i < nbl; ++i) sl += (int)hist[lane * nbl + i];
      int suf = sl;
#pragma unroll
      for (int d = 1; d <= 32; d <<= 1) {
        const int v = __shfl_down(suf, d);
        suf += (lane + d < 64) ? v : 0;
      }
      const u64 okm = __ballot(suf >= 256);
      const int istar = 63 - __builtin_clzll(okm);
      int cacc = suf - sl, tbin = 0, cgt = 0;
      bool found = false;
      for (int i = nbl - 1; i >= 0; --i) {
        const int hc = (int)hist[lane * nbl + i];
        if (!found && cacc + hc >= 256) { found = true; tbin = lane * nbl + i; cgt = cacc; }
        cacc += hc;
      }
      tbin = __shfl(tbin, istar);
      cgt = __shfl(cgt, istar);
      T = lo + (u32)tbin;
      need = 256 - cgt;
    } else {
      u32 hi = (u32)H + 1u;
      while (hi - lo > 1) {
        const u32 mid = (lo + hi) >> 1;
        if (count_ge(r, nj, mid) >= 256) lo = mid; else hi = mid;
      }
      T = lo;
      const int cgt = (T >= 65535u) ? 0 : count_ge(r, nj, T + 1);
      need = 256 - cgt;
    }
  }
  int mlo[2] = {0, 0}, mhi[2] = {0, 0};
  const u32 thi = (T << 16) | 0xFFFFu;
#pragma unroll
  for (int j = 0; j < 64; ++j) {
    if (j < nj) {
#pragma unroll
      for (int hfw = 0; hfw < 2; ++hfw) {
        const u32 cd = hfw ? (r[j] >> 16) : (r[j] & 0xFFFFu);
        u64 word = hfw ? __ballot(r[j] > thi) : __ballot(cd > T);
        if (T > 0 && need > 0) {
          const bool eq = cd == T;
          const u64 eqm = __ballot(eq);
          if (eqm != 0) {
            const int rank = __builtin_amdgcn_mbcnt_hi((u32)(eqm >> 32), __builtin_amdgcn_mbcnt_lo((u32)eqm, 0));
            word |= __ballot(eq && rank < need);
            need -= __popcll(eqm);
          }
        }
        const int widx = 2 * j + hfw;
        if (lane == (widx & 63)) { mlo[widx >> 6] = (int)(u32)word; mhi[widx >> 6] = (int)(u32)(word >> 32); }
      }
    }
  }
  u32x2* mrow = (u32x2*)(p.ws + OFF_MASK + (size_t)Q * 1024);
#pragma unroll
  for (int k = 0; k < 2; ++k)
    if (lane + 64 * k < 2 * nj) mrow[lane + 64 * k] = u32x2{(u32)mlo[k], (u32)mhi[k]};
}

__device__ __forceinline__ void b2_phase(const P& p, int bid, int nb, char* smem, int tid) {
  const int rounds = (4096 + nb - 1) / nb;
  u32 ra[64], rb[64];
  int ia = snake_item(0, bid, nb);
  if (ia < 4096) b2_load(p, ia, tid, ra);
#pragma unroll 1
  for (int k = 0; k < rounds; k += 2) {
    const int ib = (k + 1 < rounds) ? snake_item(k + 1, bid, nb) : 4096;
    if (ib < 4096) b2_load(p, ib, tid, rb);
    if (ia < 4096) b2_process(p, ia, smem, tid, ra);
    ia = (k + 2 < rounds) ? snake_item(k + 2, bid, nb) : 4096;
    if (ia < 4096) b2_load(p, ia, tid, ra);
    if (ib < 4096) b2_process(p, ib, smem, tid, rb);
  }
}

__device__ __forceinline__ void b3_item(const P& p, int l, int item, char* smem, int tid) {
  const int lane = tid & 63, w = tid >> 6, h = lane >> 5, lr = lane & 31;
  const int g = 63 - (item >> 4), rem = item & 15, b = rem >> 3, head = rem & 7;
  const int q0 = g * 128;
  const int nkt = 2 * g + 2;
  const u16* AK = (const u16*)(p.ws + OFF_AK) + (size_t)b * SEQ * 512 + head * 64;
  const u16* AVT = (const u16*)(p.ws + OFF_AVT) + ((size_t)(b * 512 + head * 64)) * 8192;
  const u64* MK = (const u64*)(p.ws + OFF_MASK) + (size_t)(b * SEQ + q0) * 128;
  bf16x8 qf[4];
  {
    const u16* qrow = (const u16*)(p.ws + OFF_AQ) + (size_t)(b * SEQ + q0 + w * 32 + lr) * 512 + head * 64;
#pragma unroll
    for (int ks = 0; ks < 4; ++ks) qf[ks] = *(const bf16x8*)(qrow + ks * 16 + 8 * h);
  }
  u32x4 kr[2], vr[2];
  u64 mr = 0;
  g2r<64>(kr, AK, 512, tid);
  g2r<64>(vr, AVT, 8192, tid);
  if (tid < 128) mr = MK[(size_t)tid * 128];
  r2s<64>(kr, smem, tid);
  r2s<64>(vr, smem + 8192, tid);
  if (tid < 128) *(u64*)(smem + 16384 + tid * 8) = mr;
  __syncthreads();
  f32x16 oacc[2];
#pragma unroll
  for (int i = 0; i < 2; ++i)
#pragma unroll
    for (int r = 0; r < 16; ++r) oacc[i][r] = 0.f;
  float mrun = -5e29f, lrun = 0.f;
  float mq = fabsf(p.qn[l * 64 + lane]), mk = fabsf(p.kn[l * 64 + lane]);
#pragma unroll
  for (int o = 32; o >= 1; o >>= 1) { mq = fmaxf(mq, __shfl_xor(mq, o)); mk = fmaxf(mk, __shfl_xor(mk, o)); }
  const bool fast = (0.125f * 1.4426950408889634f * 64.f * 1.03f) * mq * mk + 1.f < 60.f;
  for (int kt = 0; kt < nkt; ++kt) {
    const char* buf = smem + (kt & 1) * 17408;
    char* nbuf = smem + ((kt + 1) & 1) * 17408;
    if (kt + 1 < nkt) {
      g2r<64>(kr, AK + (size_t)(kt + 1) * 64 * 512, 512, tid);
      g2r<64>(vr, AVT + (kt + 1) * 64, 8192, tid);
      if (tid < 128) mr = MK[(size_t)tid * 128 + kt + 1];
    }
    const u64 m64 = *(const u64*)(buf + 16384 + (w * 32 + lr) * 8);
    const u64 msh = ~(m64 >> (4 * h));
    const int w0 = (int)(u32)msh, w1 = (int)(u32)(msh >> 32);
    f32x16 s[2];
#pragma unroll
    for (int kb = 0; kb < 2; ++kb) {
#pragma unroll
      for (int r = 0; r < 16; ++r)
        s[kb][r] = __int_as_float(__builtin_amdgcn_sbfe(kb ? w1 : w0, (r & 3) + 8 * (r >> 2), 1) & (int)0xF149F2CAu);
#pragma unroll
      for (int ks = 0; ks < 4; ++ks)
        s[kb] = __builtin_amdgcn_mfma_f32_32x32x16_bf16(lds_frag(buf, kb * 32 + lr, ks * 2 + h), qf[ks], s[kb], 0, 0, 0);
    }
    float psum = 0.f;
    if (fast) {
#pragma unroll
      for (int kb = 0; kb < 2; ++kb)
#pragma unroll
        for (int r = 0; r < 16; ++r) {
          const float pv = __builtin_amdgcn_exp2f(s[kb][r]);
          s[kb][r] = pv;
          psum += pv;
        }
    } else {
      float tmax = s[0][0];
#pragma unroll
      for (int kb = 0; kb < 2; ++kb)
#pragma unroll
        for (int r = 0; r < 16; ++r) tmax = fmaxf(tmax, s[kb][r]);
      tmax = fmaxf(tmax, __shfl_xor(tmax, 32));
      if (__any(tmax > mrun)) {
        const float mnew = fmaxf(mrun, tmax);
        const float alpha = __builtin_amdgcn_exp2f(mrun - mnew);
        mrun = mnew;
        lrun *= alpha;
#pragma unroll
        for (int i = 0; i < 2; ++i)
#pragma unroll
          for (int r = 0; r < 16; ++r) oacc[i][r] *= alpha;
      }
#pragma unroll
      for (int kb = 0; kb < 2; ++kb)
#pragma unroll
        for (int r = 0; r < 16; ++r) {
          const float pv = __builtin_amdgcn_exp2f(s[kb][r] - mrun);
          s[kb][r] = pv;
          psum += pv;
        }
    }
    lrun += psum;
    const char* vt = buf + 8192;
#pragma unroll
    for (int kb = 0; kb < 2; ++kb)
#pragma unroll
      for (int s2 = 0; s2 < 2; ++s2) {
        union { bf16x8 v; u32 u[4]; } pf;
#pragma unroll
        for (int j = 0; j < 4; ++j) pf.u[j] = pack2(s[kb][8 * s2 + 2 * j], s[kb][8 * s2 + 2 * j + 1]);
#pragma unroll
        for (int db = 0; db < 2; ++db) {
          const int drow = db * 32 + lr;
          const int ch = kb * 4 + 2 * s2;
          const int sw = (drow >> 1) & 7;
          union { bf16x8 v; u32x2 u[2]; } vf;
          vf.u[0] = *(const u32x2*)(vt + drow * 128 + ((ch ^ sw) << 4) + 8 * h);
          vf.u[1] = *(const u32x2*)(vt + drow * 128 + (((ch + 1) ^ sw) << 4) + 8 * h);
          oacc[db] = __builtin_amdgcn_mfma_f32_32x32x16_bf16(vf.v, pf.v, oacc[db], 0, 0, 0);
        }
      }
    if (kt + 1 < nkt) {
      r2s<64>(kr, nbuf, tid);
      r2s<64>(vr, nbuf + 8192, tid);
      if (tid < 128) *(u64*)(nbuf + 16384 + tid * 8) = mr;
    }
    __syncthreads();
  }
  lrun += __shfl_xor(lrun, 32);
  const float inv = 1.f / lrun;
  u16* yrow = (u16*)(p.ws + OFF_YA) + (size_t)(b * SEQ + q0 + w * 32 + lr) * 512 + head * 64;
#pragma unroll
  for (int db = 0; db < 2; ++db)
#pragma unroll
    for (int rg = 0; rg < 4; ++rg) {
      const int d0 = db * 32 + 8 * rg + 4 * h;
      *(u32x2*)(yrow + d0) = u32x2{pack2(oacc[db][rg * 4] * inv, oacc[db][rg * 4 + 1] * inv),
                                   pack2(oacc[db][rg * 4 + 2] * inv, oacc[db][rg * 4 + 3] * inv)};
    }
}

__device__ __forceinline__ void d1_item(const P& p, int l, int mt, int nt, char* smem, int tid) {
  const int lane = tid & 63, w = tid >> 6, wm = w & 1, wn = w >> 1, lr = lane & 31;
  const int m0 = mt * 128, n0 = nt * 64;
  float* rs = (float*)(smem + 65536);
  const float* rowss = (const float*)(p.ws + OFF_ROWSS);
  if (tid < 128) rs[tid] = row_rstd(rowss, m0 + tid);
  const u16* XB = (const u16*)(p.ws + OFF_XB) + (size_t)m0 * 1024;
  f32x16 ag[2][2];
  zero_acc<2>(ag);
  gemm_loop<128, 2>(ag, XB, 1024, (const u16*)(p.ws + OFF_WGATE) + (size_t)nt * 128 * 1024, 1024, 16, smem, tid);
#pragma unroll
  for (int mi = 0; mi < 2; ++mi)
#pragma unroll
    for (int r = 0; r < 16; ++r) {
      const float rstd = rs[wm * 64 + mi * 32 + rowof(r, lane)];
      ag[mi][0][r] = sigmoidf_(ag[mi][0][r] * rstd);
      ag[mi][1][r] = sigmoidf_(ag[mi][1][r] * rstd);
    }
  f32x16 res[2][1], ap[2][1];
#pragma unroll
  for (int br = 0; br < 2; ++br) {
    zero_acc<1>(ap);
    const u16* Y = (const u16*)(p.ws + (br ? OFF_YH : OFF_YA)) + (size_t)m0 * 512;
    const u16* WP = (const u16*)(p.ws + (br ? OFF_WPH : OFF_WPA)) + (size_t)n0 * 512;
    gemm_loop<64, 1>(ap, Y, 512, WP, 512, 8, smem, tid);
#pragma unroll
    for (int mi = 0; mi < 2; ++mi)
#pragma unroll
      for (int r = 0; r < 16; ++r) {
        const float v = ag[mi][br][r] * ap[mi][0][r];
        res[mi][0][r] = br ? res[mi][0][r] + v : v;
      }
  }
  u16* M = (u16*)(p.ws + OFF_MERGED);
#pragma unroll
  for (int mi = 0; mi < 2; ++mi)
#pragma unroll
    for (int r = 0; r < 16; ++r) {
      const int tok = m0 + wm * 64 + mi * 32 + rowof(r, lane);
      M[(size_t)tok * 1024 + n0 + wn * 32 + lr] = f2bf(res[mi][0][r]);
    }
}

__device__ __forceinline__ void resid_item(const P& p, const u16* A, int K, const u16* W, float* rowss_next, int mt, int nt, char* smem,
                           int tid) {
  const int lane = tid & 63, w = tid >> 6, wm = w & 1, wn = w >> 1, lr = lane & 31;
  const int m0 = mt * 128, n0 = nt * 128;
  f32x16 acc[2][2];
  zero_acc<2>(acc);
  gemm_loop<128, 2>(acc, A + (size_t)m0 * K, K, W + (size_t)n0 * K, K, K >> 6, smem, tid);
  u16* XB = (u16*)(p.ws + OFF_XB);
  float myss = 0.f;
  int mytok = 0;
#pragma unroll
  for (int mi = 0; mi < 2; ++mi)
#pragma unroll
    for (int r = 0; r < 16; ++r) {
      const int tok = m0 + wm * 64 + mi * 32 + rowof(r, lane);
      float ss = 0.f;
#pragma unroll
      for (int ni = 0; ni < 2; ++ni) {
        const size_t o = (size_t)tok * 1024 + n0 + wn * 64 + ni * 32 + lr;
        const float xn = p.out[o] + acc[mi][ni][r];
        p.out[o] = xn;
        XB[o] = f2bf(xn);
        ss += xn * xn;
      }
#pragma unroll
      for (int of = 16; of >= 1; of >>= 1) ss += __shfl_xor(ss, of);
      if (lr == mi * 16 + r) { myss = ss; mytok = tok; }
      __builtin_amdgcn_sched_barrier(0);
    }
  rowss_next[(size_t)mytok * 16 + nt * 2 + wn] = myss;
}

__device__ __forceinline__ void e_item(const P& p, int l, int mt, int nt, char* smem, int tid) {
  const int lane = tid & 63, w = tid >> 6, wm = w & 1, wn = w >> 1, lr = lane & 31;
  const int m0 = mt * 128;
  float* rs = (float*)(smem + 65536);
  const float* rowss = (const float*)(p.ws + OFF_ROWSS) + (size_t)NTOK * 16;
  if (tid < 128) rs[tid] = row_rstd(rowss, m0 + tid);
  f32x16 acc[2][2];
  zero_acc<2>(acc);
  gemm_loop<128, 2>(acc, (const u16*)(p.ws + OFF_XB) + (size_t)m0 * 1024, 1024,
                    (const u16*)(p.ws + OFF_WFFI) + (size_t)nt * 128 * 1024, 1024, 16, smem, tid);
  u16* ACT = (u16*)(p.ws + OFF_ACT);
#pragma unroll
  for (int mi = 0; mi < 2; ++mi)
#pragma unroll
    for (int r = 0; r < 16; ++r) {
      const int tl = wm * 64 + mi * 32 + rowof(r, lane);
      const float rstd = rs[tl];
      const float gv = acc[mi][0][r] * rstd, uv = acc[mi][1][r] * rstd;
      ACT[(size_t)(m0 + tl) * DFF + nt * 64 + wn * 32 + lr] = f2bf(siluf_(gv) * uv);
    }
}

#ifndef ONLY_S
#define ONLY_S -1
#endif
#define EN(k) (ONLY_S < 0 || ONLY_S == (k))
template <class F>
__device__ __forceinline__ void for_tiles(int NT, int bid, int nb, F f) {
  if ((nb & 63) == 0) {
    const int vx = bid & 7, j = bid >> 3, JN = nb >> 6;
    const int jm = j & 7, jn = j >> 3;
    const int NG = (NT + JN - 1) / JN;
    const int wl = NT - (NG - 1) * JN;
    const bool fold = (wl * 2 == JN);
    const int NGF = fold ? NG - 1 : NG;
    for (int r = 0; r < 2 * NGF; ++r) {
      const int mh = r / NGF, ng = r - mh * NGF;
      const int mt = vx * 16 + mh * 8 + jm, nt = ng * JN + jn;
      if (nt < NT) f(mt, nt);
    }
    if (fold) f(vx * 16 + (jn / wl) * 8 + jm, (NG - 1) * JN + (jn % wl));
  } else {
    for (int it = bid; it < 128 * NT; it += nb) f(it / NT, it % NT);
  }
}
__device__ __forceinline__ int snake_item(int k, int bid, int nb) {
  return (k & 1) ? (((k + 1) * nb - 1 - bid) ^ 7) : (k * nb + bid);
}

__device__ __forceinline__ void run_phase(const P& p, int ph, char* smem) {
  int tid0 = threadIdx.x;
  asm volatile("" : "+v"(tid0));
  const int nb = gridDim.x;
  int bid = blockIdx.x;
  asm volatile("" : "+s"(bid));
#define LAUNDER int tid = tid0; asm volatile("" : "+v"(tid)); __syncthreads();
  if (ph == 0) {
    if (EN(11)) for (int it = bid; it < 4096 + 4128; it += nb) { LAUNDER
      if (it < 4096) p0_rows(p, it, tid); else conv_item(p, 0, it - 4096, smem, tid);
    }
    return;
  }
  const int l = (ph - 1) / 11, s = (ph - 1) % 11;
  float* rowss = (float*)(p.ws + OFF_ROWSS);
  switch (s) {
    case 0: if (EN(0)) {
      for_tiles(31, bid, nb, [&](int mt, int nt) { LAUNDER phaseA_tile(p, l, mt, nt, smem, tid); });
      if (l > 0) for (int it = bid; it < 704; it += nb) { LAUNDER conv_item(p, l, 3424 + it, smem, tid); }
    } break;
    case 1: if (EN(1)) for (int it = bid; it < 1024; it += nb) { LAUNDER h1_item(p, it, smem, tid); } break;
    case 2: if (EN(2)) for (int it = bid; it < 256; it += nb) { LAUNDER h2_item(p, it, tid); } break;
    case 3: if (EN(3)) for (int it = bid; it < 1024; it += nb) { LAUNDER h3_item(p, l, it, smem, tid); } break;
    case 4: if (EN(4)) for (int it = bid; it < 4160; it += nb) { LAUNDER b1_item(p, it, smem, tid); } break;
    case 5: if (EN(5)) { int tid = tid0; asm volatile("" : "+v"(tid)); b2_phase(p, bid, nb, smem, tid); } break;
    case 6: if (EN(6)) for (int k = 0; k * nb < 1024; ++k) { const int it = snake_item(k, bid, nb); if (it < 1024) { LAUNDER b3_item(p, l, it, smem, tid); } } break;
    case 7: if (EN(7)) for_tiles(16, bid, nb, [&](int mt, int nt) { LAUNDER d1_item(p, l, mt, nt, smem, tid); }); break;
    case 8:
      if (EN(8)) for_tiles(8, bid, nb, [&](int mt, int nt) { LAUNDER
        resid_item(p, (const u16*)(p.ws + OFF_MERGED), 1024, (const u16*)(p.ws + OFF_WOUT), rowss + (size_t)NTOK * 16, mt, nt, smem, tid); });
      break;
    case 9: if (EN(9)) for_tiles(44, bid, nb, [&](int mt, int nt) { LAUNDER e_item(p, l, mt, nt, smem, tid); }); break;
    case 10: if (EN(10)) {
      for_tiles(8, bid, nb, [&](int mt, int nt) { LAUNDER
        resid_item(p, (const u16*)(p.ws + OFF_ACT), DFF, (const u16*)(p.ws + OFF_WFFO), rowss, mt, nt, smem, tid); });
      if (l < 3) for (int it = bid; it < 3424; it += nb) { LAUNDER conv_item(p, l + 1, it, smem, tid); }
    } break;
  }
#undef LAUNDER
}

constexpr int NPHASE = 1 + 11 * DEPTH;

#ifndef REP_MASK
#define REP_MASK 0
#endif
#define XB_TMO      128
#define XB_XCNT(j)  (256  + 64 * (j))
#define XB_XSUB(j)  (1280 + 64 * (j))
#define XB_XGEN(j)  (2304 + 64 * (j))
#define XB_TOP      3328
#define XB_TOPGEN   3392
#define XCD_BAR_WORDS 3456
#define XB_SPIN_CAP (1u << 18)
#define LAS __attribute__((address_space(3)))

__device__ __forceinline__ unsigned xb_ld(unsigned* p)              { return __hip_atomic_load(p, __ATOMIC_RELAXED, __HIP_MEMORY_SCOPE_AGENT); }
__device__ __forceinline__ unsigned xb_add(unsigned* p, unsigned v) { return __hip_atomic_fetch_add(p, v, __ATOMIC_RELAXED, __HIP_MEMORY_SCOPE_AGENT); }
__device__ __forceinline__ unsigned xb_xcc_id() { return (unsigned)__builtin_amdgcn_s_getreg((3 << 11) | 20) & 0xFu; }
#define XB_SPIN(cond, bar) do { unsigned _sp = 0; while (cond) { __builtin_amdgcn_s_sleep(1); \
    if ((++_sp & 255u) == 0u) { if (xb_ld(&(bar)[XB_TMO])) break; if (_sp > XB_SPIN_CAP) { atomicAdd(&(bar)[XB_TMO], 1u); break; } } } } while (0)

struct XcdBarrier {
    unsigned* bar; unsigned x;
    volatile LAS unsigned* st;
};

__device__ __forceinline__ XcdBarrier xcd_barrier_post(unsigned* bar, volatile LAS unsigned* st) {
    XcdBarrier b; b.bar = bar; b.x = xb_xcc_id(); b.st = st;
    if (threadIdx.x == 0) (void)xb_add(&bar[XB_XCNT(b.x)], 1u);
    return b;
}
__device__ __forceinline__ void xcd_barrier_complete(unsigned* bar, unsigned x, unsigned& nloc, unsigned& nx) {
    const unsigned G = gridDim.x * gridDim.y * gridDim.z;
    unsigned sum, cnt, mine, sp = 0u;
    for (;;) {
        sum = 0u; cnt = 0u; mine = 0u;
#pragma unroll
        for (unsigned j = 0; j < 16; ++j) { const unsigned c = xb_ld(&bar[XB_XCNT(j)]); sum += c; cnt += (c > 0u) ? 1u : 0u; mine = (j == x) ? c : mine; }
        if (sum == G) break;
        __builtin_amdgcn_s_sleep(1);
        if ((++sp & 255u) == 0u) { if (xb_ld(&bar[XB_TMO])) break; if (sp > XB_SPIN_CAP) { atomicAdd(&bar[XB_TMO], 1u); break; } }
    }
    nloc = mine > 0u ? mine : 1u; nx = cnt > 0u ? cnt : 1u;
}

__device__ __forceinline__ void xcd_barrier(const XcdBarrier& b) {
    asm volatile("s_waitcnt vmcnt(0)" ::: "memory");
    __syncthreads();
    if (threadIdx.x == 0) {
        unsigned* bar = b.bar;
        __builtin_amdgcn_s_waitcnt(0);
        unsigned nloc = b.st[0], nx = b.st[1];
        if (nloc == 0u) { xcd_barrier_complete(bar, b.x, nloc, nx); b.st[0] = nloc; b.st[1] = nx; }
        const unsigned old = xb_add(&bar[XB_XSUB(b.x)], 1u);
        const unsigned gen = old / nloc;
        if (old + 1u == (gen + 1u) * nloc) {
            __builtin_amdgcn_fence(__ATOMIC_RELEASE, "agent");
            asm volatile("s_waitcnt vmcnt(0)" ::: "memory");
            const unsigned og = xb_add(&bar[XB_TOP], 1u);
            const unsigned tg = og / nx;
            if (og + 1u == (tg + 1u) * nx) xb_add(&bar[XB_TOPGEN], 1u);
            else XB_SPIN(xb_ld(&bar[XB_TOPGEN]) == tg, bar);
            __builtin_amdgcn_fence(__ATOMIC_ACQUIRE, "agent");
            xb_add(&bar[XB_XGEN(b.x)], 1u);
            asm volatile("s_waitcnt vmcnt(0)" ::: "memory");
        } else {
            XB_SPIN(xb_ld(&bar[XB_XGEN(b.x)]) == gen, bar);
            __builtin_amdgcn_fence(__ATOMIC_ACQUIRE, "agent");
            asm volatile("s_waitcnt vmcnt(0)" ::: "memory");
        }
    }
    __syncthreads();
}


template <bool COOP>
__global__ void __launch_bounds__(256, 2) mega(P p, int ph0, int ph1) {
  __shared__ __attribute__((aligned(16))) char smem[66560];
  __shared__ uint4 xb_words;
  if (threadIdx.x == 0) xb_words = make_uint4(0u, 0u, 0u, 0u);
  __syncthreads();
  XcdBarrier xb = xcd_barrier_post((unsigned*)(p.ws + OFF_BAR), (volatile LAS unsigned*)&xb_words);
  for (int ph = ph0; ph < ph1; ++ph) {
    int reps = 1;
    if (REP_MASK != 0 && ph > 0 && ((REP_MASK >> ((ph - 1) % 11)) & 1)) reps = 2;
    for (int rp = 0; rp < reps; ++rp) {
      run_phase(p, ph, smem);
      if (COOP) {
        if (ph + 1 < ph1 || rp + 1 < reps) {
          if (ph == 0) cg::this_grid().sync();
          else xcd_barrier(xb);
        }
      }
    }
  }
}

extern "C" void kernel_launch(void* const* d_in, const int* in_sizes, int n_in, void* d_out, int out_size, void* d_ws,
                              size_t ws_size, hipStream_t stream) {
  if (ws_size < WS_END) { fprintf(stderr, "workspace too small: %zu\n", ws_size); return; }
  P p{};
  p.x = (const float*)d_in[0]; p.pos = (const int*)d_in[1]; p.w_in = (const float*)d_in[2];
  p.w_pa = (const float*)d_in[3]; p.w_ph = (const float*)d_in[4]; p.w_out = (const float*)d_in[5];
  p.nmix = (const float*)d_in[6]; p.nffn = (const float*)d_in[7]; p.qn = (const float*)d_in[8];
  p.kn = (const float*)d_in[9]; p.hn = (const float*)d_in[10]; p.hlb = (const float*)d_in[11];
  p.w_ffi = (const float*)d_in[12]; p.w_ffo = (const float*)d_in[13];
  p.out = (float*)d_out; p.ws = (char*)d_ws;
#if COOP_MODE
  static int grid_blocks = 0;
  if (!grid_blocks) {
    int dev = 0, cus = 0, per_cu = 0;
    hipGetDevice(&dev);
    hipDeviceGetAttribute(&cus, hipDeviceAttributeMultiprocessorCount, dev);
    hipOccupancyMaxActiveBlocksPerMultiprocessor(&per_cu, mega<true>, 256, 0);
    if (per_cu > 2) per_cu = 2;
    grid_blocks = cus * per_cu;
  }
  int ph0 = 0, ph1 = NPHASE;
  hipMemsetAsync((char*)d_ws + OFF_BAR, 0, 16384, stream);
  void* args[] = {&p, &ph0, &ph1};
  hipError_t e = hipLaunchCooperativeKernel((void*)mega<true>, dim3(grid_blocks), dim3(256), args, 0, stream);
  if (e != hipSuccess) fprintf(stderr, "cooperative launch failed: %s (grid %d)\n", hipGetErrorString(e), grid_blocks);
#else
  for (int ph = 0; ph < NPHASE; ++ph) mega<false><<<dim3(512), dim3(256), 0, stream>>>(p, ph, ph + 1);
#endif
}
```

```cpp
#include <hip/hip_runtime.h>
#include <hip/hip_cooperative_groups.h>
#include <stdint.h>
#include <stdio.h>
namespace cg = cooperative_groups;

#ifndef COOP_MODE
#define COOP_MODE 1
#endif

typedef unsigned short u16;
typedef unsigned int u32;
typedef unsigned long long u64;
typedef __attribute__((ext_vector_type(8))) short bf16x8;
typedef __attribute__((ext_vector_type(16))) float f32x16;
typedef __attribute__((ext_vector_type(4))) u32 u32x4;
typedef __attribute__((ext_vector_type(2))) u32 u32x2;
typedef __attribute__((ext_vector_type(2))) unsigned short u16x2;

constexpr int NTOK = 16384, SEQ = 8192, DEPTH = 4;
constexpr int DFF = 2816;
constexpr float EPS = 1e-6f;
constexpr size_t MiB = (size_t)1 << 20;
constexpr size_t OFF_WIN = 0, OFF_WGATE = 8 * MiB, OFF_WPA = 12 * MiB, OFF_WPH = 13 * MiB, OFF_WOUT = 14 * MiB,
                 OFF_WFFI = 16 * MiB, OFF_WFFO = 27 * MiB, OFF_AQ = 33 * MiB, OFF_AK = 49 * MiB, OFF_AVT = 65 * MiB,
                 OFF_IQ = 81 * MiB, OFF_IK = 89 * MiB, OFF_IW = 91 * MiB, OFF_HQ = 92 * MiB, OFF_HVT = 108 * MiB,
                 OFF_HG = 124 * MiB, OFF_LOGF = 140 * MiB, OFF_XB = 172 * MiB, OFF_YH = 204 * MiB, OFF_MASK = 220 * MiB,
                 OFF_ROWSS = 236 * MiB, OFF_CODES = 238 * MiB, OFF_YA = OFF_CODES, OFF_US = OFF_CODES,
                 OFF_GDEC = OFF_CODES + 32 * MiB, OFF_MERGED = OFF_AQ, OFF_ACT = OFF_AQ, OFF_BAR = 32 * MiB + 768 * 1024, WS_END = 368 * MiB;
constexpr size_t CODES_PER_BATCH = (size_t)16384 * 2080;

struct P {
  const float* x; const int* pos; const float* w_in; const float* w_pa; const float* w_ph; const float* w_out;
  const float* nmix; const float* nffn; const float* qn; const float* kn; const float* hn; const float* hlb;
  const float* w_ffi; const float* w_ffo; float* out; char* ws;
};

__device__ __forceinline__ u16 f2bf(float f) {
  u32 u = __float_as_uint(f);
  u += 0x7FFFu + ((u >> 16) & 1u);
  return (u16)(u >> 16);
}
__device__ __forceinline__ float bf2f(u16 v) { return __uint_as_float(((u32)v) << 16); }
__device__ __forceinline__ u32 pack2(float a, float b) { u32 r; asm("v_cvt_pk_bf16_f32 %0, %1, %2" : "=v"(r) : "v"(a), "v"(b)); return r; }
__device__ __forceinline__ float wave_sum(float v) {
#pragma unroll
  for (int o = 32; o >= 1; o >>= 1) v += __shfl_xor(v, o);
  return v;
}
__device__ __forceinline__ float sigmoidf_(float x) { return 1.f / (1.f + __expf(-x)); }
__device__ __forceinline__ float siluf_(float x) { return x / (1.f + __expf(-x)); }

template <int ROWS>
__device__ __forceinline__ void g2r(u32x4 (&r)[ROWS / 32], const u16* g, size_t ld, int tid) {
  const int c = tid & 7, row = tid >> 3;
#pragma unroll
  for (int i = 0; i < ROWS / 32; ++i) r[i] = *(const u32x4*)(g + (size_t)(row + 32 * i) * ld + c * 8);
}
template <int ROWS>
__device__ __forceinline__ void r2s(const u32x4 (&r)[ROWS / 32], char* s, int tid) {
  const int c = tid & 7, row = tid >> 3;
#pragma unroll
  for (int i = 0; i < ROWS / 32; ++i) {
    const int rr = row + 32 * i;
    *(u32x4*)(s + rr * 128 + ((c ^ ((rr >> 1) & 7)) << 4)) = r[i];
  }
}
__device__ __forceinline__ bf16x8 lds_frag(const char* s, int row, int kc) {
  return *(const bf16x8*)(s + row * 128 + ((kc ^ ((row >> 1) & 7)) << 4));
}
__device__ __forceinline__ int rowof(int reg, int lane) { return (reg & 3) + 8 * (reg >> 2) + 4 * (lane >> 5); }

template <int MI, int NI>
__device__ __forceinline__ void mma_tile(f32x16 (&acc)[MI][NI], const char* xs, int xrow0, const char* ys, int yrow0,
                                         int lane) {
  const int r = lane & 31, h = lane >> 5;
  bf16x8 a[2][MI], b[2][NI];
#pragma unroll
  for (int mi = 0; mi < MI; ++mi) a[0][mi] = lds_frag(xs, xrow0 + mi * 32 + r, h);
#pragma unroll
  for (int ni = 0; ni < NI; ++ni) b[0][ni] = lds_frag(ys, yrow0 + ni * 32 + r, h);
#pragma unroll
  for (int ks = 0; ks < 4; ++ks) {
    const int c = ks & 1, n = c ^ 1;
    if (ks < 3) {
#pragma unroll
      for (int mi = 0; mi < MI; ++mi) a[n][mi] = lds_frag(xs, xrow0 + mi * 32 + r, (ks + 1) * 2 + h);
#pragma unroll
      for (int ni = 0; ni < NI; ++ni) b[n][ni] = lds_frag(ys, yrow0 + ni * 32 + r, (ks + 1) * 2 + h);
    }
    __builtin_amdgcn_sched_barrier(0);
#pragma unroll
    for (int mi = 0; mi < MI; ++mi)
#pragma unroll
      for (int ni = 0; ni < NI; ++ni)
        acc[mi][ni] = __builtin_amdgcn_mfma_f32_32x32x16_bf16(a[c][mi], b[c][ni], acc[mi][ni], 0, 0, 0);
    __builtin_amdgcn_sched_barrier(0);
  }
}

template <int YR, int NI>
__device__ __forceinline__ void gemm_loop_shallow(f32x16 (&acc)[2][NI], const u16* X, size_t ldx, const u16* Y, size_t ldy,
                                          int KT, char* smem, int tid) {
  const int lane = tid & 63, w = tid >> 6, wm = w & 1, wn = w >> 1;
  char* xs = smem;
  char* ys = smem + 32768;
  u32x4 xr[4], yr[YR / 32];
  g2r<128>(xr, X, ldx, tid);
  g2r<YR>(yr, Y, ldy, tid);
  r2s<128>(xr, xs, tid);
  r2s<YR>(yr, ys, tid);
  __syncthreads();
#pragma unroll 1
  for (int kt = 0; kt < KT; ++kt) {
    const int cur = kt & 1;
    if (kt + 1 < KT) {
      g2r<128>(xr, X + (size_t)(kt + 1) * 64, ldx, tid);
      g2r<YR>(yr, Y + (size_t)(kt + 1) * 64, ldy, tid);
    }
    mma_tile<2, NI>(acc, xs + cur * 16384, wm * 64, ys + cur * (YR * 128), wn * 32 * NI, lane);
    if (kt + 1 < KT) {
      r2s<128>(xr, xs + (cur ^ 1) * 16384, tid);
      r2s<YR>(yr, ys + (cur ^ 1) * (YR * 128), tid);
    }
    __syncthreads();
  }
}
template <int YR, int NI>
__device__ __forceinline__ void gemm_loop_deep(f32x16 (&acc)[2][NI], const u16* X, size_t ldx, const u16* Y, size_t ldy,
                                          int KT, char* smem, int tid) {
  const int lane = tid & 63, w = tid >> 6, wm = w & 1, wn = w >> 1;
  char* xs = smem;
  char* ys = smem + 32768;
  u32x4 xa[4], ya[YR / 32], xb[4], yb[YR / 32];
  g2r<128>(xa, X, ldx, tid);
  g2r<YR>(ya, Y, ldy, tid);
  g2r<128>(xb, X + 64, ldx, tid);
  g2r<YR>(yb, Y + 64, ldy, tid);
  r2s<128>(xa, xs, tid);
  r2s<YR>(ya, ys, tid);
  __syncthreads();
#pragma unroll 1
  for (int kt = 0; kt < KT; kt += 2) {
    if (kt + 2 < KT) {
      g2r<128>(xa, X + (size_t)(kt + 2) * 64, ldx, tid);
      g2r<YR>(ya, Y + (size_t)(kt + 2) * 64, ldy, tid);
    }
    mma_tile<2, NI>(acc, xs, wm * 64, ys, wn * 32 * NI, lane);
    r2s<128>(xb, xs + 16384, tid);
    r2s<YR>(yb, ys + YR * 128, tid);
    __syncthreads();
    if (kt + 3 < KT) {
      g2r<128>(xb, X + (size_t)(kt + 3) * 64, ldx, tid);
      g2r<YR>(yb, Y + (size_t)(kt + 3) * 64, ldy, tid);
    }
    mma_tile<2, NI>(acc, xs + 16384, wm * 64, ys + YR * 128, wn * 32 * NI, lane);
    if (kt + 2 < KT) {
      r2s<128>(xa, xs, tid);
      r2s<YR>(ya, ys, tid);
    }
    __syncthreads();
  }
}
template <int YR, int NI>
__device__ __forceinline__ void gemm_loop(f32x16 (&acc)[2][NI], const u16* X, size_t ldx, const u16* Y, size_t ldy,
                                          int KT, char* smem, int tid) {
  if constexpr (YR == 128) gemm_loop_deep<YR, NI>(acc, X, ldx, Y, ldy, KT, smem, tid);
  else gemm_loop_shallow<YR, NI>(acc, X, ldx, Y, ldy, KT, smem, tid);
}
template <int NI>
__device__ __forceinline__ void zero_acc(f32x16 (&acc)[2][NI]) {
#pragma unroll
  for (int mi = 0; mi < 2; ++mi)
#pragma unroll
    for (int ni = 0; ni < NI; ++ni)
#pragma unroll
      for (int r = 0; r < 16; ++r) acc[mi][ni][r] = 0.f;
}

__device__ __forceinline__ int conv_map(int mode, int n) {
  if (mode == 0) return n < 1860 ? n : (n < 1920 ? -1 : n - 60);
  if (mode == 1) {
    const int tile = n >> 7, r = n & 127, sub = r >> 5;
    return 3908 + (sub & 1) * 1024 + tile * 64 + (sub >> 1) * 32 + (r & 31);
  }
  if (mode == 3) {
    const int tile = n >> 7, r = n & 127, sub = r >> 5;
    const int j = tile * 64 + (sub >> 1) * 32 + (r & 31);
    return (sub & 1) ? DFF + j : j;
  }
  return n;
}
__device__ __forceinline__ void conv_tile(const float* src, int ld, int K, int mode, const float* scale, u16* dst, int tile, float* lds,
                          int tid) {
  const int ktiles = K >> 6;
  const int ntile = tile / ktiles, ktile = tile - ntile * ktiles;
  const int n0 = ntile * 64, k0 = ktile * 64;
  const int n4 = (tid & 15) * 4, kq = tid >> 4;
  const int col = conv_map(mode, n0 + n4);
  float4 vv[4];
#pragma unroll
  for (int i = 0; i < 4; ++i) {
    const int k = kq + 16 * i;
    vv[i] = (col >= 0) ? *(const float4*)(src + (size_t)(k0 + k) * ld + col) : float4{0.f, 0.f, 0.f, 0.f};
    if (scale) { const float sc = scale[k0 + k]; vv[i].x *= sc; vv[i].y *= sc; vv[i].z *= sc; vv[i].w *= sc; }
  }
#pragma unroll
  for (int i = 0; i < 4; ++i) {
    float* d = lds + (kq + 16 * i) * 65 + n4;
    d[0] = vv[i].x; d[1] = vv[i].y; d[2] = vv[i].z; d[3] = vv[i].w;
  }
  __syncthreads();
  const int nr = tid >> 2, part = tid & 3;
  u32 o[8];
#pragma unroll
  for (int i = 0; i < 8; ++i)
    o[i] = pack2(lds[(part * 16 + 2 * i) * 65 + nr], lds[(part * 16 + 2 * i + 1) * 65 + nr]);
  u32x4* d = (u32x4*)(dst + (size_t)(n0 + nr) * K + k0 + part * 16);
  d[0] = u32x4{o[0], o[1], o[2], o[3]};
  d[1] = u32x4{o[4], o[5], o[6], o[7]};
}
__device__ __forceinline__ void conv_item(const P& p, int l, int c, char* smem, int tid) {
  const float* src; int ld, K, mode; const float* scale = nullptr; u16* dst;
  if (c < 992) { src = p.w_in + (size_t)l * 1024 * 5956; ld = 5956; K = 1024; mode = 0; scale = p.nmix + l * 1024; dst = (u16*)(p.ws + OFF_WIN); }
  else if (c < 1504) { c -= 992; src = p.w_in + (size_t)l * 1024 * 5956; ld = 5956; K = 1024; mode = 1; scale = p.nmix + l * 1024; dst = (u16*)(p.ws + OFF_WGATE); }
  else if (c < 1632) { c -= 1504; src = p.w_pa + (size_t)l * 512 * 1024; ld = 1024; K = 512; mode = 2; dst = (u16*)(p.ws + OFF_WPA); }
  else if (c < 1760) { c -= 1632; src = p.w_ph + (size_t)l * 512 * 1024; ld = 1024; K = 512; mode = 2; dst = (u16*)(p.ws + OFF_WPH); }
  else if (c < 2016) { c -= 1760; src = p.w_out + (size_t)l * 1024 * 1024; ld = 1024; K = 1024; mode = 2; dst = (u16*)(p.ws + OFF_WOUT); }
  else if (c < 3424) { c -= 2016; src = p.w_ffi + (size_t)l * 1024 * 5632; ld = 5632; K = 1024; mode = 3; scale = p.nffn + l * 1024; dst = (u16*)(p.ws + OFF_WFFI); }
  else { c -= 3424; src = p.w_ffo + (size_t)l * DFF * 1024; ld = 1024; K = DFF; mode = 2; dst = (u16*)(p.ws + OFF_WFFO); }
  conv_tile(src, ld, K, mode, scale, dst, c, (float*)smem, tid);
}

__device__ __forceinline__ void p0_rows(const P& p, int item, int tid) {
  const int lane = tid & 63, w = tid >> 6;
  const int tok = item * 4 + w;
  const float4* xr = (const float4*)(p.x + (size_t)tok * 1024);
  float4* orow = (float4*)(p.out + (size_t)tok * 1024);
  u32x2* xb = (u32x2*)(p.ws + OFF_XB + (size_t)tok * 2048);
  float ss = 0.f;
#pragma unroll
  for (int i = 0; i < 4; ++i) {
    float4 v = xr[lane + 64 * i];
    ss += v.x * v.x + v.y * v.y + v.z * v.z + v.w * v.w;
    orow[lane + 64 * i] = v;
    xb[lane + 64 * i] = u32x2{pack2(v.x, v.y), pack2(v.z, v.w)};
  }
  ss = wave_sum(ss);
  float* rowss = (float*)(p.ws + OFF_ROWSS);
  if (lane < 16) rowss[(size_t)tok * 16 + lane] = lane == 0 ? ss : 0.f;
}


__device__ __forceinline__ float row_rstd(const float* part, int tok) {
  const float4* q = (const float4*)(part + (size_t)tok * 16);
  const float4 a = q[0], b = q[1], c = q[2], d = q[3];
  const float ss = ((a.x + a.y) + (a.z + a.w)) + ((b.x + b.y) + (b.z + b.w)) + ((c.x + c.y) + (c.z + c.w)) + ((d.x + d.y) + (d.z + d.w));
  return rsqrtf(ss * (1.f / 1024.f) + EPS);
}
__device__ __forceinline__ void rope_cs(int pos, int d1, float& c, float& s) {
  const float inv = exp2f(-(float)d1 * (13.287712379549449f / 32.f));
  const float ang = (float)pos * inv;
  double rv = (double)ang * 0.15915494309189535;
  rv -= floor(rv);
  const float r = (float)rv;
  c = __builtin_amdgcn_cosf(r);
  s = __builtin_amdgcn_sinf(r);
}

__device__ __forceinline__ void phaseA_tile(const P& p, int l, int mt, int nt, char* smem, int tid) {
  const int lane = tid & 63, w = tid >> 6, wm = w & 1, wn = w >> 1, h = lane >> 5, lr = lane & 31;
  const int m0 = mt * 128;
  float* rs = (float*)(smem + 65536);
  const float* rowss = (const float*)(p.ws + OFF_ROWSS);
  if (tid < 128) rs[tid] = row_rstd(rowss, m0 + tid);
  const u16* XB = (const u16*)(p.ws + OFF_XB) + (size_t)m0 * 1024;
  const u16* W = (const u16*)(p.ws + OFF_WIN) + (size_t)nt * 128 * 1024;
  const bool fr = (nt < 15) || (nt >= 23 && nt < 27);
  f32x16 acc[2][2];
  zero_acc<2>(acc);
  if (fr) gemm_loop<128, 2>(acc, W, 1024, XB, 1024, 16, smem, tid);
  else gemm_loop<128, 2>(acc, XB, 1024, W, 1024, 16, smem, tid);

  if (fr) {
    if (nt < 8 || (nt >= 12 && nt < 15)) {
      const bool isidx = nt >= 12;
      const int fbase = isidx ? (nt - 12) * 128 + wm * 64 : nt * 128 + wm * 64;
      if (isidx && nt == 14 && wm == 1) {
#pragma unroll
        for (int ni = 0; ni < 2; ++ni) {
          const int tl = wn * 64 + ni * 32 + lr;
          const float rstd = rs[tl] * 0.5f;
          if (h == 0) {
            float4 o = {acc[0][ni][0] * rstd, acc[0][ni][1] * rstd, acc[0][ni][2] * rstd, acc[0][ni][3] * rstd};
            *(float4*)(p.ws + OFF_IW + (size_t)(m0 + tl) * 16) = o;
          }
        }
        return;
      }
      const bool isk = (!isidx) && fbase >= 512;
      const int head = isidx ? (nt == 14 ? 0 : (fbase >> 6)) : ((fbase & 511) >> 6);
      const float* nw = isidx ? nullptr : (isk ? p.kn + l * 64 : p.qn + l * 64);
      u16* dst; int dld;
      float oscale = 1.f;
      if (!isidx) { dst = (u16*)(p.ws + (isk ? OFF_AK : OFF_AQ)); dld = 512; if (!isk) oscale = 0.125f * 1.4426950408889634f; }
      else if (nt < 14) { dst = (u16*)(p.ws + OFF_IQ); dld = 256; oscale = 0.125f; }
      else { dst = (u16*)(p.ws + OFF_IK); dld = 64; }
#pragma unroll
      for (int ni = 0; ni < 2; ++ni) {
        const int tl = wn * 64 + ni * 32 + lr;
        const int tok = m0 + tl;
        const float rstd = rs[tl];
        const int pos = p.pos[tok];
        float rn = rstd;
        if (!isidx) {
          float ss = 0.f;
#pragma unroll
          for (int mi = 0; mi < 2; ++mi)
#pragma unroll
            for (int r = 0; r < 16; ++r) { const float v = acc[mi][ni][r] * rstd; ss += v * v; }
          ss += __shfl_xor(ss, 32);
          rn = rstd * rsqrtf(ss * (1.f / 64.f) + EPS);
        }
        u16* drow = dst + (size_t)tok * dld + head * 64;
#pragma unroll
        for (int rg = 0; rg < 4; ++rg) {
          float o1[4], o2[4];
#pragma unroll
          for (int j = 0; j < 4; ++j) {
            const int r = rg * 4 + j;
            const int d1 = j + 8 * rg + 4 * h;
            float x1 = acc[0][ni][r] * rn, x2 = acc[1][ni][r] * rn;
            if (!isidx) { x1 *= nw[d1]; x2 *= nw[d1 + 32]; }
            float c, s;
            rope_cs(pos, d1, c, s);
            o1[j] = (x1 * c - x2 * s) * oscale;
            o2[j] = (x2 * c + x1 * s) * oscale;
          }
          const int d1b = 8 * rg + 4 * h;
          *(u32x2*)(drow + d1b) = u32x2{pack2(o1[0], o1[1]), pack2(o1[2], o1[3])};
          *(u32x2*)(drow + d1b + 32) = u32x2{pack2(o2[0], o2[1]), pack2(o2[2], o2[3])};
          __builtin_amdgcn_sched_barrier(0);
        }
      }
    } else {
      const bool isav = nt < 12;
      u16* dst = (u16*)(p.ws + (isav ? OFF_AVT : OFF_HVT));
#pragma unroll
      for (int ni = 0; ni < 2; ++ni) {
        const int tl = wn * 64 + ni * 32 + lr;
        const int tok = m0 + tl;
        const float rstd = rs[tl];
        const int b = tok >> 13, t = tok & 8191;
#pragma unroll
        for (int mi = 0; mi < 2; ++mi)
#pragma unroll
          for (int r = 0; r < 16; ++r) {
            const int f = (isav ? (nt - 8) : (nt - 23)) * 128 + wm * 64 + mi * 32 + rowof(r, lane);
            dst[((size_t)(b * 512 + f)) * 8192 + t] = f2bf(acc[mi][ni][r] * rstd);
            if ((r & 3) == 3) __builtin_amdgcn_sched_barrier(0);
          }
      }
    }
  } else {
    const int seg = (nt - 15) >> 2;
    const int fb = ((nt - 15) & 3) * 128 + wn * 64;
#pragma unroll
    for (int ni = 0; ni < 2; ++ni) {
      const int f = fb + ni * 32 + lr;
      float lb = 0.f;
      if (seg == 1) {
        float e[4], mx = -1e30f;
#pragma unroll
        for (int i = 0; i < 4; ++i) { e[i] = p.hlb[i * 512 + f]; mx = fmaxf(mx, e[i]); }
        float tot = 0.f, part = 0.f;
#pragma unroll
        for (int i = 0; i < 4; ++i) { e[i] = __expf(e[i] - mx); tot += e[i]; if (i >= 1 && i <= l) part += e[i]; }
        lb = part / tot;
      }
#pragma unroll
      for (int mi = 0; mi < 2; ++mi)
#pragma unroll
        for (int r = 0; r < 16; ++r) {
          const int tl = wm * 64 + mi * 32 + rowof(r, lane);
          const float v = acc[mi][ni][r] * rs[tl];
          const size_t o = (size_t)(m0 + tl) * 512 + f;
          if (seg == 0) ((u16*)(p.ws + OFF_HQ))[o] = f2bf(siluf_(v));
          else if (seg == 3) ((u16*)(p.ws + OFF_HG))[o] = f2bf(siluf_(v));
          else {
            const float sg = 1.f / (1.f + __expf(-v));
            ((float*)(p.ws + OFF_LOGF))[o] = logf(lb + (1.f - lb) * sg);
          }
          if ((r & 3) == 3) __builtin_amdgcn_sched_barrier(0);
        }
    }
  }
}

__device__ __forceinline__ void hgrn_load_cumsum(const P& p, int tok0, int hh, int d, int hf, float (&lf)[32],
                                                 float (&cs)[32]) {
  const float* src = (const float*)(p.ws + OFF_LOGF) + (size_t)(tok0 + hf * 32) * 512 + hh * 128 + d;
#pragma unroll
  for (int i = 0; i < 32; ++i) lf[i] = src[(size_t)i * 512];
  float run = 0.f;
#pragma unroll
  for (int i = 0; i < 32; ++i) { run += lf[i]; cs[i] = run; }
}
__device__ __forceinline__ void put_td(char* base, int t, int d, float v) {
  const int kt = d >> 6, dd = d & 63;
  *(u16*)(base + kt * 8192 + t * 128 + (((dd >> 3) ^ ((t >> 1) & 7)) << 4) + (dd & 7) * 2) = f2bf(v);
}

__device__ __forceinline__ void h1_item(const P& p, int item, char* smem, int tid) {
  const int lane = tid & 63, w = tid >> 6, wm = w & 1, wn = w >> 1;
  const int b = item >> 9, hh = (item >> 7) & 3, c = item & 127;
  const int tok0 = b * SEQ + c * 64;
  const int d = tid & 127, hf = tid >> 7;
  char* vts = smem;
  char* kts = smem + 16384;
  float* tot = (float*)(smem + 65536);
  u32x4 vr[4];
  g2r<128>(vr, (const u16*)(p.ws + OFF_HVT) + ((size_t)(b * 512 + hh * 128)) * 8192 + c * 64, 8192, tid);
  float lf[32], cs[32];
  hgrn_load_cumsum(p, tok0, hh, d, hf, lf, cs);
  tot[hf * 128 + d] = cs[31];
  r2s<128>(vr, vts, tid);
  __syncthreads();
  const float after = hf ? 0.f : tot[128 + d];
  if (hf) ((float*)(p.ws + OFF_GDEC))[(size_t)item * 128 + d] = __expf(cs[31] + tot[d]);
#pragma unroll
  for (int ch = 0; ch < 4; ++ch) {
    u32 o[4];
#pragma unroll
    for (int j = 0; j < 4; ++j) {
      const int i0 = ch * 8 + 2 * j;
      const float k0 = (1.f - __expf(lf[i0])) * __expf(cs[31] - cs[i0] + after);
      const float k1 = (1.f - __expf(lf[i0 + 1])) * __expf(cs[31] - cs[i0 + 1] + after);
      o[j] = pack2(k0, k1);
    }
    const int chunk = hf * 4 + ch;
    *(u32x4*)(kts + d * 128 + ((chunk ^ ((d >> 1) & 7)) << 4)) = u32x4{o[0], o[1], o[2], o[3]};
  }
  __syncthreads();
  f32x16 acc[2][2];
  zero_acc<2>(acc);
  mma_tile<2, 2>(acc, vts, wm * 64, kts, wn * 64, lane);
  u16* us = (u16*)(p.ws + OFF_US) + (size_t)item * 16384;
#pragma unroll
  for (int mi = 0; mi < 2; ++mi)
#pragma unroll
    for (int ni = 0; ni < 2; ++ni)
#pragma unroll
      for (int r = 0; r < 16; ++r) {
        const int e = wm * 64 + mi * 32 + rowof(r, lane);
        const int dd = wn * 64 + ni * 32 + (lane & 31);
        us[e * 128 + dd] = f2bf(acc[mi][ni][r]);
      }
}

__device__ __forceinline__ void h2_item(const P& p, int item, int tid) {
  const int g = item * 256 + tid;
  const int bh = g >> 13, e = (g >> 6) & 127, dp = g & 63;
  float s0 = 0.f, s1 = 0.f;
  u32* us = (u32*)(p.ws + OFF_US) + (size_t)bh * 128 * 8192 + e * 64 + dp;
  const float2* gd = (const float2*)(p.ws + OFF_GDEC) + (size_t)bh * 128 * 64 + dp;
#pragma unroll 1
  for (int c0 = 0; c0 < 128; c0 += 16) {
    u32 u[16];
    float2 g2[16];
#pragma unroll
    for (int i = 0; i < 16; ++i) { u[i] = us[(size_t)(c0 + i) * 8192]; g2[i] = gd[(c0 + i) * 64]; }
#pragma unroll
    for (int i = 0; i < 16; ++i) {
      us[(size_t)(c0 + i) * 8192] = pack2(s0, s1);
      s0 = g2[i].x * s0 + bf2f((u16)(u[i] & 0xFFFF));
      s1 = g2[i].y * s1 + bf2f((u16)(u[i] >> 16));
    }
  }
}

__device__ __forceinline__ void h3_item(const P& p, int l, int item, char* smem, int tid) {
  const int lane = tid & 63, w = tid >> 6, h = lane >> 5, lr = lane & 31;
  const int b = item >> 9, hh = (item >> 7) & 3, c = item & 127;
  const int tok0 = b * SEQ + c * 64;
  const int d = tid & 127, hf = tid >> 7;
  char* R0 = smem;
  char* R1 = smem + 16384;
  char* R2 = smem + 32768;
  char* R3 = smem + 49152;
  float* tot = (float*)(smem + 65536);
  const u16* usb = (const u16*)(p.ws + OFF_US) + (size_t)item * 16384;
  u32x4 vr[4], s0r[4], s1r[4];
  g2r<128>(vr, (const u16*)(p.ws + OFF_HVT) + ((size_t)(b * 512 + hh * 128)) * 8192 + c * 64, 8192, tid);
  g2r<128>(s0r, usb, 128, tid);
  g2r<128>(s1r, usb + 64, 128, tid);
  float lf[32], cs[32], q[32];
  hgrn_load_cumsum(p, tok0, hh, d, hf, lf, cs);
  {
    const u16* qs = (const u16*)(p.ws + OFF_HQ) + (size_t)(tok0 + hf * 32) * 512 + hh * 128 + d;
#pragma unroll
    for (int i = 0; i < 32; ++i) q[i] = bf2f(qs[(size_t)i * 512]);
  }
  if (hf == 0) tot[d] = cs[31];
  r2s<128>(vr, R3, tid);
  r2s<128>(s0r, R2, tid);
  __syncthreads();
  const float t0 = tot[d];
#pragma unroll
  for (int i = 0; i < 32; ++i) {
    const int t = hf * 32 + i;
    const float rel = hf ? cs[i] : cs[i] - t0;
    put_td(R0, t, d, q[i] * __expf(rel));
    put_td(R1, t, d, (1.f - __expf(lf[i])) * __expf(-rel));
  }
  __syncthreads();
  {
    const int sb = w & 1, tb = w >> 1;
    f32x16 a1[1][1];
#pragma unroll
    for (int r = 0; r < 16; ++r) a1[0][0][r] = 0.f;
    if (sb <= tb) {
      mma_tile<1, 1>(a1, R1, sb * 32, R0, tb * 32, lane);
      mma_tile<1, 1>(a1, R1 + 8192, sb * 32, R0 + 8192, tb * 32, lane);
    }
    __syncthreads();
    const int t = tb * 32 + lr;
#pragma unroll
    for (int rg = 0; rg < 4; ++rg) {
      float v[4];
#pragma unroll
      for (int j = 0; j < 4; ++j) {
        const int s = sb * 32 + 8 * rg + 4 * h + j;
        v[j] = (s <= t) ? a1[0][0][rg * 4 + j] : 0.f;
      }
      const int s0 = sb * 32 + 8 * rg + 4 * h;
      *(u32x2*)(R1 + t * 128 + (((s0 >> 3) ^ ((t >> 1) & 7)) << 4) + (s0 & 7) * 2) =
          u32x2{pack2(v[0], v[1]), pack2(v[2], v[3])};
    }
#pragma unroll
    for (int i = 0; i < 32; ++i) {
      const int tt = hf * 32 + i;
      put_td(R0, tt, d, q[i] * __expf(hf ? cs[i] + t0 : cs[i]));
    }
  }
  __syncthreads();
  f32x16 o[1][2];
#pragma unroll
  for (int ni = 0; ni < 2; ++ni)
#pragma unroll
    for (int r = 0; r < 16; ++r) o[0][ni][r] = 0.f;
  mma_tile<1, 2>(o, R2, w * 32, R0, 0, lane);
  mma_tile<1, 2>(o, R3, w * 32, R1, 0, lane);
  __syncthreads();
  r2s<128>(s1r, R2, tid);
  __syncthreads();
  mma_tile<1, 2>(o, R2, w * 32, R0 + 8192, 0, lane);
  float* red = tot;
#pragma unroll
  for (int ni = 0; ni < 2; ++ni) {
    float ss = 0.f;
#pragma unroll
    for (int r = 0; r < 16; ++r) ss += o[0][ni][r] * o[0][ni][r];
    ss += __shfl_xor(ss, 32);
    if (h == 0) red[w * 64 + ni * 32 + lr] = ss;
  }
  __syncthreads();
#pragma unroll
  for (int ni = 0; ni < 2; ++ni) {
    const int t = ni * 32 + lr;
    const float ss = red[t] + red[64 + t] + red[128 + t] + red[192 + t];
    const float rn = rsqrtf(ss * (1.f / 128.f) + EPS);
    const size_t rowo = (size_t)(tok0 + t) * 512 + hh * 128;
#pragma unroll
    for (int rg = 0; rg < 4; ++rg) {
      const int e0 = w * 32 + 8 * rg + 4 * h;
      const u32x2 gg = *(const u32x2*)((const u16*)(p.ws + OFF_HG) + rowo + e0);
      const float4 nw = *(const float4*)(p.hn + l * 128 + e0);
      const float y0 = o[0][ni][rg * 4 + 0] * rn * nw.x * bf2f((u16)(gg.x & 0xFFFF));
      const float y1 = o[0][ni][rg * 4 + 1] * rn * nw.y * bf2f((u16)(gg.x >> 16));
      const float y2 = o[0][ni][rg * 4 + 2] * rn * nw.z * bf2f((u16)(gg.y & 0xFFFF));
      const float y3 = o[0][ni][rg * 4 + 3] * rn * nw.w * bf2f((u16)(gg.y >> 16));
      *(u32x2*)((u16*)(p.ws + OFF_YH) + rowo + e0) = u32x2{pack2(y0, y1), pack2(y2, y3)};
    }
  }
}

__device__ __forceinline__ size_t code_rowoff(int q) {
  const int g = q >> 7, r = q & 127;
  return (size_t)128 * ((size_t)64 * g * (g + 1) + (size_t)r * (g + 1));
}
__device__ __forceinline__ u32 tocode(float s) {
  u32 u = __float_as_uint(s);
  if ((u << 1) == 0) u = 0;
  u = (u & 0x80000000u) ? ~u : (u | 0x80000000u);
  u >>= 16;
  return u < 1 ? 1 : u;
}
__device__ __forceinline__ void b1_item(const P& p, int item, char* smem, int tid) {
  const int lane = tid & 63, w = tid >> 6, wm = w & 1, wn = w >> 1, lr = lane & 31;
  const int b = item >= 2080;
  int idx = item - b * 2080;
  int g = (int)((sqrtf(8.f * idx + 1.f) - 1.f) * 0.5f);
  while (g * (g + 1) / 2 > idx) --g;
  while ((g + 1) * (g + 2) / 2 <= idx) ++g;
  const int kt = idx - g * (g + 1) / 2;
  const int q0 = b * SEQ + g * 128, k0 = b * SEQ + kt * 128;
  char* ys = smem;
  char* xs = smem + 16384;
  float* wsm = (float*)(smem + 49152);
  const u16* IQ = (const u16*)(p.ws + OFF_IQ) + (size_t)q0 * 256;
  const u16* IK = (const u16*)(p.ws + OFF_IK) + (size_t)k0 * 64;
  u32x4 xr[4], yr[4];
  g2r<128>(yr, IK, 64, tid);
  g2r<128>(xr, IQ, 256, tid);
  if (tid < 128) *(float4*)(wsm + tid * 4) = *(const float4*)(p.ws + OFF_IW + (size_t)(q0 + tid) * 16);
  r2s<128>(yr, ys, tid);
  r2s<128>(xr, xs, tid);
  __syncthreads();
  f32x16 sc[2][2];
  zero_acc<2>(sc);
#pragma unroll 1
  for (int hd = 0; hd < 4; ++hd) {
    if (hd < 3) g2r<128>(xr, IQ + (hd + 1) * 64, 256, tid);
#pragma unroll
    for (int mi = 0; mi < 2; ++mi) {
      f32x16 acc[1][2];
#pragma unroll
      for (int ni = 0; ni < 2; ++ni)
#pragma unroll
        for (int r = 0; r < 16; ++r) acc[0][ni][r] = 0.f;
      mma_tile<1, 2>(acc, xs + (hd & 1) * 16384, wm * 64 + mi * 32, ys, wn * 64, lane);
#pragma unroll
      for (int r = 0; r < 16; ++r) {
        const float wv = wsm[(wm * 64 + mi * 32 + rowof(r, lane)) * 4 + hd];
#pragma unroll
        for (int ni = 0; ni < 2; ++ni) sc[mi][ni][r] += wv * fmaxf(acc[0][ni][r], 0.f);
      }
      __builtin_amdgcn_sched_barrier(0);
    }
    if (hd < 3) r2s<128>(xr, xs + ((hd + 1) & 1) * 16384, tid);
    __syncthreads();
  }
  u16* codes = (u16*)(p.ws + OFF_CODES) + (size_t)b * CODES_PER_BATCH;
  char* st = smem + 16384;
#pragma unroll
  for (int mi = 0; mi < 2; ++mi)
#pragma unroll
    for (int r = 0; r < 16; ++r) {
      const int ql = wm * 64 + mi * 32 + rowof(r, lane);
      const int q = g * 128 + ql;
#pragma unroll
      for (int ni = 0; ni < 2; ++ni) {
        const int kl = wn * 64 + ni * 32 + lr;
        const bool vis = (kt * 128 + kl) <= q;
        const u32 cd = vis ? tocode(sc[mi][ni][r]) : 0u;
        *(u16*)(st + ql * 256 + (2 * (ni * 32 + lr) + wn) * 2) = (u16)cd;
      }
    }
  __syncthreads();
  {
    u16* dst0 = codes + code_rowoff(g * 128) + kt * 128;
    const size_t rstride = (size_t)128 * (g + 1);
#pragma unroll
    for (int i = 0; i < 8; ++i) {
      const int cid = tid + 256 * i;
      const int row = cid >> 4, c = cid & 15;
      __builtin_nontemporal_store(*(const u32x4*)(st + row * 256 + c * 16), (u32x4*)(dst0 + (size_t)row * rstride + c * 8));
    }
  }
}

__device__ __forceinline__ int wave_isum(int c) {
#pragma unroll
  for (int o = 32; o >= 1; o >>= 1) c += __shfl_xor(c, o);
  return c;
}
__device__ __forceinline__ int count_ge(const u32 (&r)[64], int nj, u32 t) {
  const u16 tm1 = (u16)(t - 1);
  const u16x2 tv = {tm1, tm1};
  const u16x2 one = {1, 1};
  u16x2 acc = {0, 0};
#pragma unroll
  for (int jb = 0; jb < 8; ++jb) {
    if (jb * 8 < nj) {
#pragma unroll
      for (int jj = 0; jj < 8; ++jj) {
        u16x2 d = __builtin_elementwise_sub_sat(__builtin_bit_cast(u16x2, r[jb * 8 + jj]), tv);
        d = __builtin_elementwise_min(d, one);
        acc += d;
      }
    }
  }
  return wave_isum((int)acc.x + (int)acc.y);
}
__device__ __forceinline__ int snake_item(int k, int bid, int nb);
__device__ __forceinline__ void b2_load(const P& p, int item, int tid, u32 (&r)[64]) {
  const int lane = tid & 63, w = tid >> 6;
  const int Q = item * 4 + w;
  const int b = Q >> 13, q = Q & 8191;
  const int nj = (q >> 7) + 1;
  const u32* row = (const u32*)((const u16*)(p.ws + OFF_CODES) + (size_t)b * CODES_PER_BATCH + code_rowoff(q));
#pragma unroll
  for (int j = 0; j < 64; ++j) r[j] = (j < nj) ? __builtin_nontemporal_load(row + j * 64 + lane) : 0u;
}
__device__ __forceinline__ void b2_process(const P& p, int item, char* smem, int tid, const u32 (&r)[64]) {
  const int lane = tid & 63, w = tid >> 6;
  const int Q = item * 4 + w;
  const int q = Q & 8191;
  const int nj = (q >> 7) + 1;
  u16x2 m1 = {0, 0}, m2 = {0, 0};
#pragma unroll
  for (int jb = 0; jb < 8; ++jb) {
    if (jb * 8 < nj) {
#pragma unroll
      for (int jj = 0; jj < 8; ++jj) {
        const u16x2 x = __builtin_bit_cast(u16x2, r[jb * 8 + jj]);
        const u16x2 t = __builtin_elementwise_min(m1, x);
        m1 = __builtin_elementwise_max(m1, x);
        m2 = __builtin_elementwise_max(m2, t);
      }
    }
  }
  int L = min((int)m2.x, (int)m2.y), H = max((int)m1.x, (int)m1.y);
#pragma unroll
  for (int o = 32; o >= 1; o >>= 1) { L = min(L, __shfl_xor(L, o)); H = max(H, __shfl_xor(H, o)); }
  u32 T = 0;
  int need = 0;
  u32 lo = L < 1 ? 1u : (u32)L;
  if (lo > 1 || count_ge(r, nj, 1) >= 256) {
    const int R = H - (int)lo + 1;
    if (R <= 2048) {
      u32* hist = (u32*)(smem + w * 8192);
      const int nbl = (R + 63) >> 6;
      for (int i = 0; i < nbl; ++i) hist[i * 64 + lane] = 0u;
#pragma unroll
      for (int jb = 0; jb < 8; ++jb) {
        if (jb * 8 < nj) {
#pragma unroll
          for (int jj = 0; jj < 8; ++jj) {
            const u32 v = r[jb * 8 + jj];
            const u32 c0 = v & 0xFFFFu, c1 = v >> 16;
            if (c0 >= lo) atomicAdd(&hist[c0 - lo], 1u);
            if (c1 >= lo) atomicAdd(&hist[c1 - lo], 1u);
          }
        }
      }
      int sl = 0;
      for (int i = 0; i < nbl; ++i) sl += (int)hist[lane * nbl + i];
      int suf = sl;
#pragma unroll
      for (int d = 1; d <= 32; d <<= 1) {
        const int v = __shfl_down(suf, d);
        suf += (lane + d < 64) ? v : 0;
      }
      const u64 okm = __ballot(suf >= 256);
      const int istar = 63 - __builtin_clzll(okm);
      int cacc = suf - sl, tbin = 0, cgt = 0;
      bool found = false;
      for (int i = nbl - 1; i >= 0; --i) {
        const int hc = (int)hist[lane * nbl + i];
        if (!found && cacc + hc >= 256) { found = true; tbin = lane * nbl + i; cgt = cacc; }
        cacc += hc;
      }
      tbin = __shfl(tbin, istar);
      cgt = __shfl(cgt, istar);
      T = lo + (u32)tbin;
      need = 256 - cgt;
    } else {
      u32 hi = (u32)H + 1u;
      while (hi - lo > 1) {
        const u32 mid = (lo + hi) >> 1;
        if (count_ge(r, nj, mid) >= 256) lo = mid; else hi = mid;
      }
      T = lo;
      const int cgt = (T >= 65535u) ? 0 : count_ge(r, nj, T + 1);
      need = 256 - cgt;
    }
  }
  int mlo[2] = {0, 0}, mhi[2] = {0, 0};
  const u32 thi = (T << 16) | 0xFFFFu;
#pragma unroll
  for (int j = 0; j < 64; ++j) {
    if (j < nj) {
#pragma unroll
      for (int hfw = 0; hfw < 2; ++hfw) {
        const u32 cd = hfw ? (r[j] >> 16) : (r[j] & 0xFFFFu);
        u64 word = hfw ? __ballot(r[j] > thi) : __ballot(cd > T);
        if (T > 0 && need > 0) {
          const bool eq = cd == T;
          const u64 eqm = __ballot(eq);
          if (eqm != 0) {
            const int rank = __builtin_amdgcn_mbcnt_hi((u32)(eqm >> 32), __builtin_amdgcn_mbcnt_lo((u32)eqm, 0));
            word |= __ballot(eq && rank < need);
            need -= __popcll(eqm);
          }
        }
        const int widx = 2 * j + hfw;
        if (lane == (widx & 63)) { mlo[widx >> 6] = (int)(u32)word; mhi[widx >> 6] = (int)(u32)(word >> 32); }
      }
    }
  }
  u32x2* mrow = (u32x2*)(p.ws + OFF_MASK + (size_t)Q * 1024);
#pragma unroll
  for (int k = 0; k < 2; ++k)
    if (lane + 64 * k < 2 * nj) mrow[lane + 64 * k] = u32x2{(u32)mlo[k], (u32)mhi[k]};
}

__device__ __forceinline__ void b2_phase(const P& p, int bid, int nb, char* smem, int tid) {
  const int rounds = (4096 + nb - 1) / nb;
  u32 ra[64], rb[64];
  int ia = snake_item(0, bid, nb);
  if (ia < 4096) b2_load(p, ia, tid, ra);
#pragma unroll 1
  for (int k = 0; k < rounds; k += 2) {
    const int ib = (k + 1 < rounds) ? snake_item(k + 1, bid, nb) : 4096;
    if (ib < 4096) b2_load(p, ib, tid, rb);
    if (ia < 4096) b2_process(p, ia, smem, tid, ra);
    ia = (k + 2 < rounds) ? snake_item(k + 2, bid, nb) : 4096;
    if (ia < 4096) b2_load(p, ia, tid, ra);
    if (ib < 4096) b2_process(p, ib, smem, tid, rb);
  }
}

__device__ __forceinline__ void b3_item(const P& p, int l, int item, char* smem, int tid) {
  const int lane = tid & 63, w = tid >> 6, h = lane >> 5, lr = lane & 31;
  const int g = 63 - (item >> 4), rem = item & 15, b = rem >> 3, head = rem & 7;
  const int q0 = g * 128;
  const int nkt = 2 * g + 2;
  const u16* AK = (const u16*)(p.ws + OFF_AK) + (size_t)b * SEQ * 512 + head * 64;
  const u16* AVT = (const u16*)(p.ws + OFF_AVT) + ((size_t)(b * 512 + head * 64)) * 8192;
  const u64* MK = (const u64*)(p.ws + OFF_MASK) + (size_t)(b * SEQ + q0) * 128;
  bf16x8 qf[4];
  {
    const u16* qrow = (const u16*)(p.ws + OFF_AQ) + (size_t)(b * SEQ + q0 + w * 32 + lr) * 512 + head * 64;
#pragma unroll
    for (int ks = 0; ks < 4; ++ks) qf[ks] = *(const bf16x8*)(qrow + ks * 16 + 8 * h);
  }
  u32x4 kr[2], vr[2];
  u64 mr = 0;
  g2r<64>(kr, AK, 512, tid);
  g2r<64>(vr, AVT, 8192, tid);
  if (tid < 128) mr = MK[(size_t)tid * 128];
  r2s<64>(kr, smem, tid);
  r2s<64>(vr, smem + 8192, tid);
  if (tid < 128) *(u64*)(smem + 16384 + tid * 8) = mr;
  __syncthreads();
  f32x16 oacc[2];
#pragma unroll
  for (int i = 0; i < 2; ++i)
#pragma unroll
    for (int r = 0; r < 16; ++r) oacc[i][r] = 0.f;
  float mrun = -5e29f, lrun = 0.f;
  float mq = fabsf(p.qn[l * 64 + lane]), mk = fabsf(p.kn[l * 64 + lane]);
#pragma unroll
  for (int o = 32; o >= 1; o >>= 1) { mq = fmaxf(mq, __shfl_xor(mq, o)); mk = fmaxf(mk, __shfl_xor(mk, o)); }
  const bool fast = (0.125f * 1.4426950408889634f * 64.f * 1.03f) * mq * mk + 1.f < 60.f;
  for (int kt = 0; kt < nkt; ++kt) {
    const char* buf = smem + (kt & 1) * 17408;
    char* nbuf = smem + ((kt + 1) & 1) * 17408;
    if (kt + 1 < nkt) {
      g2r<64>(kr, AK + (size_t)(kt + 1) * 64 * 512, 512, tid);
      g2r<64>(vr, AVT + (kt + 1) * 64, 8192, tid);
      if (tid < 128) mr = MK[(size_t)tid * 128 + kt + 1];
    }
    const u64 m64 = *(const u64*)(buf + 16384 + (w * 32 + lr) * 8);
    const u64 msh = ~(m64 >> (4 * h));
    const int w0 = (int)(u32)msh, w1 = (int)(u32)(msh >> 32);
    f32x16 s[2];
#pragma unroll
    for (int kb = 0; kb < 2; ++kb) {
#pragma unroll
      for (int r = 0; r < 16; ++r)
        s[kb][r] = __int_as_float(__builtin_amdgcn_sbfe(kb ? w1 : w0, (r & 3) + 8 * (r >> 2), 1) & (int)0xF149F2CAu);
#pragma unroll
      for (int ks = 0; ks < 4; ++ks)
        s[kb] = __builtin_amdgcn_mfma_f32_32x32x16_bf16(lds_frag(buf, kb * 32 + lr, ks * 2 + h), qf[ks], s[kb], 0, 0, 0);
    }
    float psum = 0.f;
    if (fast) {
#pragma unroll
      for (int kb = 0; kb < 2; ++kb)
#pragma unroll
        for (int r = 0; r < 16; ++r) {
          const float pv = __builtin_amdgcn_exp2f(s[kb][r]);
          s[kb][r] = pv;
          psum += pv;
        }
    } else {
      float tmax = s[0][0];
#pragma unroll
      for (int kb = 0; kb < 2; ++kb)
#pragma unroll
        for (int r = 0; r < 16; ++r) tmax = fmaxf(tmax, s[kb][r]);
      tmax = fmaxf(tmax, __shfl_xor(tmax, 32));
      if (__any(tmax > mrun)) {
        const float mnew = fmaxf(mrun, tmax);
        const float alpha = __builtin_amdgcn_exp2f(mrun - mnew);
        mrun = mnew;
        lrun *= alpha;
#pragma unroll
        for (int i = 0; i < 2; ++i)
#pragma unroll
          for (int r = 0; r < 16; ++r) oacc[i][r] *= alpha;
      }
#pragma unroll
      for (int kb = 0; kb < 2; ++kb)
#pragma unroll
        for (int r = 0; r < 16; ++r) {
          const float pv = __builtin_amdgcn_exp2f(s[kb][r] - mrun);
          s[kb][r] = pv;
          psum += pv;
        }
    }
    lrun += psum;
    const char* vt = buf + 8192;
#pragma unroll
    for (int kb = 0; kb < 2; ++kb)
#pragma unroll
      for (int s2 = 0; s2 < 2; ++s2) {
        union { bf16x8 v; u32 u[4]; } pf;
#pragma unroll
        for (int j = 0; j < 4; ++j) pf.u[j] = pack2(s[kb][8 * s2 + 2 * j], s[kb][8 * s2 + 2 * j + 1]);
#pragma unroll
        for (int db = 0; db < 2; ++db) {
          const int drow = db * 32 + lr;
          const int ch = kb * 4 + 2 * s2;
          const int sw = (drow >> 1) & 7;
          union { bf16x8 v; u32x2 u[2]; } vf;
          vf.u[0] = *(const u32x2*)(vt + drow * 128 + ((ch ^ sw) << 4) + 8 * h);
          vf.u[1] = *(const u32x2*)(vt + drow * 128 + (((ch + 1) ^ sw) << 4) + 8 * h);
          oacc[db] = __builtin_amdgcn_mfma_f32_32x32x16_bf16(vf.v, pf.v, oacc[db], 0, 0, 0);
        }
      }
    if (kt + 1 < nkt) {
      r2s<64>(kr, nbuf, tid);
      r2s<64>(vr, nbuf + 8192, tid);
      if (tid < 128) *(u64*)(nbuf + 16384 + tid * 8) = mr;
    }
    __syncthreads();
  }
  lrun += __shfl_xor(lrun, 32);
  const float inv = 1.f / lrun;
  u16* yrow = (u16*)(p.ws + OFF_YA) + (size_t)(b * SEQ + q0 + w * 32 + lr) * 512 + head * 64;
#pragma unroll
  for (int db = 0; db < 2; ++db)
#pragma unroll
    for (int rg = 0; rg < 4; ++rg) {
      const int d0 = db * 32 + 8 * rg + 4 * h;
      *(u32x2*)(yrow + d0) = u32x2{pack2(oacc[db][rg * 4] * inv, oacc[db][rg * 4 + 1] * inv),
                                   pack2(oacc[db][rg * 4 + 2] * inv, oacc[db][rg * 4 + 3] * inv)};
    }
}

__device__ __forceinline__ void d1_item(const P& p, int l, int mt, int nt, char* smem, int tid) {
  const int lane = tid & 63, w = tid >> 6, wm = w & 1, wn = w >> 1, lr = lane & 31;
  const int m0 = mt * 128, n0 = nt * 64;
  float* rs = (float*)(smem + 65536);
  const float* rowss = (const float*)(p.ws + OFF_ROWSS);
  if (tid < 128) rs[tid] = row_rstd(rowss, m0 + tid);
  const u16* XB = (const u16*)(p.ws + OFF_XB) + (size_t)m0 * 1024;
  f32x16 ag[2][2];
  zero_acc<2>(ag);
  gemm_loop<128, 2>(ag, XB, 1024, (const u16*)(p.ws + OFF_WGATE) + (size_t)nt * 128 * 1024, 1024, 16, smem, tid);
#pragma unroll
  for (int mi = 0; mi < 2; ++mi)
#pragma unroll
    for (int r = 0; r < 16; ++r) {
      const float rstd = rs[wm * 64 + mi * 32 + rowof(r, lane)];
      ag[mi][0][r] = sigmoidf_(ag[mi][0][r] * rstd);
      ag[mi][1][r] = sigmoidf_(ag[mi][1][r] * rstd);
    }
  f32x16 res[2][1], ap[2][1];
#pragma unroll
  for (int br = 0; br < 2; ++br) {
    zero_acc<1>(ap);
    const u16* Y = (const u16*)(p.ws + (br ? OFF_YH : OFF_YA)) + (size_t)m0 * 512;
    const u16* WP = (const u16*)(p.ws + (br ? OFF_WPH : OFF_WPA)) + (size_t)n0 * 512;
    gemm_loop<64, 1>(ap, Y, 512, WP, 512, 8, smem, tid);
#pragma unroll
    for (int mi = 0; mi < 2; ++mi)
#pragma unroll
      for (int r = 0; r < 16; ++r) {
        const float v = ag[mi][br][r] * ap[mi][0][r];
        res[mi][0][r] = br ? res[mi][0][r] + v : v;
      }
  }
  u16* M = (u16*)(p.ws + OFF_MERGED);
#pragma unroll
  for (int mi = 0; mi < 2; ++mi)
#pragma unroll
    for (int r = 0; r < 16; ++r) {
      const int tok = m0 + wm * 64 + mi * 32 + rowof(r, lane);
      M[(size_t)tok * 1024 + n0 + wn * 32 + lr] = f2bf(res[mi][0][r]);
    }
}

__device__ __forceinline__ void resid_item(const P& p, const u16* A, int K, const u16* W, float* rowss_next, int mt, int nt, char* smem,
                           int tid) {
  const int lane = tid & 63, w = tid >> 6, wm = w & 1, wn = w >> 1, lr = lane & 31;
  const int m0 = mt * 128, n0 = nt * 128;
  f32x16 acc[2][2];
  zero_acc<2>(acc);
  gemm_loop<128, 2>(acc, A + (size_t)m0 * K, K, W + (size_t)n0 * K, K, K >> 6, smem, tid);
  u16* XB = (u16*)(p.ws + OFF_XB);
  float myss = 0.f;
  int mytok = 0;
#pragma unroll
  for (int mi = 0; mi < 2; ++mi)
#pragma unroll
    for (int r = 0; r < 16; ++r) {
      const int tok = m0 + wm * 64 + mi * 32 + rowof(r, lane);
      float ss = 0.f;
#pragma unroll
      for (int ni = 0; ni < 2; ++ni) {
        const size_t o = (size_t)tok * 1024 + n0 + wn * 64 + ni * 32 + lr;
        const float xn = p.out[o] + acc[mi][ni][r];
        p.out[o] = xn;
        XB[o] = f2bf(xn);
        ss += xn * xn;
      }
#pragma unroll
      for (int of = 16; of >= 1; of >>= 1) ss += __shfl_xor(ss, of);
      if (lr == mi * 16 + r) { myss = ss; mytok = tok; }
      __builtin_amdgcn_sched_barrier(0);
    }
  rowss_next[(size_t)mytok * 16 + nt * 2 + wn] = myss;
}

__device__ __forceinline__ void e_item(const P& p, int l, int mt, int nt, char* smem, int tid) {
  const int lane = tid & 63, w = tid >> 6, wm = w & 1, wn = w >> 1, lr = lane & 31;
  const int m0 = mt * 128;
  float* rs = (float*)(smem + 65536);
  const float* rowss = (const float*)(p.ws + OFF_ROWSS) + (size_t)NTOK * 16;
  if (tid < 128) rs[tid] = row_rstd(rowss, m0 + tid);
  f32x16 acc[2][2];
  zero_acc<2>(acc);
  gemm_loop<128, 2>(acc, (const u16*)(p.ws + OFF_XB) + (size_t)m0 * 1024, 1024,
                    (const u16*)(p.ws + OFF_WFFI) + (size_t)nt * 128 * 1024, 1024, 16, smem, tid);
  u16* ACT = (u16*)(p.ws + OFF_ACT);
#pragma unroll
  for (int mi = 0; mi < 2; ++mi)
#pragma unroll
    for (int r = 0; r < 16; ++r) {
      const int tl = wm * 64 + mi * 32 + rowof(r, lane);
      const float rstd = rs[tl];
      const float gv = acc[mi][0][r] * rstd, uv = acc[mi][1][r] * rstd;
      ACT[(size_t)(m0 + tl) * DFF + nt * 64 + wn * 32 + lr] = f2bf(siluf_(gv) * uv);
    }
}

#ifndef ONLY_S
#define ONLY_S -1
#endif
#define EN(k) (ONLY_S < 0 || ONLY_S == (k))
template <class F>
__device__ __forceinline__ void for_tiles(int NT, int bid, int nb, F f) {
  if ((nb & 63) == 0) {
    const int vx = bid & 7, j = bid >> 3, JN = nb >> 6;
    const int jm = j & 7, jn = j >> 3;
    const int NG = (NT + JN - 1) / JN;
    const int wl = NT - (NG - 1) * JN;
    const bool fold = (wl * 2 == JN);
    const int NGF = fold ? NG - 1 : NG;
    for (int r = 0; r < 2 * NGF; ++r) {
      const int mh = r / NGF, ng = r - mh * NGF;
      const int mt = vx * 16 + mh * 8 + jm, nt = ng * JN + jn;
      if (nt < NT) f(mt, nt);
    }
    if (fold) f(vx * 16 + (jn / wl) * 8 + jm, (NG - 1) * JN + (jn % wl));
  } else {
    for (int it = bid; it < 128 * NT; it += nb) f(it / NT, it % NT);
  }
}
__device__ __forceinline__ int snake_item(int k, int bid, int nb) {
  return (k & 1) ? (((k + 1) * nb - 1 - bid) ^ 7) : (k * nb + bid);
}

__device__ __forceinline__ void run_phase(const P& p, int ph, char* smem) {
  int tid0 = threadIdx.x;
  asm volatile("" : "+v"(tid0));
  const int nb = gridDim.x;
  int bid = blockIdx.x;
  asm volatile("" : "+s"(bid));
#define LAUNDER int tid = tid0; asm volatile("" : "+v"(tid)); __syncthreads();
  if (ph == 0) {
    if (EN(11)) for (int it = bid; it < 4096 + 4128; it += nb) { LAUNDER
      if (it < 4096) p0_rows(p, it, tid); else conv_item(p, 0, it - 4096, smem, tid);
    }
    return;
  }
  const int l = (ph - 1) / 11, s = (ph - 1) % 11;
  float* rowss = (float*)(p.ws + OFF_ROWSS);
  switch (s) {
    case 0: if (EN(0)) {
      for_tiles(31, bid, nb, [&](int mt, int nt) { LAUNDER phaseA_tile(p, l, mt, nt, smem, tid); });
      if (l > 0) for (int it = bid; it < 704; it += nb) { LAUNDER conv_item(p, l, 3424 + it, smem, tid); }
    } break;
    case 1: if (EN(1)) for (int it = bid; it < 1024; it += nb) { LAUNDER h1_item(p, it, smem, tid); } break;
    case 2: if (EN(2)) for (int it = bid; it < 256; it += nb) { LAUNDER h2_item(p, it, tid); } break;
    case 3: if (EN(3)) for (int it = bid; it < 1024; it += nb) { LAUNDER h3_item(p, l, it, smem, tid); } break;
    case 4: if (EN(4)) for (int it = bid; it < 4160; it += nb) { LAUNDER b1_item(p, it, smem, tid); } break;
    case 5: if (EN(5)) { int tid = tid0; asm volatile("" : "+v"(tid)); b2_phase(p, bid, nb, smem, tid); } break;
    case 6: if (EN(6)) for (int k = 0; k * nb < 1024; ++k) { const int it = snake_item(k, bid, nb); if (it < 1024) { LAUNDER b3_item(p, l, it, smem, tid); } } break;
    case 7: if (EN(7)) for_tiles(16, bid, nb, [&](int mt, int nt) { LAUNDER d1_item(p, l, mt, nt, smem, tid); }); break;
    case 8:
      if (EN(8)) for_tiles(8, bid, nb, [&](int mt, int nt) { LAUNDER
        resid_item(p, (const u16*)(p.ws + OFF_MERGED), 1024, (const u16*)(p.ws + OFF_WOUT), rowss + (size_t)NTOK * 16, mt, nt, smem, tid); });
      break;
    case 9: if (EN(9)) for_tiles(44, bid, nb, [&](int mt, int nt) { LAUNDER e_item(p, l, mt, nt, smem, tid); }); break;
    case 10: if (EN(10)) {
      for_tiles(8, bid, nb, [&](int mt, int nt) { LAUNDER
        resid_item(p, (const u16*)(p.ws + OFF_ACT), DFF, (const u16*)(p.ws + OFF_WFFO), rowss, mt, nt, smem, tid); });
      if (l < 3) for (int it = bid; it < 3424; it += nb) { LAUNDER conv_item(p, l + 1, it, smem, tid); }
    } break;
  }
#undef LAUNDER
}

constexpr int NPHASE = 1 + 11 * DEPTH;

#ifndef REP_MASK
#define REP_MASK 0
#endif
#define XB_TMO      128
#define XB_XCNT(j)  (256  + 64 * (j))
#define XB_XSUB(j)  (1280 + 64 * (j))
#define XB_XGEN(j)  (2304 + 64 * (j))
#define XB_TOP      3328
#define XB_TOPGEN   3392
#define XCD_BAR_WORDS 3456
#define XB_SPIN_CAP (1u << 18)
#define LAS __attribute__((address_space(3)))

__device__ __forceinline__ unsigned xb_ld(unsigned* p)              { return __hip_atomic_load(p, __ATOMIC_RELAXED, __HIP_MEMORY_SCOPE_AGENT); }
__device__ __forceinline__ unsigned xb_add(unsigned* p, unsigned v) { return __hip_atomic_fetch_add(p, v, __ATOMIC_RELAXED, __HIP_MEMORY_SCOPE_AGENT); }
__device__ __forceinline__ unsigned xb_xcc_id() { return (unsigned)__builtin_amdgcn_s_getreg((3 << 11) | 20) & 0xFu; }
#define XB_SPIN(cond, bar) do { unsigned _sp = 0; while (cond) { __builtin_amdgcn_s_sleep(1); \
    if ((++_sp & 255u) == 0u) { if (xb_ld(&(bar)[XB_TMO])) break; if (_sp > XB_SPIN_CAP) { atomicAdd(&(bar)[XB_TMO], 1u); break; } } } } while (0)

struct XcdBarrier {
    unsigned* bar; unsigned x;
    volatile LAS unsigned* st;
};

__device__ __forceinline__ XcdBarrier xcd_barrier_post(unsigned* bar, volatile LAS unsigned* st) {
    XcdBarrier b; b.bar = bar; b.x = xb_xcc_id(); b.st = st;
    if (threadIdx.x == 0) (void)xb_add(&bar[XB_XCNT(b.x)], 1u);
    return b;
}
__device__ __forceinline__ void xcd_barrier_complete(unsigned* bar, unsigned x, unsigned& nloc, unsigned& nx) {
    const unsigned G = gridDim.x * gridDim.y * gridDim.z;
    unsigned sum, cnt, mine, sp = 0u;
    for (;;) {
        sum = 0u; cnt = 0u; mine = 0u;
#pragma unroll
        for (unsigned j = 0; j < 16; ++j) { const unsigned c = xb_ld(&bar[XB_XCNT(j)]); sum += c; cnt += (c > 0u) ? 1u : 0u; mine = (j == x) ? c : mine; }
        if (sum == G) break;
        __builtin_amdgcn_s_sleep(1);
        if ((++sp & 255u) == 0u) { if (xb_ld(&bar[XB_TMO])) break; if (sp > XB_SPIN_CAP) { atomicAdd(&bar[XB_TMO], 1u); break; } }
    }
    nloc = mine > 0u ? mine : 1u; nx = cnt > 0u ? cnt : 1u;
}

__device__ __forceinline__ void xcd_barrier(const XcdBarrier& b) {
    asm volatile("s_waitcnt vmcnt(0)" ::: "memory");
    __syncthreads();
    if (threadIdx.x == 0) {
        unsigned* bar = b.bar;
        __builtin_amdgcn_s_waitcnt(0);
        unsigned nloc = b.st[0], nx = b.st[1];
        if (nloc == 0u) { xcd_barrier_complete(bar, b.x, nloc, nx); b.st[0] = nloc; b.st[1] = nx; }
        const unsigned old = xb_add(&bar[XB_XSUB(b.x)], 1u);
        const unsigned gen = old / nloc;
        if (old + 1u == (gen + 1u) * nloc) {
            __builtin_amdgcn_fence(__ATOMIC_RELEASE, "agent");
            asm volatile("s_waitcnt vmcnt(0)" ::: "memory");
            const unsigned og = xb_add(&bar[XB_TOP], 1u);
            const unsigned tg = og / nx;
            if (og + 1u == (tg + 1u) * nx) xb_add(&bar[XB_TOPGEN], 1u);
            else XB_SPIN(xb_ld(&bar[XB_TOPGEN]) == tg, bar);
            __builtin_amdgcn_fence(__ATOMIC_ACQUIRE, "agent");
            xb_add(&bar[XB_XGEN(b.x)], 1u);
            asm volatile("s_waitcnt vmcnt(0)" ::: "memory");
        } else {
            XB_SPIN(xb_ld(&bar[XB_XGEN(b.x)]) == gen, bar);
            __builtin_amdgcn_fence(__ATOMIC_ACQUIRE, "agent");
            asm volatile("s_waitcnt vmcnt(0)" ::: "memory");
        }
    }
    __syncthreads();
}


template <bool COOP>
__global__ void __launch_bounds__(256, 2) mega(P p, int ph0, int ph1) {
  __shared__ __attribute__((aligned(16))) char smem[66560];
  __shared__ uint4 xb_words;
  if (threadIdx.x == 0) xb_words = make_uint4(0u, 0u, 0u, 0u);
  __syncthreads();
  XcdBarrier xb = xcd_barrier_post((unsigned*)(p.ws + OFF_BAR), (volatile LAS unsigned*)&xb_words);
  for (int ph = ph0; ph < ph1; ++ph) {
    int reps = 1;
    if (REP_MASK != 0 && ph > 0 && ((REP_MASK >> ((ph - 1) % 11)) & 1)) reps = 2;
    for (int rp = 0; rp < reps; ++rp) {
      run_phase(p, ph, smem);
      if (COOP) {
        if (ph + 1 < ph1 || rp + 1 < reps) {
          if (ph == 0) cg::this_grid().sync();
          else xcd_barrier(xb);
        }
      }
    }
  }
}

extern "C" void kernel_launch(void* const* d_in, const int* in_sizes, int n_in, void* d_out, int out_size, void* d_ws,
                              size_t ws_size, hipStream_t stream) {
  if (ws_size < WS_END) { fprintf(stderr, "workspace too small: %zu\n", ws_size); return; }
  P p{};
  p.x = (const float*)d_in[0]; p.pos = (const int*)d_in[1]; p.w_in = (const float*)d_in[2];
  p.w_pa = (const float*)d_in[3]; p.w_ph = (const float*)d_in[4]; p.w_out = (const float*)d_in[5];
  p.nmix = (const float*)d_in[6]; p.nffn = (const float*)d_in[7]; p.qn = (const float*)d_in[8];
  p.kn = (const float*)d_in[9]; p.hn = (const float*)d_in[10]; p.hlb = (const float*)d_in[11];
  p.w_ffi = (const float*)d_in[12]; p.w_ffo = (const float*)d_in[13];
  p.out = (float*)d_out; p.ws = (char*)d_ws;
#if COOP_MODE
  static int grid_blocks = 0;
  if (!grid_blocks) {
    int dev = 0, cus = 0, per_cu = 0;
    hipGetDevice(&dev);
    hipDeviceGetAttribute(&cus, hipDeviceAttributeMultiprocessorCount, dev);
    hipOccupancyMaxActiveBlocksPerMultiprocessor(&per_cu, mega<true>, 256, 0);
    if (per_cu > 2) per_cu = 2;
    grid_blocks = cus * per_cu;
  }
  int ph0 = 0, ph1 = NPHASE;
  hipMemsetAsync((char*)d_ws + OFF_BAR, 0, 16384, stream);
  void* args[] = {&p, &ph0, &ph1};
  hipError_t e = hipLaunchCooperativeKernel((void*)mega<true>, dim3(grid_blocks), dim3(256), args, 0, stream);
  if (e != hipSuccess) fprintf(stderr, "cooperative launch failed: %s (grid %d)\n", hipGetErrorString(e), grid_blocks);
#else
  for (int ph = 0; ph < NPHASE; ++ph) mega<false><<<dim3(512), dim3(256), 0, stream>>>(p, ph, ph + 1);
#endif
}
```

```cpp
#include <hip/hip_runtime.h>
#include <hip/hip_cooperative_groups.h>
#include <stdint.h>
#include <stdio.h>
namespace cg = cooperative_groups;

#ifndef COOP_MODE
#define COOP_MODE 1
#endif

typedef unsigned short u16;
typedef unsigned int u32;
typedef unsigned long long u64;
typedef __attribute__((ext_vector_type(8))) short bf16x8;
typedef __attribute__((ext_vector_type(16))) float f32x16;
typedef __attribute__((ext_vector_type(4))) u32 u32x4;
typedef __attribute__((ext_vector_type(2))) u32 u32x2;
typedef __attribute__((ext_vector_type(2))) unsigned short u16x2;

constexpr int NTOK = 16384, SEQ = 8192, DEPTH = 4;
constexpr int DFF = 2816;
constexpr float EPS = 1e-6f;
constexpr size_t MiB = (size_t)1 << 20;
constexpr size_t OFF_WIN = 0, OFF_WGATE = 8 * MiB, OFF_WPA = 12 * MiB, OFF_WPH = 13 * MiB, OFF_WOUT = 14 * MiB,
                 OFF_WFFI = 16 * MiB, OFF_WFFO = 27 * MiB, OFF_AQ = 33 * MiB, OFF_AK = 49 * MiB, OFF_AVT = 65 * MiB,
                 OFF_IQ = 81 * MiB, OFF_IK = 89 * MiB, OFF_IW = 91 * MiB, OFF_HQ = 92 * MiB, OFF_HVT = 108 * MiB,
                 OFF_HG = 124 * MiB, OFF_LOGF = 140 * MiB, OFF_XB = 172 * MiB, OFF_YH = 204 * MiB, OFF_MASK = 220 * MiB,
                 OFF_ROWSS = 236 * MiB, OFF_CODES = 238 * MiB, OFF_YA = OFF_CODES, OFF_US = OFF_CODES + 16 * MiB,
                 OFF_GDEC = OFF_CODES + 48 * MiB, OFF_MERGED = OFF_AQ, OFF_ACT = OFF_AQ, OFF_BAR = 32 * MiB + 768 * 1024, WS_END = 368 * MiB;
constexpr size_t CODES_PER_BATCH = (size_t)16384 * 2080;

struct P {
  const float* x; const int* pos; const float* w_in; const float* w_pa; const float* w_ph; const float* w_out;
  const float* nmix; const float* nffn; const float* qn; const float* kn; const float* hn; const float* hlb;
  const float* w_ffi; const float* w_ffo; float* out; char* ws;
};

__device__ __forceinline__ u16 f2bf(float f) {
  u32 u = __float_as_uint(f);
  u += 0x7FFFu + ((u >> 16) & 1u);
  return (u16)(u >> 16);
}
__device__ __forceinline__ float bf2f(u16 v) { return __uint_as_float(((u32)v) << 16); }
__device__ __forceinline__ u32 pack2(float a, float b) { u32 r; asm("v_cvt_pk_bf16_f32 %0, %1, %2" : "=v"(r) : "v"(a), "v"(b)); return r; }
__device__ __forceinline__ float wave_sum(float v) {
#pragma unroll
  for (int o = 32; o >= 1; o >>= 1) v += __shfl_xor(v, o);
  return v;
}
__device__ __forceinline__ float sigmoidf_(float x) { return 1.f / (1.f + __expf(-x)); }
__device__ __forceinline__ float siluf_(float x) { return x / (1.f + __expf(-x)); }

template <int ROWS>
__device__ __forceinline__ void g2r(u32x4 (&r)[ROWS / 32], const u16* g, size_t ld, int tid) {
  const int c = tid & 7, row = tid >> 3;
#pragma unroll
  for (int i = 0; i < ROWS / 32; ++i) r[i] = *(const u32x4*)(g + (size_t)(row + 32 * i) * ld + c * 8);
}
template <int ROWS>
__device__ __forceinline__ void r2s(const u32x4 (&r)[ROWS / 32], char* s, int tid) {
  const int c = tid & 7, row = tid >> 3;
#pragma unroll
  for (int i = 0; i < ROWS / 32; ++i) {
    const int rr = row + 32 * i;
    *(u32x4*)(s + rr * 128 + ((c ^ ((rr >> 1) & 7)) << 4)) = r[i];
  }
}
__device__ __forceinline__ bf16x8 lds_frag(const char* s, int row, int kc) {
  return *(const bf16x8*)(s + row * 128 + ((kc ^ ((row >> 1) & 7)) << 4));
}
__device__ __forceinline__ int rowof(int reg, int lane) { return (reg & 3) + 8 * (reg >> 2) + 4 * (lane >> 5); }

template <int MI, int NI>
__device__ __forceinline__ void mma_tile(f32x16 (&acc)[MI][NI], const char* xs, int xrow0, const char* ys, int yrow0,
                                         int lane) {
  const int r = lane & 31, h = lane >> 5;
  bf16x8 a[2][MI], b[2][NI];
#pragma unroll
  for (int mi = 0; mi < MI; ++mi) a[0][mi] = lds_frag(xs, xrow0 + mi * 32 + r, h);
#pragma unroll
  for (int ni = 0; ni < NI; ++ni) b[0][ni] = lds_frag(ys, yrow0 + ni * 32 + r, h);
#pragma unroll
  for (int ks = 0; ks < 4; ++ks) {
    const int c = ks & 1, n = c ^ 1;
    if (ks < 3) {
#pragma unroll
      for (int mi = 0; mi < MI; ++mi) a[n][mi] = lds_frag(xs, xrow0 + mi * 32 + r, (ks + 1) * 2 + h);
#pragma unroll
      for (int ni = 0; ni < NI; ++ni) b[n][ni] = lds_frag(ys, yrow0 + ni * 32 + r, (ks + 1) * 2 + h);
    }
    __builtin_amdgcn_sched_barrier(0);
#pragma unroll
    for (int mi = 0; mi < MI; ++mi)
#pragma unroll
      for (int ni = 0; ni < NI; ++ni)
        acc[mi][ni] = __builtin_amdgcn_mfma_f32_32x32x16_bf16(a[c][mi], b[c][ni], acc[mi][ni], 0, 0, 0);
    __builtin_amdgcn_sched_barrier(0);
  }
}

template <int YR, int NI>
__device__ __forceinline__ void gemm_loop_shallow(f32x16 (&acc)[2][NI], const u16* X, size_t ldx, const u16* Y, size_t ldy,
                                          int KT, char* smem, int tid) {
  const int lane = tid & 63, w = tid >> 6, wm = w & 1, wn = w >> 1;
  char* xs = smem;
  char* ys = smem + 32768;
  u32x4 xr[4], yr[YR / 32];
  g2r<128>(xr, X, ldx, tid);
  g2r<YR>(yr, Y, ldy, tid);
  r2s<128>(xr, xs, tid);
  r2s<YR>(yr, ys, tid);
  __syncthreads();
#pragma unroll 1
  for (int kt = 0; kt < KT; ++kt) {
    const int cur = kt & 1;
    if (kt + 1 < KT) {
      g2r<128>(xr, X + (size_t)(kt + 1) * 64, ldx, tid);
      g2r<YR>(yr, Y + (size_t)(kt + 1) * 64, ldy, tid);
    }
    mma_tile<2, NI>(acc, xs + cur * 16384, wm * 64, ys + cur * (YR * 128), wn * 32 * NI, lane);
    if (kt + 1 < KT) {
      r2s<128>(xr, xs + (cur ^ 1) * 16384, tid);
      r2s<YR>(yr, ys + (cur ^ 1) * (YR * 128), tid);
    }
    __syncthreads();
  }
}
template <int YR, int NI>
__device__ __forceinline__ void gemm_loop_deep(f32x16 (&acc)[2][NI], const u16* X, size_t ldx, const u16* Y, size_t ldy,
                                          int KT, char* smem, int tid) {
  const int lane = tid & 63, w = tid >> 6, wm = w & 1, wn = w >> 1;
  char* xs = smem;
  char* ys = smem + 32768;
  u32x4 xa[4], ya[YR / 32], xb[4], yb[YR / 32];
  g2r<128>(xa, X, ldx, tid);
  g2r<YR>(ya, Y, ldy, tid);
  g2r<128>(xb, X + 64, ldx, tid);
  g2r<YR>(yb, Y + 64, ldy, tid);
  r2s<128>(xa, xs, tid);
  r2s<YR>(ya, ys, tid);
  __syncthreads();
#pragma unroll 1
  for (int kt = 0; kt < KT; kt += 2) {
    if (kt + 2 < KT) {
      g2r<128>(xa, X + (size_t)(kt + 2) * 64, ldx, tid);
      g2r<YR>(ya, Y + (size_t)(kt + 2) * 64, ldy, tid);
    }
    mma_tile<2, NI>(acc, xs, wm * 64, ys, wn * 32 * NI, lane);
    r2s<128>(xb, xs + 16384, tid);
    r2s<YR>(yb, ys + YR * 128, tid);
    __syncthreads();
    if (kt + 3 < KT) {
      g2r<128>(xb, X + (size_t)(kt + 3) * 64, ldx, tid);
      g2r<YR>(yb, Y + (size_t)(kt + 3) * 64, ldy, tid);
    }
    mma_tile<2, NI>(acc, xs + 16384, wm * 64, ys + YR * 128, wn * 32 * NI, lane);
    if (kt + 2 < KT) {
      r2s<128>(xa, xs, tid);
      r2s<YR>(ya, ys, tid);
    }
    __syncthreads();
  }
}
template <int YR, int NI>
__device__ __forceinline__ void gemm_loop(f32x16 (&acc)[2][NI], const u16* X, size_t ldx, const u16* Y, size_t ldy,
                                          int KT, char* smem, int tid) {
  if constexpr (YR == 128) gemm_loop_deep<YR, NI>(acc, X, ldx, Y, ldy, KT, smem, tid);
  else gemm_loop_shallow<YR, NI>(acc, X, ldx, Y, ldy, KT, smem, tid);
}
template <int NI>
__device__ __forceinline__ void zero_acc(f32x16 (&acc)[2][NI]) {
#pragma unroll
  for (int mi = 0; mi < 2; ++mi)
#pragma unroll
    for (int ni = 0; ni < NI; ++ni)
#pragma unroll
      for (int r = 0; r < 16; ++r) acc[mi][ni][r] = 0.f;
}

__device__ __forceinline__ int conv_map(int mode, int n) {
  if (mode == 0) return n < 1860 ? n : (n < 1920 ? -1 : n - 60);
  if (mode == 1) {
    const int tile = n >> 7, r = n & 127, sub = r >> 5;
    return 3908 + (sub & 1) * 1024 + tile * 64 + (sub >> 1) * 32 + (r & 31);
  }
  if (mode == 3) {
    const int tile = n >> 7, r = n & 127, sub = r >> 5;
    const int j = tile * 64 + (sub >> 1) * 32 + (r & 31);
    return (sub & 1) ? DFF + j : j;
  }
  return n;
}
__device__ __forceinline__ void conv_tile(const float* src, int ld, int K, int mode, const float* scale, u16* dst, int tile, float* lds,
                          int tid) {
  const int ktiles = K >> 6;
  const int ntile = tile / ktiles, ktile = tile - ntile * ktiles;
  const int n0 = ntile * 64, k0 = ktile * 64;
  const int n4 = (tid & 15) * 4, kq = tid >> 4;
  const int col = conv_map(mode, n0 + n4);
  float4 vv[4];
#pragma unroll
  for (int i = 0; i < 4; ++i) {
    const int k = kq + 16 * i;
    vv[i] = (col >= 0) ? *(const float4*)(src + (size_t)(k0 + k) * ld + col) : float4{0.f, 0.f, 0.f, 0.f};
    if (scale) { const float sc = scale[k0 + k]; vv[i].x *= sc; vv[i].y *= sc; vv[i].z *= sc; vv[i].w *= sc; }
  }
#pragma unroll
  for (int i = 0; i < 4; ++i) {
    float* d = lds + (kq + 16 * i) * 65 + n4;
    d[0] = vv[i].x; d[1] = vv[i].y; d[2] = vv[i].z; d[3] = vv[i].w;
  }
  __syncthreads();
  const int nr = tid >> 2, part = tid & 3;
  u32 o[8];
#pragma unroll
  for (int i = 0; i < 8; ++i)
    o[i] = pack2(lds[(part * 16 + 2 * i) * 65 + nr], lds[(part * 16 + 2 * i + 1) * 65 + nr]);
  u32x4* d = (u32x4*)(dst + (size_t)(n0 + nr) * K + k0 + part * 16);
  d[0] = u32x4{o[0], o[1], o[2], o[3]};
  d[1] = u32x4{o[4], o[5], o[6], o[7]};
}
__device__ __forceinline__ void conv_item(const P& p, int l, int c, char* smem, int tid) {
  const float* src; int ld, K, mode; const float* scale = nullptr; u16* dst;
  if (c < 992) { src = p.w_in + (size_t)l * 1024 * 5956; ld = 5956; K = 1024; mode = 0; scale = p.nmix + l * 1024; dst = (u16*)(p.ws + OFF_WIN); }
  else if (c < 1504) { c -= 992; src = p.w_in + (size_t)l * 1024 * 5956; ld = 5956; K = 1024; mode = 1; scale = p.nmix + l * 1024; dst = (u16*)(p.ws + OFF_WGATE); }
  else if (c < 1632) { c -= 1504; src = p.w_pa + (size_t)l * 512 * 1024; ld = 1024; K = 512; mode = 2; dst = (u16*)(p.ws + OFF_WPA); }
  else if (c < 1760) { c -= 1632; src = p.w_ph + (size_t)l * 512 * 1024; ld = 1024; K = 512; mode = 2; dst = (u16*)(p.ws + OFF_WPH); }
  else if (c < 2016) { c -= 1760; src = p.w_out + (size_t)l * 1024 * 1024; ld = 1024; K = 1024; mode = 2; dst = (u16*)(p.ws + OFF_WOUT); }
  else if (c < 3424) { c -= 2016; src = p.w_ffi + (size_t)l * 1024 * 5632; ld = 5632; K = 1024; mode = 3; scale = p.nffn + l * 1024; dst = (u16*)(p.ws + OFF_WFFI); }
  else { c -= 3424; src = p.w_ffo + (size_t)l * DFF * 1024; ld = 1024; K = DFF; mode = 2; dst = (u16*)(p.ws + OFF_WFFO); }
  conv_tile(src, ld, K, mode, scale, dst, c, (float*)smem, tid);
}

__device__ __forceinline__ void p0_rows(const P& p, int item, int tid) {
  const int lane = tid & 63, w = tid >> 6;
  const int tok = item * 4 + w;
  const float4* xr = (const float4*)(p.x + (size_t)tok * 1024);
  float4* orow = (float4*)(p.out + (size_t)tok * 1024);
  u32x2* xb = (u32x2*)(p.ws + OFF_XB + (size_t)tok * 2048);
  float ss = 0.f;
#pragma unroll
  for (int i = 0; i < 4; ++i) {
    float4 v = xr[lane + 64 * i];
    ss += v.x * v.x + v.y * v.y + v.z * v.z + v.w * v.w;
    orow[lane + 64 * i] = v;
    xb[lane + 64 * i] = u32x2{pack2(v.x, v.y), pack2(v.z, v.w)};
  }
  ss = wave_sum(ss);
  float* rowss = (float*)(p.ws + OFF_ROWSS);
  if (lane < 16) rowss[(size_t)tok * 16 + lane] = lane == 0 ? ss : 0.f;
}


__device__ __forceinline__ float row_rstd(const float* part, int tok) {
  const float4* q = (const float4*)(part + (size_t)tok * 16);
  const float4 a = q[0], b = q[1], c = q[2], d = q[3];
  const float ss = ((a.x + a.y) + (a.z + a.w)) + ((b.x + b.y) + (b.z + b.w)) + ((c.x + c.y) + (c.z + c.w)) + ((d.x + d.y) + (d.z + d.w));
  return rsqrtf(ss * (1.f / 1024.f) + EPS);
}
__device__ __forceinline__ void rope_cs(int pos, int d1, float& c, float& s) {
  const float inv = exp2f(-(float)d1 * (13.287712379549449f / 32.f));
  const float ang = (float)pos * inv;
  double rv = (double)ang * 0.15915494309189535;
  rv -= floor(rv);
  const float r = (float)rv;
  c = __builtin_amdgcn_cosf(r);
  s = __builtin_amdgcn_sinf(r);
}

__device__ __forceinline__ void phaseA_tile(const P& p, int l, int mt, int nt, char* smem, int tid) {
  const int lane = tid & 63, w = tid >> 6, wm = w & 1, wn = w >> 1, h = lane >> 5, lr = lane & 31;
  const int m0 = mt * 128;
  float* rs = (float*)(smem + 65536);
  const float* rowss = (const float*)(p.ws + OFF_ROWSS);
  if (tid < 128) rs[tid] = row_rstd(rowss, m0 + tid);
  const u16* XB = (const u16*)(p.ws + OFF_XB) + (size_t)m0 * 1024;
  const u16* W = (const u16*)(p.ws + OFF_WIN) + (size_t)nt * 128 * 1024;
  const bool fr = (nt < 15) || (nt >= 23 && nt < 27);
  f32x16 acc[2][2];
  zero_acc<2>(acc);
  if (fr) gemm_loop<128, 2>(acc, W, 1024, XB, 1024, 16, smem, tid);
  else gemm_loop<128, 2>(acc, XB, 1024, W, 1024, 16, smem, tid);

  if (fr) {
    if (nt < 8 || (nt >= 12 && nt < 15)) {
      const bool isidx = nt >= 12;
      const int fbase = isidx ? (nt - 12) * 128 + wm * 64 : nt * 128 + wm * 64;
      if (isidx && nt == 14 && wm == 1) {
#pragma unroll
        for (int ni = 0; ni < 2; ++ni) {
          const int tl = wn * 64 + ni * 32 + lr;
          const float rstd = rs[tl] * 0.5f;
          if (h == 0) {
            float4 o = {acc[0][ni][0] * rstd, acc[0][ni][1] * rstd, acc[0][ni][2] * rstd, acc[0][ni][3] * rstd};
            *(float4*)(p.ws + OFF_IW + (size_t)(m0 + tl) * 16) = o;
          }
        }
        return;
      }
      const bool isk = (!isidx) && fbase >= 512;
      const int head = isidx ? (nt == 14 ? 0 : (fbase >> 6)) : ((fbase & 511) >> 6);
      const float* nw = isidx ? nullptr : (isk ? p.kn + l * 64 : p.qn + l * 64);
      u16* dst; int dld;
      float oscale = 1.f;
      if (!isidx) { dst = (u16*)(p.ws + (isk ? OFF_AK : OFF_AQ)); dld = 512; if (!isk) oscale = 0.125f * 1.4426950408889634f; }
      else if (nt < 14) { dst = (u16*)(p.ws + OFF_IQ); dld = 256; oscale = 0.125f; }
      else { dst = (u16*)(p.ws + OFF_IK); dld = 64; }
#pragma unroll
      for (int ni = 0; ni < 2; ++ni) {
        const int tl = wn * 64 + ni * 32 + lr;
        const int tok = m0 + tl;
        const float rstd = rs[tl];
        const int pos = p.pos[tok];
        float rn = rstd;
        if (!isidx) {
          float ss = 0.f;
#pragma unroll
          for (int mi = 0; mi < 2; ++mi)
#pragma unroll
            for (int r = 0; r < 16; ++r) { const float v = acc[mi][ni][r] * rstd; ss += v * v; }
          ss += __shfl_xor(ss, 32);
          rn = rstd * rsqrtf(ss * (1.f / 64.f) + EPS);
        }
        u16* drow = dst + (size_t)tok * dld + head * 64;
#pragma unroll
        for (int rg = 0; rg < 4; ++rg) {
          float o1[4], o2[4];
#pragma unroll
          for (int j = 0; j < 4; ++j) {
            const int r = rg * 4 + j;
            const int d1 = j + 8 * rg + 4 * h;
            float x1 = acc[0][ni][r] * rn, x2 = acc[1][ni][r] * rn;
            if (!isidx) { x1 *= nw[d1]; x2 *= nw[d1 + 32]; }
            float c, s;
            rope_cs(pos, d1, c, s);
            o1[j] = (x1 * c - x2 * s) * oscale;
            o2[j] = (x2 * c + x1 * s) * oscale;
          }
          const int d1b = 8 * rg + 4 * h;
          *(u32x2*)(drow + d1b) = u32x2{pack2(o1[0], o1[1]), pack2(o1[2], o1[3])};
          *(u32x2*)(drow + d1b + 32) = u32x2{pack2(o2[0], o2[1]), pack2(o2[2], o2[3])};
          __builtin_amdgcn_sched_barrier(0);
        }
      }
    } else {
      const bool isav = nt < 12;
      u16* dst = (u16*)(p.ws + (isav ? OFF_AVT : OFF_HVT));
#pragma unroll
      for (int ni = 0; ni < 2; ++ni) {
        const int tl = wn * 64 + ni * 32 + lr;
        const int tok = m0 + tl;
        const float rstd = rs[tl];
        const int b = tok >> 13, t = tok & 8191;
#pragma unroll
        for (int mi = 0; mi < 2; ++mi)
#pragma unroll
          for (int r = 0; r < 16; ++r) {
            const int f = (isav ? (nt - 8) : (nt - 23)) * 128 + wm * 64 + mi * 32 + rowof(r, lane);
            dst[((size_t)(b * 512 + f)) * 8192 + t] = f2bf(acc[mi][ni][r] * rstd);
            if ((r & 3) == 3) __builtin_amdgcn_sched_barrier(0);
          }
      }
    }
  } else {
    const int seg = (nt - 15) >> 2;
    const int fb = ((nt - 15) & 3) * 128 + wn * 64;
#pragma unroll
    for (int ni = 0; ni < 2; ++ni) {
      const int f = fb + ni * 32 + lr;
      float lb = 0.f;
      if (seg == 1) {
        float e[4], mx = -1e30f;
#pragma unroll
        for (int i = 0; i < 4; ++i) { e[i] = p.hlb[i * 512 + f]; mx = fmaxf(mx, e[i]); }
        float tot = 0.f, part = 0.f;
#pragma unroll
        for (int i = 0; i < 4; ++i) { e[i] = __expf(e[i] - mx); tot += e[i]; if (i >= 1 && i <= l) part += e[i]; }
        lb = part / tot;
      }
#pragma unroll
      for (int mi = 0; mi < 2; ++mi)
#pragma unroll
        for (int r = 0; r < 16; ++r) {
          const int tl = wm * 64 + mi * 32 + rowof(r, lane);
          const float v = acc[mi][ni][r] * rs[tl];
          const size_t o = (size_t)(m0 + tl) * 512 + f;
          if (seg == 0) ((u16*)(p.ws + OFF_HQ))[o] = f2bf(siluf_(v));
          else if (seg == 3) ((u16*)(p.ws + OFF_HG))[o] = f2bf(siluf_(v));
          else {
            const float sg = 1.f / (1.f + __expf(-v));
            ((float*)(p.ws + OFF_LOGF))[o] = logf(lb + (1.f - lb) * sg);
          }
          if ((r & 3) == 3) __builtin_amdgcn_sched_barrier(0);
        }
    }
  }
}

__device__ __forceinline__ void hgrn_load_cumsum(const P& p, int tok0, int hh, int d, int hf, float (&lf)[32],
                                                 float (&cs)[32]) {
  const float* src = (const float*)(p.ws + OFF_LOGF) + (size_t)(tok0 + hf * 32) * 512 + hh * 128 + d;
#pragma unroll
  for (int i = 0; i < 32; ++i) lf[i] = src[(size_t)i * 512];
  float run = 0.f;
#pragma unroll
  for (int i = 0; i < 32; ++i) { run += lf[i]; cs[i] = run; }
}
__device__ __forceinline__ void put_td(char* base, int t, int d, float v) {
  const int kt = d >> 6, dd = d & 63;
  *(u16*)(base + kt * 8192 + t * 128 + (((dd >> 3) ^ ((t >> 1) & 7)) << 4) + (dd & 7) * 2) = f2bf(v);
}

__device__ __forceinline__ void h1_item(const P& p, int item, char* smem, int tid) {
  const int lane = tid & 63, w = tid >> 6, wm = w & 1, wn = w >> 1;
  const int b = item >> 9, hh = (item >> 7) & 3, c = item & 127;
  const int tok0 = b * SEQ + c * 64;
  const int d = tid & 127, hf = tid >> 7;
  char* vts = smem;
  char* kts = smem + 16384;
  float* tot = (float*)(smem + 65536);
  u32x4 vr[4];
  g2r<128>(vr, (const u16*)(p.ws + OFF_HVT) + ((size_t)(b * 512 + hh * 128)) * 8192 + c * 64, 8192, tid);
  float lf[32], cs[32];
  hgrn_load_cumsum(p, tok0, hh, d, hf, lf, cs);
  tot[hf * 128 + d] = cs[31];
  r2s<128>(vr, vts, tid);
  __syncthreads();
  const float after = hf ? 0.f : tot[128 + d];
  if (hf) ((float*)(p.ws + OFF_GDEC))[(size_t)item * 128 + d] = __expf(cs[31] + tot[d]);
#pragma unroll
  for (int ch = 0; ch < 4; ++ch) {
    u32 o[4];
#pragma unroll
    for (int j = 0; j < 4; ++j) {
      const int i0 = ch * 8 + 2 * j;
      const float k0 = (1.f - __expf(lf[i0])) * __expf(cs[31] - cs[i0] + after);
      const float k1 = (1.f - __expf(lf[i0 + 1])) * __expf(cs[31] - cs[i0 + 1] + after);
      o[j] = pack2(k0, k1);
    }
    const int chunk = hf * 4 + ch;
    *(u32x4*)(kts + d * 128 + ((chunk ^ ((d >> 1) & 7)) << 4)) = u32x4{o[0], o[1], o[2], o[3]};
  }
  __syncthreads();
  f32x16 acc[2][2];
  zero_acc<2>(acc);
  mma_tile<2, 2>(acc, vts, wm * 64, kts, wn * 64, lane);
  u16* us = (u16*)(p.ws + OFF_US) + (size_t)item * 16384;
#pragma unroll
  for (int mi = 0; mi < 2; ++mi)
#pragma unroll
    for (int ni = 0; ni < 2; ++ni)
#pragma unroll
      for (int r = 0; r < 16; ++r) {
        const int e = wm * 64 + mi * 32 + rowof(r, lane);
        const int dd = wn * 64 + ni * 32 + (lane & 31);
        us[e * 128 + dd] = f2bf(acc[mi][ni][r]);
      }
}

__device__ __forceinline__ void h2_item(const P& p, int item, int tid) {
  const int g = item * 256 + tid;
  const int bh = g >> 13, e = (g >> 6) & 127, dp = g & 63;
  float s0 = 0.f, s1 = 0.f;
  u32* us = (u32*)(p.ws + OFF_US) + (size_t)bh * 128 * 8192 + e * 64 + dp;
  const float2* gd = (const float2*)(p.ws + OFF_GDEC) + (size_t)bh * 128 * 64 + dp;
#pragma unroll 1
  for (int c0 = 0; c0 < 128; c0 += 16) {
    u32 u[16];
    float2 g2[16];
#pragma unroll
    for (int i = 0; i < 16; ++i) { u[i] = us[(size_t)(c0 + i) * 8192]; g2[i] = gd[(c0 + i) * 64]; }
#pragma unroll
    for (int i = 0; i < 16; ++i) {
      us[(size_t)(c0 + i) * 8192] = pack2(s0, s1);
      s0 = g2[i].x * s0 + bf2f((u16)(u[i] & 0xFFFF));
      s1 = g2[i].y * s1 + bf2f((u16)(u[i] >> 16));
    }
  }
}

__device__ __forceinline__ void h3_item(const P& p, int l, int item, char* smem, int tid) {
  const int lane = tid & 63, w = tid >> 6, h = lane >> 5, lr = lane & 31;
  const int b = item >> 9, hh = (item >> 7) & 3, c = item & 127;
  const int tok0 = b * SEQ + c * 64;
  const int d = tid & 127, hf = tid >> 7;
  char* R0 = smem;
  char* R1 = smem + 16384;
  char* R2 = smem + 32768;
  char* R3 = smem + 49152;
  float* tot = (float*)(smem + 65536);
  const u16* usb = (const u16*)(p.ws + OFF_US) + (size_t)item * 16384;
  u32x4 vr[4], s0r[4], s1r[4];
  g2r<128>(vr, (const u16*)(p.ws + OFF_HVT) + ((size_t)(b * 512 + hh * 128)) * 8192 + c * 64, 8192, tid);
  g2r<128>(s0r, usb, 128, tid);
  g2r<128>(s1r, usb + 64, 128, tid);
  float lf[32], cs[32], q[32];
  hgrn_load_cumsum(p, tok0, hh, d, hf, lf, cs);
  {
    const u16* qs = (const u16*)(p.ws + OFF_HQ) + (size_t)(tok0 + hf * 32) * 512 + hh * 128 + d;
#pragma unroll
    for (int i = 0; i < 32; ++i) q[i] = bf2f(qs[(size_t)i * 512]);
  }
  if (hf == 0) tot[d] = cs[31];
  r2s<128>(vr, R3, tid);
  r2s<128>(s0r, R2, tid);
  __syncthreads();
  const float t0 = tot[d];
#pragma unroll
  for (int i = 0; i < 32; ++i) {
    const int t = hf * 32 + i;
    const float rel = hf ? cs[i] : cs[i] - t0;
    put_td(R0, t, d, q[i] * __expf(rel));
    put_td(R1, t, d, (1.f - __expf(lf[i])) * __expf(-rel));
  }
  __syncthreads();
  {
    const int sb = w & 1, tb = w >> 1;
    f32x16 a1[1][1];
#pragma unroll
    for (int r = 0; r < 16; ++r) a1[0][0][r] = 0.f;
    if (sb <= tb) {
      mma_tile<1, 1>(a1, R1, sb * 32, R0, tb * 32, lane);
      mma_tile<1, 1>(a1, R1 + 8192, sb * 32, R0 + 8192, tb * 32, lane);
    }
    __syncthreads();
    const int t = tb * 32 + lr;
#pragma unroll
    for (int rg = 0; rg < 4; ++rg) {
      float v[4];
#pragma unroll
      for (int j = 0; j < 4; ++j) {
        const int s = sb * 32 + 8 * rg + 4 * h + j;
        v[j] = (s <= t) ? a1[0][0][rg * 4 + j] : 0.f;
      }
      const int s0 = sb * 32 + 8 * rg + 4 * h;
      *(u32x2*)(R1 + t * 128 + (((s0 >> 3) ^ ((t >> 1) & 7)) << 4) + (s0 & 7) * 2) =
          u32x2{pack2(v[0], v[1]), pack2(v[2], v[3])};
    }
#pragma unroll
    for (int i = 0; i < 32; ++i) {
      const int tt = hf * 32 + i;
      put_td(R0, tt, d, q[i] * __expf(hf ? cs[i] + t0 : cs[i]));
    }
  }
  __syncthreads();
  f32x16 o[1][2];
#pragma unroll
  for (int ni = 0; ni < 2; ++ni)
#pragma unroll
    for (int r = 0; r < 16; ++r) o[0][ni][r] = 0.f;
  mma_tile<1, 2>(o, R2, w * 32, R0, 0, lane);
  mma_tile<1, 2>(o, R3, w * 32, R1, 0, lane);
  __syncthreads();
  r2s<128>(s1r, R2, tid);
  __syncthreads();
  mma_tile<1, 2>(o, R2, w * 32, R0 + 8192, 0, lane);
  float* red = tot;
#pragma unroll
  for (int ni = 0; ni < 2; ++ni) {
    float ss = 0.f;
#pragma unroll
    for (int r = 0; r < 16; ++r) ss += o[0][ni][r] * o[0][ni][r];
    ss += __shfl_xor(ss, 32);
    if (h == 0) red[w * 64 + ni * 32 + lr] = ss;
  }
  __syncthreads();
#pragma unroll
  for (int ni = 0; ni < 2; ++ni) {
    const int t = ni * 32 + lr;
    const float ss = red[t] + red[64 + t] + red[128 + t] + red[192 + t];
    const float rn = rsqrtf(ss * (1.f / 128.f) + EPS);
    const size_t rowo = (size_t)(tok0 + t) * 512 + hh * 128;
#pragma unroll
    for (int rg = 0; rg < 4; ++rg) {
      const int e0 = w * 32 + 8 * rg + 4 * h;
      const u32x2 gg = *(const u32x2*)((const u16*)(p.ws + OFF_HG) + rowo + e0);
      const float4 nw = *(const float4*)(p.hn + l * 128 + e0);
      const float y0 = o[0][ni][rg * 4 + 0] * rn * nw.x * bf2f((u16)(gg.x & 0xFFFF));
      const float y1 = o[0][ni][rg * 4 + 1] * rn * nw.y * bf2f((u16)(gg.x >> 16));
      const float y2 = o[0][ni][rg * 4 + 2] * rn * nw.z * bf2f((u16)(gg.y & 0xFFFF));
      const float y3 = o[0][ni][rg * 4 + 3] * rn * nw.w * bf2f((u16)(gg.y >> 16));
      *(u32x2*)((u16*)(p.ws + OFF_YH) + rowo + e0) = u32x2{pack2(y0, y1), pack2(y2, y3)};
    }
  }
}

__device__ __forceinline__ size_t code_rowoff(int q) {
  const int g = q >> 7, r = q & 127;
  return (size_t)128 * ((size_t)64 * g * (g + 1) + (size_t)r * (g + 1));
}
__device__ __forceinline__ u32 tocode(float s) {
  u32 u = __float_as_uint(s);
  if ((u << 1) == 0) u = 0;
  u = (u & 0x80000000u) ? ~u : (u | 0x80000000u);
  u >>= 16;
  return u < 1 ? 1 : u;
}
__device__ __forceinline__ void b1_item(const P& p, int item, char* smem, int tid) {
  const int lane = tid & 63, w = tid >> 6, wm = w & 1, wn = w >> 1, lr = lane & 31;
  const int b = item >= 2080;
  int idx = item - b * 2080;
  int g = (int)((sqrtf(8.f * idx + 1.f) - 1.f) * 0.5f);
  while (g * (g + 1) / 2 > idx) --g;
  while ((g + 1) * (g + 2) / 2 <= idx) ++g;
  const int kt = idx - g * (g + 1) / 2;
  const int q0 = b * SEQ + g * 128, k0 = b * SEQ + kt * 128;
  char* ys = smem;
  char* xs = smem + 16384;
  float* wsm = (float*)(smem + 49152);
  const u16* IQ = (const u16*)(p.ws + OFF_IQ) + (size_t)q0 * 256;
  const u16* IK = (const u16*)(p.ws + OFF_IK) + (size_t)k0 * 64;
  u32x4 xr[4], yr[4];
  g2r<128>(yr, IK, 64, tid);
  g2r<128>(xr, IQ, 256, tid);
  if (tid < 128) *(float4*)(wsm + tid * 4) = *(const float4*)(p.ws + OFF_IW + (size_t)(q0 + tid) * 16);
  r2s<128>(yr, ys, tid);
  r2s<128>(xr, xs, tid);
  __syncthreads();
  f32x16 sc[2][2];
  zero_acc<2>(sc);
#pragma unroll 1
  for (int hd = 0; hd < 4; ++hd) {
    if (hd < 3) g2r<128>(xr, IQ + (hd + 1) * 64, 256, tid);
#pragma unroll
    for (int mi = 0; mi < 2; ++mi) {
      f32x16 acc[1][2];
#pragma unroll
      for (int ni = 0; ni < 2; ++ni)
#pragma unroll
        for (int r = 0; r < 16; ++r) acc[0][ni][r] = 0.f;
      mma_tile<1, 2>(acc, xs + (hd & 1) * 16384, wm * 64 + mi * 32, ys, wn * 64, lane);
#pragma unroll
      for (int r = 0; r < 16; ++r) {
        const float wv = wsm[(wm * 64 + mi * 32 + rowof(r, lane)) * 4 + hd];
#pragma unroll
        for (int ni = 0; ni < 2; ++ni) sc[mi][ni][r] += wv * fmaxf(acc[0][ni][r], 0.f);
      }
      __builtin_amdgcn_sched_barrier(0);
    }
    if (hd < 3) r2s<128>(xr, xs + ((hd + 1) & 1) * 16384, tid);
    __syncthreads();
  }
  u16* codes = (u16*)(p.ws + OFF_CODES) + (size_t)b * CODES_PER_BATCH;
  char* st = smem + 16384;
#pragma unroll
  for (int mi = 0; mi < 2; ++mi)
#pragma unroll
    for (int r = 0; r < 16; ++r) {
      const int ql = wm * 64 + mi * 32 + rowof(r, lane);
      const int q = g * 128 + ql;
#pragma unroll
      for (int ni = 0; ni < 2; ++ni) {
        const int kl = wn * 64 + ni * 32 + lr;
        const bool vis = (kt * 128 + kl) <= q;
        const u32 cd = vis ? tocode(sc[mi][ni][r]) : 0u;
        *(u16*)(st + ql * 256 + (2 * (ni * 32 + lr) + wn) * 2) = (u16)cd;
      }
    }
  __syncthreads();
  {
    u16* dst0 = codes + code_rowoff(g * 128) + kt * 128;
    const size_t rstride = (size_t)128 * (g + 1);
#pragma unroll
    for (int i = 0; i < 8; ++i) {
      const int cid = tid + 256 * i;
      const int row = cid >> 4, c = cid & 15;
      __builtin_nontemporal_store(*(const u32x4*)(st + row * 256 + c * 16), (u32x4*)(dst0 + (size_t)row * rstride + c * 8));
    }
  }
}

__device__ __forceinline__ int wave_isum(int c) {
#pragma unroll
  for (int o = 32; o >= 1; o >>= 1) c += __shfl_xor(c, o);
  return c;
}
__device__ __forceinline__ int count_ge(const u32 (&r)[64], int nj, u32 t) {
  const u16 tm1 = (u16)(t - 1);
  const u16x2 tv = {tm1, tm1};
  const u16x2 one = {1, 1};
  u16x2 acc = {0, 0};
#pragma unroll
  for (int jb = 0; jb < 8; ++jb) {
    if (jb * 8 < nj) {
#pragma unroll
      for (int jj = 0; jj < 8; ++jj) {
        u16x2 d = __builtin_elementwise_sub_sat(__builtin_bit_cast(u16x2, r[jb * 8 + jj]), tv);
        d = __builtin_elementwise_min(d, one);
        acc += d;
      }
    }
  }
  return wave_isum((int)acc.x + (int)acc.y);
}
__device__ __forceinline__ int snake_item(int k, int bid, int nb);
__device__ __forceinline__ void b2_load(const P& p, int item, int tid, u32 (&r)[64]) {
  const int lane = tid & 63, w = tid >> 6;
  const int Q = item * 4 + w;
  const int b = Q >> 13, q = Q & 8191;
  const int nj = (q >> 7) + 1;
  const u32* row = (const u32*)((const u16*)(p.ws + OFF_CODES) + (size_t)b * CODES_PER_BATCH + code_rowoff(q));
#pragma unroll
  for (int j = 0; j < 64; ++j) r[j] = (j < nj) ? __builtin_nontemporal_load(row + j * 64 + lane) : 0u;
}
__device__ __forceinline__ void b2_process(const P& p, int item, char* smem, int tid, const u32 (&r)[64]) {
  const int lane = tid & 63, w = tid >> 6;
  const int Q = item * 4 + w;
  const int q = Q & 8191;
  const int nj = (q >> 7) + 1;
  u16x2 m1 = {0, 0}, m2 = {0, 0};
#pragma unroll
  for (int jb = 0; jb < 8; ++jb) {
    if (jb * 8 < nj) {
#pragma unroll
      for (int jj = 0; jj < 8; ++jj) {
        const u16x2 x = __builtin_bit_cast(u16x2, r[jb * 8 + jj]);
        const u16x2 t = __builtin_elementwise_min(m1, x);
        m1 = __builtin_elementwise_max(m1, x);
        m2 = __builtin_elementwise_max(m2, t);
      }
    }
  }
  int L = min((int)m2.x, (int)m2.y), H = max((int)m1.x, (int)m1.y);
#pragma unroll
  for (int o = 32; o >= 1; o >>= 1) { L = min(L, __shfl_xor(L, o)); H = max(H, __shfl_xor(H, o)); }
  u32 T = 0;
  int need = 0;
  u32 lo = L < 1 ? 1u : (u32)L;
  if (lo > 1 || count_ge(r, nj, 1) >= 256) {
    const int R = H - (int)lo + 1;
    if (R <= 2048) {
      u32* hist = (u32*)(smem + w * 8192);
      const int nbl = (R + 63) >> 6;
      for (int i = 0; i < nbl; ++i) hist[i * 64 + lane] = 0u;
#pragma unroll
      for (int jb = 0; jb < 8; ++jb) {
        if (jb * 8 < nj) {
#pragma unroll
          for (int jj = 0; jj < 8; ++jj) {
            const u32 v = r[jb * 8 + jj];
            const u32 c0 = v & 0xFFFFu, c1 = v >> 16;
            if (c0 >= lo) atomicAdd(&hist[c0 - lo], 1u);
            if (c1 >= lo) atomicAdd(&hist[c1 - lo], 1u);
          }
        }
      }
      int sl = 0;
      for (int i = 0; i < nbl; ++i) sl += (int)hist[lane * nbl + i];
      int suf = sl;
#pragma unroll
      for (int d = 1; d <= 32; d <<= 1) {
        const int v = __shfl_down(suf, d);
        suf += (lane + d < 64) ? v : 0;
      }
      const u64 okm = __ballot(suf >= 256);
      const int istar = 63 - __builtin_clzll(okm);
      int cacc = suf - sl, tbin = 0, cgt = 0;
      bool found = false;
      for (int i = nbl - 1; i >= 0; --i) {
        const int hc = (int)hist[lane * nbl + i];
        if (!found && cacc + hc >= 256) { found = true; tbin = lane * nbl + i; cgt = cacc; }
        cacc += hc;
      }
      tbin = __shfl(tbin, istar);
      cgt = __shfl(cgt, istar);
      T = lo + (u32)tbin;
      need = 256 - cgt;
    } else {
      u32 hi = (u32)H + 1u;
      while (hi - lo > 1) {
        const u32 mid = (lo + hi) >> 1;
        if (count_ge(r, nj, mid) >= 256) lo = mid; else hi = mid;
      }
      T = lo;
      const int cgt = (T >= 65535u) ? 0 : count_ge(r, nj, T + 1);
      need = 256 - cgt;
    }
  }
  int mlo[2] = {0, 0}, mhi[2] = {0, 0};
  const u32 thi = (T << 16) | 0xFFFFu;
#pragma unroll
  for (int j = 0; j < 64; ++j) {
    if (j < nj) {
#pragma unroll
      for (int hfw = 0; hfw < 2; ++hfw) {
        const u32 cd = hfw ? (r[j] >> 16) : (r[j] & 0xFFFFu);
        u64 word = hfw ? __ballot(r[j] > thi) : __ballot(cd > T);
        if (T > 0 && need > 0) {
          const bool eq = cd == T;
          const u64 eqm = __ballot(eq);
          if (eqm != 0) {
            const int rank = __builtin_amdgcn_mbcnt_hi((u32)(eqm >> 32), __builtin_amdgcn_mbcnt_lo((u32)eqm, 0));
            word |= __ballot(eq && rank < need);
            need -= __popcll(eqm);
          }
        }
        const int widx = 2 * j + hfw;
        if (lane == (widx & 63)) { mlo[widx >> 6] = (int)(u32)word; mhi[widx >> 6] = (int)(u32)(word >> 32); }
      }
    }
  }
  u32x2* mrow = (u32x2*)(p.ws + OFF_MASK + (size_t)Q * 1024);
#pragma unroll
  for (int k = 0; k < 2; ++k)
    if (lane + 64 * k < 2 * nj) mrow[lane + 64 * k] = u32x2{(u32)mlo[k], (u32)mhi[k]};
}

__device__ __forceinline__ void b2_phase(const P& p, int bid, int nb, char* smem, int tid) {
  const int rounds = (4096 + nb - 1) / nb;
  u32 ra[64], rb[64];
  int ia = snake_item(0, bid, nb);
  if (ia < 4096) b2_load(p, ia, tid, ra);
#pragma unroll 1
  for (int k = 0; k < rounds; k += 2) {
    const int ib = (k + 1 < rounds) ? snake_item(k + 1, bid, nb) : 4096;
    if (ib < 4096) b2_load(p, ib, tid, rb);
    if (ia < 4096) b2_process(p, ia, smem, tid, ra);
    ia = (k + 2 < rounds) ? snake_item(k + 2, bid, nb) : 4096;
    if (ia < 4096) b2_load(p, ia, tid, ra);
    if (ib < 4096) b2_process(p, ib, smem, tid, rb);
  }
}

__device__ __forceinline__ void b3_item(const P& p, int l, int item, char* smem, int tid) {
  const int lane = tid & 63, w = tid >> 6, h = lane >> 5, lr = lane & 31;
  const int g = 63 - (item >> 4), rem = item & 15, b = rem >> 3, head = rem & 7;
  const int q0 = g * 128;
  const int nkt = 2 * g + 2;
  const u16* AK = (const u16*)(p.ws + OFF_AK) + (size_t)b * SEQ * 512 + head * 64;
  const u16* AVT = (const u16*)(p.ws + OFF_AVT) + ((size_t)(b * 512 + head * 64)) * 8192;
  const u64* MK = (const u64*)(p.ws + OFF_MASK) + (size_t)(b * SEQ + q0) * 128;
  bf16x8 qf[4];
  {
    const u16* qrow = (const u16*)(p.ws + OFF_AQ) + (size_t)(b * SEQ + q0 + w * 32 + lr) * 512 + head * 64;
#pragma unroll
    for (int ks = 0; ks < 4; ++ks) qf[ks] = *(const bf16x8*)(qrow + ks * 16 + 8 * h);
  }
  u32x4 kr[2], vr[2];
  u64 mr = 0;
  g2r<64>(kr, AK, 512, tid);
  g2r<64>(vr, AVT, 8192, tid);
  if (tid < 128) mr = MK[(size_t)tid * 128];
  r2s<64>(kr, smem, tid);
  r2s<64>(vr, smem + 8192, tid);
  if (tid < 128) *(u64*)(smem + 16384 + tid * 8) = mr;
  __syncthreads();
  f32x16 oacc[2];
#pragma unroll
  for (int i = 0; i < 2; ++i)
#pragma unroll
    for (int r = 0; r < 16; ++r) oacc[i][r] = 0.f;
  float mrun = -5e29f, lrun = 0.f;
  float mq = fabsf(p.qn[l * 64 + lane]), mk = fabsf(p.kn[l * 64 + lane]);
#pragma unroll
  for (int o = 32; o >= 1; o >>= 1) { mq = fmaxf(mq, __shfl_xor(mq, o)); mk = fmaxf(mk, __shfl_xor(mk, o)); }
  const bool fast = (0.125f * 1.4426950408889634f * 64.f * 1.03f) * mq * mk + 1.f < 60.f;
  for (int kt = 0; kt < nkt; ++kt) {
    const char* buf = smem + (kt & 1) * 17408;
    char* nbuf = smem + ((kt + 1) & 1) * 17408;
    if (kt + 1 < nkt) {
      g2r<64>(kr, AK + (size_t)(kt + 1) * 64 * 512, 512, tid);
      g2r<64>(vr, AVT + (kt + 1) * 64, 8192, tid);
      if (tid < 128) mr = MK[(size_t)tid * 128 + kt + 1];
    }
    const u64 m64 = *(const u64*)(buf + 16384 + (w * 32 + lr) * 8);
    const u64 msh = ~(m64 >> (4 * h));
    const int w0 = (int)(u32)msh, w1 = (int)(u32)(msh >> 32);
    f32x16 s[2];
#pragma unroll
    for (int kb = 0; kb < 2; ++kb) {
#pragma unroll
      for (int r = 0; r < 16; ++r)
        s[kb][r] = __int_as_float(__builtin_amdgcn_sbfe(kb ? w1 : w0, (r & 3) + 8 * (r >> 2), 1) & (int)0xF149F2CAu);
#pragma unroll
      for (int ks = 0; ks < 4; ++ks)
        s[kb] = __builtin_amdgcn_mfma_f32_32x32x16_bf16(lds_frag(buf, kb * 32 + lr, ks * 2 + h), qf[ks], s[kb], 0, 0, 0);
    }
    float psum = 0.f;
    if (fast) {
#pragma unroll
      for (int kb = 0; kb < 2; ++kb)
#pragma unroll
        for (int r = 0; r < 16; ++r) {
          const float pv = __builtin_amdgcn_exp2f(s[kb][r]);
          s[kb][r] = pv;
          psum += pv;
        }
    } else {
      float tmax = s[0][0];
#pragma unroll
      for (int kb = 0; kb < 2; ++kb)
#pragma unroll
        for (int r = 0; r < 16; ++r) tmax = fmaxf(tmax, s[kb][r]);
      tmax = fmaxf(tmax, __shfl_xor(tmax, 32));
      if (__any(tmax > mrun)) {
        const float mnew = fmaxf(mrun, tmax);
        const float alpha = __builtin_amdgcn_exp2f(mrun - mnew);
        mrun = mnew;
        lrun *= alpha;
#pragma unroll
        for (int i = 0; i < 2; ++i)
#pragma unroll
          for (int r = 0; r < 16; ++r) oacc[i][r] *= alpha;
      }
#pragma unroll
      for (int kb = 0; kb < 2; ++kb)
#pragma unroll
        for (int r = 0; r < 16; ++r) {
          const float pv = __builtin_amdgcn_exp2f(s[kb][r] - mrun);
          s[kb][r] = pv;
          psum += pv;
        }
    }
    lrun += psum;
    const char* vt = buf + 8192;
#pragma unroll
    for (int kb = 0; kb < 2; ++kb)
#pragma unroll
      for (int s2 = 0; s2 < 2; ++s2) {
        union { bf16x8 v; u32 u[4]; } pf;
#pragma unroll
        for (int j = 0; j < 4; ++j) pf.u[j] = pack2(s[kb][8 * s2 + 2 * j], s[kb][8 * s2 + 2 * j + 1]);
#pragma unroll
        for (int db = 0; db < 2; ++db) {
          const int drow = db * 32 + lr;
          const int ch = kb * 4 + 2 * s2;
          const int sw = (drow >> 1) & 7;
          union { bf16x8 v; u32x2 u[2]; } vf;
          vf.u[0] = *(const u32x2*)(vt + drow * 128 + ((ch ^ sw) << 4) + 8 * h);
          vf.u[1] = *(const u32x2*)(vt + drow * 128 + (((ch + 1) ^ sw) << 4) + 8 * h);
          oacc[db] = __builtin_amdgcn_mfma_f32_32x32x16_bf16(vf.v, pf.v, oacc[db], 0, 0, 0);
        }
      }
    if (kt + 1 < nkt) {
      r2s<64>(kr, nbuf, tid);
      r2s<64>(vr, nbuf + 8192, tid);
      if (tid < 128) *(u64*)(nbuf + 16384 + tid * 8) = mr;
    }
    __syncthreads();
  }
  lrun += __shfl_xor(lrun, 32);
  const float inv = 1.f / lrun;
  u16* yrow = (u16*)(p.ws + OFF_YA) + (size_t)(b * SEQ + q0 + w * 32 + lr) * 512 + head * 64;
#pragma unroll
  for (int db = 0; db < 2; ++db)
#pragma unroll
    for (int rg = 0; rg < 4; ++rg) {
      const int d0 = db * 32 + 8 * rg + 4 * h;
      *(u32x2*)(yrow + d0) = u32x2{pack2(oacc[db][rg * 4] * inv, oacc[db][rg * 4 + 1] * inv),
                                   pack2(oacc[db][rg * 4 + 2] * inv, oacc[db][rg * 4 + 3] * inv)};
    }
}

__device__ __forceinline__ void d1_item(const P& p, int l, int mt, int nt, char* smem, int tid) {
  const int lane = tid & 63, w = tid >> 6, wm = w & 1, wn = w >> 1, lr = lane & 31;
  const int m0 = mt * 128, n0 = nt * 64;
  float* rs = (float*)(smem + 65536);
  const float* rowss = (const float*)(p.ws + OFF_ROWSS);
  if (tid < 128) rs[tid] = row_rstd(rowss, m0 + tid);
  const u16* XB = (const u16*)(p.ws + OFF_XB) + (size_t)m0 * 1024;
  f32x16 ag[2][2];
  zero_acc<2>(ag);
  gemm_loop<128, 2>(ag, XB, 1024, (const u16*)(p.ws + OFF_WGATE) + (size_t)nt * 128 * 1024, 1024, 16, smem, tid);
#pragma unroll
  for (int mi = 0; mi < 2; ++mi)
#pragma unroll
    for (int r = 0; r < 16; ++r) {
      const float rstd = rs[wm * 64 + mi * 32 + rowof(r, lane)];
      ag[mi][0][r] = sigmoidf_(ag[mi][0][r] * rstd);
      ag[mi][1][r] = sigmoidf_(ag[mi][1][r] * rstd);
    }
  f32x16 res[2][1], ap[2][1];
#pragma unroll
  for (int br = 0; br < 2; ++br) {
    zero_acc<1>(ap);
    const u16* Y = (const u16*)(p.ws + (br ? OFF_YH : OFF_YA)) + (size_t)m0 * 512;
    const u16* WP = (const u16*)(p.ws + (br ? OFF_WPH : OFF_WPA)) + (size_t)n0 * 512;
    gemm_loop<64, 1>(ap, Y, 512, WP, 512, 8, smem, tid);
#pragma unroll
    for (int mi = 0; mi < 2; ++mi)
#pragma unroll
      for (int r = 0; r < 16; ++r) {
        const float v = ag[mi][br][r] * ap[mi][0][r];
        res[mi][0][r] = br ? res[mi][0][r] + v : v;
      }
  }
  u16* M = (u16*)(p.ws + OFF_MERGED);
#pragma unroll
  for (int mi = 0; mi < 2; ++mi)
#pragma unroll
    for (int r = 0; r < 16; ++r) {
      const int tok = m0 + wm * 64 + mi * 32 + rowof(r, lane);
      M[(size_t)tok * 1024 + n0 + wn * 32 + lr] = f2bf(res[mi][0][r]);
    }
}

__device__ __forceinline__ void resid_item(const P& p, const u16* A, int K, const u16* W, float* rowss_next, int mt, int nt, char* smem,
                           int tid) {
  const int lane = tid & 63, w = tid >> 6, wm = w & 1, wn = w >> 1, lr = lane & 31;
  const int m0 = mt * 128, n0 = nt * 128;
  f32x16 acc[2][2];
  zero_acc<2>(acc);
  gemm_loop<128, 2>(acc, A + (size_t)m0 * K, K, W + (size_t)n0 * K, K, K >> 6, smem, tid);
  u16* XB = (u16*)(p.ws + OFF_XB);
  float myss = 0.f;
  int mytok = 0;
#pragma unroll
  for (int mi = 0; mi < 2; ++mi)
#pragma unroll
    for (int r = 0; r < 16; ++r) {
      const int tok = m0 + wm * 64 + mi * 32 + rowof(r, lane);
      float ss = 0.f;
#pragma unroll
      for (int ni = 0; ni < 2; ++ni) {
        const size_t o = (size_t)tok * 1024 + n0 + wn * 64 + ni * 32 + lr;
        const float xn = p.out[o] + acc[mi][ni][r];
        p.out[o] = xn;
        XB[o] = f2bf(xn);
        ss += xn * xn;
      }
#pragma unroll
      for (int of = 16; of >= 1; of >>= 1) ss += __shfl_xor(ss, of);
      if (lr == mi * 16 + r) { myss = ss; mytok = tok; }
      __builtin_amdgcn_sched_barrier(0);
    }
  rowss_next[(size_t)mytok * 16 + nt * 2 + wn] = myss;
}

__device__ __forceinline__ void e_item(const P& p, int l, int mt, int nt, char* smem, int tid) {
  const int lane = tid & 63, w = tid >> 6, wm = w & 1, wn = w >> 1, lr = lane & 31;
  const int m0 = mt * 128;
  float* rs = (float*)(smem + 65536);
  const float* rowss = (const float*)(p.ws + OFF_ROWSS) + (size_t)NTOK * 16;
  if (tid < 128) rs[tid] = row_rstd(rowss, m0 + tid);
  f32x16 acc[2][2];
  zero_acc<2>(acc);
  gemm_loop<128, 2>(acc, (const u16*)(p.ws + OFF_XB) + (size_t)m0 * 1024, 1024,
                    (const u16*)(p.ws + OFF_WFFI) + (size_t)nt * 128 * 1024, 1024, 16, smem, tid);
  u16* ACT = (u16*)(p.ws + OFF_ACT);
#pragma unroll
  for (int mi = 0; mi < 2; ++mi)
#pragma unroll
    for (int r = 0; r < 16; ++r) {
      const int tl = wm * 64 + mi * 32 + rowof(r, lane);
      const float rstd = rs[tl];
      const float gv = acc[mi][0][r] * rstd, uv = acc[mi][1][r] * rstd;
      ACT[(size_t)(m0 + tl) * DFF + nt * 64 + wn * 32 + lr] = f2bf(siluf_(gv) * uv);
    }
}

constexpr int PPL = 10;
#ifndef ONLY_S
#define ONLY_S -1
#endif
#define EN(k) (ONLY_S < 0 || ONLY_S == (k))
template <class F>
__device__ __forceinline__ void for_tiles(int NT, int bid, int nb, F f) {
  if ((nb & 63) == 0) {
    const int vx = bid & 7, j = bid >> 3, JN = nb >> 6;
    const int jm = j & 7, jn = j >> 3;
    const int NG = (NT + JN - 1) / JN;
    const int wl = NT - (NG - 1) * JN;
    const bool fold = (wl * 2 == JN);
    const int NGF = fold ? NG - 1 : NG;
    for (int r = 0; r < 2 * NGF; ++r) {
      const int mh = r / NGF, ng = r - mh * NGF;
      const int mt = vx * 16 + mh * 8 + jm, nt = ng * JN + jn;
      if (nt < NT) f(mt, nt);
    }
    if (fold) f(vx * 16 + (jn / wl) * 8 + jm, (NG - 1) * JN + (jn % wl));
  } else {
    for (int it = bid; it < 128 * NT; it += nb) f(it / NT, it % NT);
  }
}
__device__ __forceinline__ int snake_item(int k, int bid, int nb) {
  return (k & 1) ? (((k + 1) * nb - 1 - bid) ^ 7) : (k * nb + bid);
}

__device__ __forceinline__ void run_phase(const P& p, int ph, char* smem) {
  int tid0 = threadIdx.x;
  asm volatile("" : "+v"(tid0));
  const int nb = gridDim.x;
  int bid = blockIdx.x;
  asm volatile("" : "+s"(bid));
#define LAUNDER int tid = tid0; asm volatile("" : "+v"(tid)); __syncthreads();
  if (ph == 0) {
    if (EN(11)) for (int it = bid; it < 4096 + 4128; it += nb) { LAUNDER
      if (it < 4096) p0_rows(p, it, tid); else conv_item(p, 0, it - 4096, smem, tid);
    }
    return;
  }
  const int l = (ph - 1) / PPL;
  const int smap[PPL] = {0, 4, 5, 6, 2, 3, 7, 8, 9, 10};
  const int s = smap[(ph - 1) % PPL];
  float* rowss = (float*)(p.ws + OFF_ROWSS);
  switch (s) {
    case 0: if (EN(0)) {
      const int par = (bid >> 8) & 1;
      if (l > 0 && par) for (int it = bid; it < 704; it += nb) { LAUNDER conv_item(p, l, 3424 + it, smem, tid); }
      for_tiles(31, bid, nb, [&](int mt, int nt) { LAUNDER phaseA_tile(p, l, mt, nt, smem, tid); });
      if (l > 0 && !par) for (int it = bid; it < 704; it += nb) { LAUNDER conv_item(p, l, 3424 + it, smem, tid); }
    } break;
    case 2: if (EN(2)) for (int it = bid; it < 256; it += nb) { LAUNDER h2_item(p, it, tid); } break;
    case 3: if (EN(3)) for (int it = bid; it < 1024; it += nb) { LAUNDER h3_item(p, l, it, smem, tid); } break;
    case 4: if (EN(4)) for (int it = bid; it < 4160; it += nb) { LAUNDER b1_item(p, it, smem, tid); } break;
    case 5: if (EN(5)) { int tid = tid0; asm volatile("" : "+v"(tid)); b2_phase(p, bid, nb, smem, tid); } break;
    case 6: if (EN(6)) {
      const int par = (bid >> 8) & 1;
      if (par) for (int it = bid; it < 1024; it += nb) { LAUNDER h1_item(p, it, smem, tid); }
      for (int k = 0; k * nb < 1024; ++k) { const int it = snake_item(k, bid, nb); if (it < 1024) { LAUNDER b3_item(p, l, it, smem, tid); } }
      if (!par) for (int it = bid; it < 1024; it += nb) { LAUNDER h1_item(p, it, smem, tid); }
    } break;
    case 7: if (EN(7)) for_tiles(16, bid, nb, [&](int mt, int nt) { LAUNDER d1_item(p, l, mt, nt, smem, tid); }); break;
    case 8:
      if (EN(8)) for_tiles(8, bid, nb, [&](int mt, int nt) { LAUNDER
        resid_item(p, (const u16*)(p.ws + OFF_MERGED), 1024, (const u16*)(p.ws + OFF_WOUT), rowss + (size_t)NTOK * 16, mt, nt, smem, tid); });
      break;
    case 9: if (EN(9)) for_tiles(44, bid, nb, [&](int mt, int nt) { LAUNDER e_item(p, l, mt, nt, smem, tid); }); break;
    case 10: if (EN(10)) {
      const int par = (bid >> 8) & 1;
      if (l < 3 && par) for (int it = bid; it < 3424; it += nb) { LAUNDER conv_item(p, l + 1, it, smem, tid); }
      for_tiles(8, bid, nb, [&](int mt, int nt) { LAUNDER
        resid_item(p, (const u16*)(p.ws + OFF_ACT), DFF, (const u16*)(p.ws + OFF_WFFO), rowss, mt, nt, smem, tid); });
      if (l < 3 && !par) for (int it = bid; it < 3424; it += nb) { LAUNDER conv_item(p, l + 1, it, smem, tid); }
    } break;
  }
#undef LAUNDER
}

constexpr int NPHASE = 1 + PPL * DEPTH;

#ifndef REP_MASK
#define REP_MASK 0
#endif
#define XB_TMO      128
#define XB_XCNT(j)  (256  + 64 * (j))
#define XB_XSUB(j)  (1280 + 64 * (j))
#define XB_XGEN(j)  (2304 + 64 * (j))
#define XB_TOP      3328
#define XB_TOPGEN   3392
#define XCD_BAR_WORDS 3456
#define XB_SPIN_CAP (1u << 18)
#define LAS __attribute__((address_space(3)))

__device__ __forceinline__ unsigned xb_ld(unsigned* p)              { return __hip_atomic_load(p, __ATOMIC_RELAXED, __HIP_MEMORY_SCOPE_AGENT); }
__device__ __forceinline__ unsigned xb_add(unsigned* p, unsigned v) { return __hip_atomic_fetch_add(p, v, __ATOMIC_RELAXED, __HIP_MEMORY_SCOPE_AGENT); }
__device__ __forceinline__ unsigned xb_xcc_id() { return (unsigned)__builtin_amdgcn_s_getreg((3 << 11) | 20) & 0xFu; }
#define XB_SPIN(cond, bar) do { unsigned _sp = 0; while (cond) { __builtin_amdgcn_s_sleep(1); \
    if ((++_sp & 255u) == 0u) { if (xb_ld(&(bar)[XB_TMO])) break; if (_sp > XB_SPIN_CAP) { atomicAdd(&(bar)[XB_TMO], 1u); break; } } } } while (0)

struct XcdBarrier {
    unsigned* bar; unsigned x;
    volatile LAS unsigned* st;
};

__device__ __forceinline__ XcdBarrier xcd_barrier_post(unsigned* bar, volatile LAS unsigned* st) {
    XcdBarrier b; b.bar = bar; b.x = xb_xcc_id(); b.st = st;
    if (threadIdx.x == 0) (void)xb_add(&bar[XB_XCNT(b.x)], 1u);
    return b;
}
__device__ __forceinline__ void xcd_barrier_complete(unsigned* bar, unsigned x, unsigned& nloc, unsigned& nx) {
    const unsigned G = gridDim.x * gridDim.y * gridDim.z;
    unsigned sum, cnt, mine, sp = 0u;
    for (;;) {
        sum = 0u; cnt = 0u; mine = 0u;
#pragma unroll
        for (unsigned j = 0; j < 16; ++j) { const unsigned c = xb_ld(&bar[XB_XCNT(j)]); sum += c; cnt += (c > 0u) ? 1u : 0u; mine = (j == x) ? c : mine; }
        if (sum == G) break;
        __builtin_amdgcn_s_sleep(1);
        if ((++sp & 255u) == 0u) { if (xb_ld(&bar[XB_TMO])) break; if (sp > XB_SPIN_CAP) { atomicAdd(&bar[XB_TMO], 1u); break; } }
    }
    nloc = mine > 0u ? mine : 1u; nx = cnt > 0u ? cnt : 1u;
}

__device__ __forceinline__ void xcd_barrier(const XcdBarrier& b) {
    asm volatile("s_waitcnt vmcnt(0)" ::: "memory");
    __syncthreads();
    if (threadIdx.x == 0) {
        unsigned* bar = b.bar;
        __builtin_amdgcn_s_waitcnt(0);
        unsigned nloc = b.st[0], nx = b.st[1];
        if (nloc == 0u) { xcd_barrier_complete(bar, b.x, nloc, nx); b.st[0] = nloc; b.st[1] = nx; }
        const unsigned old = xb_add(&bar[XB_XSUB(b.x)], 1u);
        const unsigned gen = old / nloc;
        if (old + 1u == (gen + 1u) * nloc) {
            __builtin_amdgcn_fence(__ATOMIC_RELEASE, "agent");
            asm volatile("s_waitcnt vmcnt(0)" ::: "memory");
            const unsigned og = xb_add(&bar[XB_TOP], 1u);
            const unsigned tg = og / nx;
            if (og + 1u == (tg + 1u) * nx) xb_add(&bar[XB_TOPGEN], 1u);
            else XB_SPIN(xb_ld(&bar[XB_TOPGEN]) == tg, bar);
            __builtin_amdgcn_fence(__ATOMIC_ACQUIRE, "agent");
            xb_add(&bar[XB_XGEN(b.x)], 1u);
            asm volatile("s_waitcnt vmcnt(0)" ::: "memory");
        } else {
            XB_SPIN(xb_ld(&bar[XB_XGEN(b.x)]) == gen, bar);
            __builtin_amdgcn_fence(__ATOMIC_ACQUIRE, "agent");
            asm volatile("s_waitcnt vmcnt(0)" ::: "memory");
        }
    }
    __syncthreads();
}


template <bool COOP>
__global__ void __launch_bounds__(256, 2) mega(P p, int ph0, int ph1) {
  __shared__ __attribute__((aligned(16))) char smem[66560];
  __shared__ uint4 xb_words;
  if (threadIdx.x == 0) xb_words = make_uint4(0u, 0u, 0u, 0u);
  __syncthreads();
  XcdBarrier xb = xcd_barrier_post((unsigned*)(p.ws + OFF_BAR), (volatile LAS unsigned*)&xb_words);
  for (int ph = ph0; ph < ph1; ++ph) {
    int reps = 1;
    if (REP_MASK != 0 && ph > 0 && ((REP_MASK >> ((ph - 1) % PPL)) & 1)) reps = 2;
    for (int rp = 0; rp < reps; ++rp) {
      run_phase(p, ph, smem);
      if (COOP) {
        if (ph + 1 < ph1 || rp + 1 < reps) {
          if (ph == 0) cg::this_grid().sync();
          else xcd_barrier(xb);
        }
      }
    }
  }
}

extern "C" void kernel_launch(void* const* d_in, const int* in_sizes, int n_in, void* d_out, int out_size, void* d_ws,
                              size_t ws_size, hipStream_t stream) {
  if (ws_size < WS_END) { fprintf(stderr, "workspace too small: %zu\n", ws_size); return; }
  P p{};
  p.x = (const float*)d_in[0]; p.pos = (const int*)d_in[1]; p.w_in = (const float*)d_in[2];
  p.w_pa = (const float*)d_in[3]; p.w_ph = (const float*)d_in[4]; p.w_out = (const float*)d_in[5];
  p.nmix = (const float*)d_in[6]; p.nffn = (const float*)d_in[7]; p.qn = (const float*)d_in[8];
  p.kn = (const float*)d_in[9]; p.hn = (const float*)d_in[10]; p.hlb = (const float*)d_in[11];
  p.w_ffi = (const float*)d_in[12]; p.w_ffo = (const float*)d_in[13];
  p.out = (float*)d_out; p.ws = (char*)d_ws;
#if COOP_MODE
  static int grid_blocks = 0;
  if (!grid_blocks) {
    int dev = 0, cus = 0, per_cu = 0;
    hipGetDevice(&dev);
    hipDeviceGetAttribute(&cus, hipDeviceAttributeMultiprocessorCount, dev);
    hipOccupancyMaxActiveBlocksPerMultiprocessor(&per_cu, mega<true>, 256, 0);
    if (per_cu > 2) per_cu = 2;
    grid_blocks = cus * per_cu;
  }
  int ph0 = 0, ph1 = NPHASE;
  hipMemsetAsync((char*)d_ws + OFF_BAR, 0, 16384, stream);
  void* args[] = {&p, &ph0, &ph1};
  hipError_t e = hipLaunchCooperativeKernel((void*)mega<true>, dim3(grid_blocks), dim3(256), args, 0, stream);
  if (e != hipSuccess) fprintf(stderr, "cooperative launch failed: %s (grid %d)\n", hipGetErrorString(e), grid_blocks);
#else
  for (int ph = 0; ph < NPHASE; ++ph) mega<false><<<dim3(512), dim3(256), 0, stream>>>(p, ph, ph + 1);
#endif
}
```

```cpp
#include <hip/hip_runtime.h>
#include <hip/hip_cooperative_groups.h>
#include <stdint.h>
#include <stdio.h>
namespace cg = cooperative_groups;

#ifndef COOP_MODE
#define COOP_MODE 1
#endif

typedef unsigned short u16;
typedef unsigned int u32;
typedef unsigned long long u64;
typedef __attribute__((ext_vector_type(8))) short bf16x8;
typedef __attribute__((ext_vector_type(16))) float f32x16;
typedef __attribute__((ext_vector_type(4))) u32 u32x4;
typedef __attribute__((ext_vector_type(2))) u32 u32x2;
typedef __attribute__((ext_vector_type(2))) unsigned short u16x2;

constexpr int NTOK = 16384, SEQ = 8192, DEPTH = 4;
constexpr int DFF = 2816;
constexpr float EPS = 1e-6f;
constexpr size_t MiB = (size_t)1 << 20;
constexpr size_t OFF_WIN = 0, OFF_WGATE = 8 * MiB, OFF_WPA = 12 * MiB, OFF_WPH = 13 * MiB, OFF_WOUT = 14 * MiB,
                 OFF_WFFI = 16 * MiB, OFF_WFFO = 27 * MiB, OFF_AQ = 33 * MiB, OFF_AK = 49 * MiB, OFF_AVT = 65 * MiB,
                 OFF_IQ = 81 * MiB, OFF_IK = 89 * MiB, OFF_IW = 91 * MiB, OFF_HQ = 92 * MiB, OFF_HVT = 108 * MiB,
                 OFF_HG = 124 * MiB, OFF_LOGF = 140 * MiB, OFF_XB = 172 * MiB, OFF_YH = 204 * MiB, OFF_MASK = 220 * MiB,
                 OFF_ROWSS = 236 * MiB, OFF_CODES = 238 * MiB, OFF_YA = OFF_CODES, OFF_US = OFF_CODES + 16 * MiB,
                 OFF_GDEC = OFF_CODES + 48 * MiB, OFF_MERGED = OFF_AQ, OFF_ACT = OFF_AQ, OFF_BAR = 32 * MiB + 768 * 1024, WS_END = 368 * MiB;
constexpr size_t CODES_PER_BATCH = (size_t)16384 * 2080;

struct P {
  const float* x; const int* pos; const float* w_in; const float* w_pa; const float* w_ph; const float* w_out;
  const float* nmix; const float* nffn; const float* qn; const float* kn; const float* hn; const float* hlb;
  const float* w_ffi; const float* w_ffo; float* out; char* ws;
};

__device__ __forceinline__ u16 f2bf(float f) {
  u32 u = __float_as_uint(f);
  u += 0x7FFFu + ((u >> 16) & 1u);
  return (u16)(u >> 16);
}
__device__ __forceinline__ float bf2f(u16 v) { return __uint_as_float(((u32)v) << 16); }
__device__ __forceinline__ u32 pack2(float a, float b) { u32 r; asm("v_cvt_pk_bf16_f32 %0, %1, %2" : "=v"(r) : "v"(a), "v"(b)); return r; }
__device__ __forceinline__ float wave_sum(float v) {
#pragma unroll
  for (int o = 32; o >= 1; o >>= 1) v += __shfl_xor(v, o);
  return v;
}
__device__ __forceinline__ float sigmoidf_(float x) { return 1.f / (1.f + __expf(-x)); }
__device__ __forceinline__ float siluf_(float x) { return x / (1.f + __expf(-x)); }

template <int ROWS>
__device__ __forceinline__ void g2r(u32x4 (&r)[ROWS / 32], const u16* g, size_t ld, int tid) {
  const int c = tid & 7, row = tid >> 3;
#pragma unroll
  for (int i = 0; i < ROWS / 32; ++i) r[i] = *(const u32x4*)(g + (size_t)(row + 32 * i) * ld + c * 8);
}
template <int ROWS>
__device__ __forceinline__ void r2s(const u32x4 (&r)[ROWS / 32], char* s, int tid) {
  const int c = tid & 7, row = tid >> 3;
#pragma unroll
  for (int i = 0; i < ROWS / 32; ++i) {
    const int rr = row + 32 * i;
    *(u32x4*)(s + rr * 128 + ((c ^ ((rr >> 1) & 7)) << 4)) = r[i];
  }
}
__device__ __forceinline__ bf16x8 lds_frag(const char* s, int row, int kc) {
  return *(const bf16x8*)(s + row * 128 + ((kc ^ ((row >> 1) & 7)) << 4));
}
__device__ __forceinline__ int rowof(int reg, int lane) { return (reg & 3) + 8 * (reg >> 2) + 4 * (lane >> 5); }

template <int MI, int NI>
__device__ __forceinline__ void mma_tile(f32x16 (&acc)[MI][NI], const char* xs, int xrow0, const char* ys, int yrow0,
                                         int lane) {
  const int r = lane & 31, h = lane >> 5;
  bf16x8 a[2][MI], b[2][NI];
#pragma unroll
  for (int mi = 0; mi < MI; ++mi) a[0][mi] = lds_frag(xs, xrow0 + mi * 32 + r, h);
#pragma unroll
  for (int ni = 0; ni < NI; ++ni) b[0][ni] = lds_frag(ys, yrow0 + ni * 32 + r, h);
#pragma unroll
  for (int ks = 0; ks < 4; ++ks) {
    const int c = ks & 1, n = c ^ 1;
    if (ks < 3) {
#pragma unroll
      for (int mi = 0; mi < MI; ++mi) a[n][mi] = lds_frag(xs, xrow0 + mi * 32 + r, (ks + 1) * 2 + h);
#pragma unroll
      for (int ni = 0; ni < NI; ++ni) b[n][ni] = lds_frag(ys, yrow0 + ni * 32 + r, (ks + 1) * 2 + h);
    }
    __builtin_amdgcn_sched_barrier(0);
#pragma unroll
    for (int mi = 0; mi < MI; ++mi)
#pragma unroll
      for (int ni = 0; ni < NI; ++ni)
        acc[mi][ni] = __builtin_amdgcn_mfma_f32_32x32x16_bf16(a[c][mi], b[c][ni], acc[mi][ni], 0, 0, 0);
    __builtin_amdgcn_sched_barrier(0);
  }
}

template <int YR, int NI>
__device__ __forceinline__ void gemm_loop_shallow(f32x16 (&acc)[2][NI], const u16* X, size_t ldx, const u16* Y, size_t ldy,
                                          int KT, char* smem, int tid) {
  const int lane = tid & 63, w = tid >> 6, wm = w & 1, wn = w >> 1;
  char* xs = smem;
  char* ys = smem + 32768;
  u32x4 xr[4], yr[YR / 32];
  g2r<128>(xr, X, ldx, tid);
  g2r<YR>(yr, Y, ldy, tid);
  r2s<128>(xr, xs, tid);
  r2s<YR>(yr, ys, tid);
  __syncthreads();
#pragma unroll 1
  for (int kt = 0; kt < KT; ++kt) {
    const int cur = kt & 1;
    if (kt + 1 < KT) {
      g2r<128>(xr, X + (size_t)(kt + 1) * 64, ldx, tid);
      g2r<YR>(yr, Y + (size_t)(kt + 1) * 64, ldy, tid);
    }
    mma_tile<2, NI>(acc, xs + cur * 16384, wm * 64, ys + cur * (YR * 128), wn * 32 * NI, lane);
    if (kt + 1 < KT) {
      r2s<128>(xr, xs + (cur ^ 1) * 16384, tid);
      r2s<YR>(yr, ys + (cur ^ 1) * (YR * 128), tid);
    }
    __syncthreads();
  }
}
template <int YR, int NI>
__device__ __forceinline__ void gemm_loop_deep(f32x16 (&acc)[2][NI], const u16* X, size_t ldx, const u16* Y, size_t ldy,
                                          int KT, char* smem, int tid) {
  const int lane = tid & 63, w = tid >> 6, wm = w & 1, wn = w >> 1;
  char* xs = smem;
  char* ys = smem + 32768;
  u32x4 xa[4], ya[YR / 32], xb[4], yb[YR / 32];
  g2r<128>(xa, X, ldx, tid);
  g2r<YR>(ya, Y, ldy, tid);
  g2r<128>(xb, X + 64, ldx, tid);
  g2r<YR>(yb, Y + 64, ldy, tid);
  r2s<128>(xa, xs, tid);
  r2s<YR>(ya, ys, tid);
  __syncthreads();
#pragma unroll 1
  for (int kt = 0; kt < KT; kt += 2) {
    if (kt + 2 < KT) {
      g2r<128>(xa, X + (size_t)(kt + 2) * 64, ldx, tid);
      g2r<YR>(ya, Y + (size_t)(kt + 2) * 64, ldy, tid);
    }
    mma_tile<2, NI>(acc, xs, wm * 64, ys, wn * 32 * NI, lane);
    r2s<128>(xb, xs + 16384, tid);
    r2s<YR>(yb, ys + YR * 128, tid);
    __syncthreads();
    if (kt + 3 < KT) {
      g2r<128>(xb, X + (size_t)(kt + 3) * 64, ldx, tid);
      g2r<YR>(yb, Y + (size_t)(kt + 3) * 64, ldy, tid);
    }
    mma_tile<2, NI>(acc, xs + 16384, wm * 64, ys + YR * 128, wn * 32 * NI, lane);
    if (kt + 2 < KT) {
      r2s<128>(xa, xs, tid);
      r2s<YR>(ya, ys, tid);
    }
    __syncthreads();
  }
}
template <int YR, int NI>
__device__ __forceinline__ void gemm_loop(f32x16 (&acc)[2][NI], const u16* X, size_t ldx, const u16* Y, size_t ldy,
                                          int KT, char* smem, int tid) {
  if constexpr (YR == 128) gemm_loop_deep<YR, NI>(acc, X, ldx, Y, ldy, KT, smem, tid);
  else gemm_loop_shallow<YR, NI>(acc, X, ldx, Y, ldy, KT, smem, tid);
}
template <int NI>
__device__ __forceinline__ void zero_acc(f32x16 (&acc)[2][NI]) {
#pragma unroll
  for (int mi = 0; mi < 2; ++mi)
#pragma unroll
    for (int ni = 0; ni < NI; ++ni)
#pragma unroll
      for (int r = 0; r < 16; ++r) acc[mi][ni][r] = 0.f;
}

__device__ __forceinline__ int conv_map(int mode, int n) {
  if (mode == 0) return n < 1860 ? n : (n < 1920 ? -1 : n - 60);
  if (mode == 1) {
    const int tile = n >> 7, r = n & 127, sub = r >> 5;
    return 3908 + (sub & 1) * 1024 + tile * 64 + (sub >> 1) * 32 + (r & 31);
  }
  if (mode == 3) {
    const int tile = n >> 7, r = n & 127, sub = r >> 5;
    const int j = tile * 64 + (sub >> 1) * 32 + (r & 31);
    return (sub & 1) ? DFF + j : j;
  }
  return n;
}
__device__ __forceinline__ void conv_tile(const float* src, int ld, int K, int mode, const float* scale, u16* dst, int tile, float* lds,
                          int tid) {
  const int ktiles = K >> 6;
  const int ntile = tile / ktiles, ktile = tile - ntile * ktiles;
  const int n0 = ntile * 64, k0 = ktile * 64;
  const int n4 = (tid & 15) * 4, kq = tid >> 4;
  const int col = conv_map(mode, n0 + n4);
  float4 vv[4];
#pragma unroll
  for (int i = 0; i < 4; ++i) {
    const int k = kq + 16 * i;
    vv[i] = float4{0.f, 0.f, 0.f, 0.f};
    if (col >= 0) {
      typedef __attribute__((ext_vector_type(4))) float f4v;
      const f4v t = __builtin_nontemporal_load((const f4v*)(src + (size_t)(k0 + k) * ld + col));
      vv[i] = float4{t.x, t.y, t.z, t.w};
    }
    if (scale) { const float sc = scale[k0 + k]; vv[i].x *= sc; vv[i].y *= sc; vv[i].z *= sc; vv[i].w *= sc; }
  }
#pragma unroll
  for (int i = 0; i < 4; ++i) {
    float* d = lds + (kq + 16 * i) * 65 + n4;
    d[0] = vv[i].x; d[1] = vv[i].y; d[2] = vv[i].z; d[3] = vv[i].w;
  }
  __syncthreads();
  const int nr = tid >> 2, part = tid & 3;
  u32 o[8];
#pragma unroll
  for (int i = 0; i < 8; ++i)
    o[i] = pack2(lds[(part * 16 + 2 * i) * 65 + nr], lds[(part * 16 + 2 * i + 1) * 65 + nr]);
  u32x4* d = (u32x4*)(dst + (size_t)(n0 + nr) * K + k0 + part * 16);
  d[0] = u32x4{o[0], o[1], o[2], o[3]};
  d[1] = u32x4{o[4], o[5], o[6], o[7]};
}
__device__ __forceinline__ void conv_item(const P& p, int l, int c, char* smem, int tid) {
  const float* src; int ld, K, mode; const float* scale = nullptr; u16* dst;
  if (c < 992) { src = p.w_in + (size_t)l * 1024 * 5956; ld = 5956; K = 1024; mode = 0; scale = p.nmix + l * 1024; dst = (u16*)(p.ws + OFF_WIN); }
  else if (c < 1504) { c -= 992; src = p.w_in + (size_t)l * 1024 * 5956; ld = 5956; K = 1024; mode = 1; scale = p.nmix + l * 1024; dst = (u16*)(p.ws + OFF_WGATE); }
  else if (c < 1632) { c -= 1504; src = p.w_pa + (size_t)l * 512 * 1024; ld = 1024; K = 512; mode = 2; dst = (u16*)(p.ws + OFF_WPA); }
  else if (c < 1760) { c -= 1632; src = p.w_ph + (size_t)l * 512 * 1024; ld = 1024; K = 512; mode = 2; dst = (u16*)(p.ws + OFF_WPH); }
  else if (c < 2016) { c -= 1760; src = p.w_out + (size_t)l * 1024 * 1024; ld = 1024; K = 1024; mode = 2; dst = (u16*)(p.ws + OFF_WOUT); }
  else if (c < 3424) { c -= 2016; src = p.w_ffi + (size_t)l * 1024 * 5632; ld = 5632; K = 1024; mode = 3; scale = p.nffn + l * 1024; dst = (u16*)(p.ws + OFF_WFFI); }
  else { c -= 3424; src = p.w_ffo + (size_t)l * DFF * 1024; ld = 1024; K = DFF; mode = 2; dst = (u16*)(p.ws + OFF_WFFO); }
  conv_tile(src, ld, K, mode, scale, dst, c, (float*)smem, tid);
}

__device__ __forceinline__ void p0_rows(const P& p, int item, int tid) {
  const int lane = tid & 63, w = tid >> 6;
  const int tok = item * 4 + w;
  const float4* xr = (const float4*)(p.x + (size_t)tok * 1024);
  float4* orow = (float4*)(p.out + (size_t)tok * 1024);
  u32x2* xb = (u32x2*)(p.ws + OFF_XB + (size_t)tok * 2048);
  float ss = 0.f;
#pragma unroll
  for (int i = 0; i < 4; ++i) {
    float4 v = xr[lane + 64 * i];
    ss += v.x * v.x + v.y * v.y + v.z * v.z + v.w * v.w;
    orow[lane + 64 * i] = v;
    xb[lane + 64 * i] = u32x2{pack2(v.x, v.y), pack2(v.z, v.w)};
  }
  ss = wave_sum(ss);
  float* rowss = (float*)(p.ws + OFF_ROWSS);
  if (lane < 16) rowss[(size_t)tok * 16 + lane] = lane == 0 ? ss : 0.f;
}


__device__ __forceinline__ float row_rstd(const float* part, int tok) {
  const float4* q = (const float4*)(part + (size_t)tok * 16);
  const float4 a = q[0], b = q[1], c = q[2], d = q[3];
  const float ss = ((a.x + a.y) + (a.z + a.w)) + ((b.x + b.y) + (b.z + b.w)) + ((c.x + c.y) + (c.z + c.w)) + ((d.x + d.y) + (d.z + d.w));
  return rsqrtf(ss * (1.f / 1024.f) + EPS);
}
__device__ __forceinline__ void rope_cs(int pos, int d1, float& c, float& s) {
  const float inv = exp2f(-(float)d1 * (13.287712379549449f / 32.f));
  const float ang = (float)pos * inv;
  double rv = (double)ang * 0.15915494309189535;
  rv -= floor(rv);
  const float r = (float)rv;
  c = __builtin_amdgcn_cosf(r);
  s = __builtin_amdgcn_sinf(r);
}

__device__ __forceinline__ void phaseA_tile(const P& p, int l, int mt, int nt, char* smem, int tid) {
  const int lane = tid & 63, w = tid >> 6, wm = w & 1, wn = w >> 1, h = lane >> 5, lr = lane & 31;
  const int m0 = mt * 128;
  float* rs = (float*)(smem + 65536);
  const float* rowss = (const float*)(p.ws + OFF_ROWSS);
  if (tid < 128) rs[tid] = row_rstd(rowss, m0 + tid);
  const u16* XB = (const u16*)(p.ws + OFF_XB) + (size_t)m0 * 1024;
  const u16* W = (const u16*)(p.ws + OFF_WIN) + (size_t)nt * 128 * 1024;
  const bool fr = (nt < 15) || (nt >= 23 && nt < 27);
  f32x16 acc[2][2];
  zero_acc<2>(acc);
  if (fr) gemm_loop<128, 2>(acc, W, 1024, XB, 1024, 16, smem, tid);
  else gemm_loop<128, 2>(acc, XB, 1024, W, 1024, 16, smem, tid);

  if (fr) {
    if (nt < 8 || (nt >= 12 && nt < 15)) {
      const bool isidx = nt >= 12;
      const int fbase = isidx ? (nt - 12) * 128 + wm * 64 : nt * 128 + wm * 64;
      if (isidx && nt == 14 && wm == 1) {
#pragma unroll
        for (int ni = 0; ni < 2; ++ni) {
          const int tl = wn * 64 + ni * 32 + lr;
          const float rstd = rs[tl] * 0.5f;
          if (h == 0) {
            float4 o = {acc[0][ni][0] * rstd, acc[0][ni][1] * rstd, acc[0][ni][2] * rstd, acc[0][ni][3] * rstd};
            *(float4*)(p.ws + OFF_IW + (size_t)(m0 + tl) * 16) = o;
          }
        }
        return;
      }
      const bool isk = (!isidx) && fbase >= 512;
      const int head = isidx ? (nt == 14 ? 0 : (fbase >> 6)) : ((fbase & 511) >> 6);
      const float* nw = isidx ? nullptr : (isk ? p.kn + l * 64 : p.qn + l * 64);
      u16* dst; int dld;
      float oscale = 1.f;
      if (!isidx) { dst = (u16*)(p.ws + (isk ? OFF_AK : OFF_AQ)); dld = 512; if (!isk) oscale = 0.125f * 1.4426950408889634f; }
      else if (nt < 14) { dst = (u16*)(p.ws + OFF_IQ); dld = 256; oscale = 0.125f; }
      else { dst = (u16*)(p.ws + OFF_IK); dld = 64; }
#pragma unroll
      for (int ni = 0; ni < 2; ++ni) {
        const int tl = wn * 64 + ni * 32 + lr;
        const int tok = m0 + tl;
        const float rstd = rs[tl];
        const int pos = p.pos[tok];
        float rn = rstd;
        if (!isidx) {
          float ss = 0.f;
#pragma unroll
          for (int mi = 0; mi < 2; ++mi)
#pragma unroll
            for (int r = 0; r < 16; ++r) { const float v = acc[mi][ni][r] * rstd; ss += v * v; }
          ss += __shfl_xor(ss, 32);
          rn = rstd * rsqrtf(ss * (1.f / 64.f) + EPS);
        }
        u16* drow = dst + (size_t)tok * dld + head * 64;
#pragma unroll
        for (int rg = 0; rg < 4; ++rg) {
          float o1[4], o2[4];
#pragma unroll
          for (int j = 0; j < 4; ++j) {
            const int r = rg * 4 + j;
            const int d1 = j + 8 * rg + 4 * h;
            float x1 = acc[0][ni][r] * rn, x2 = acc[1][ni][r] * rn;
            if (!isidx) { x1 *= nw[d1]; x2 *= nw[d1 + 32]; }
            float c, s;
            rope_cs(pos, d1, c, s);
            o1[j] = (x1 * c - x2 * s) * oscale;
            o2[j] = (x2 * c + x1 * s) * oscale;
          }
          const int d1b = 8 * rg + 4 * h;
          *(u32x2*)(drow + d1b) = u32x2{pack2(o1[0], o1[1]), pack2(o1[2], o1[3])};
          *(u32x2*)(drow + d1b + 32) = u32x2{pack2(o2[0], o2[1]), pack2(o2[2], o2[3])};
          __builtin_amdgcn_sched_barrier(0);
        }
      }
    } else {
      const bool isav = nt < 12;
      u16* dst = (u16*)(p.ws + (isav ? OFF_AVT : OFF_HVT));
#pragma unroll
      for (int ni = 0; ni < 2; ++ni) {
        const int tl = wn * 64 + ni * 32 + lr;
        const int tok = m0 + tl;
        const float rstd = rs[tl];
        const int b = tok >> 13, t = tok & 8191;
#pragma unroll
        for (int mi = 0; mi < 2; ++mi)
#pragma unroll
          for (int r = 0; r < 16; ++r) {
            const int f = (isav ? (nt - 8) : (nt - 23)) * 128 + wm * 64 + mi * 32 + rowof(r, lane);
            dst[((size_t)(b * 512 + f)) * 8192 + t] = f2bf(acc[mi][ni][r] * rstd);
            if ((r & 3) == 3) __builtin_amdgcn_sched_barrier(0);
          }
      }
    }
  } else {
    const int seg = (nt - 15) >> 2;
    const int fb = ((nt - 15) & 3) * 128 + wn * 64;
#pragma unroll
    for (int ni = 0; ni < 2; ++ni) {
      const int f = fb + ni * 32 + lr;
      float lb = 0.f;
      if (seg == 1) {
        float e[4], mx = -1e30f;
#pragma unroll
        for (int i = 0; i < 4; ++i) { e[i] = p.hlb[i * 512 + f]; mx = fmaxf(mx, e[i]); }
        float tot = 0.f, part = 0.f;
#pragma unroll
        for (int i = 0; i < 4; ++i) { e[i] = __expf(e[i] - mx); tot += e[i]; if (i >= 1 && i <= l) part += e[i]; }
        lb = part / tot;
      }
#pragma unroll
      for (int mi = 0; mi < 2; ++mi)
#pragma unroll
        for (int r = 0; r < 16; ++r) {
          const int tl = wm * 64 + mi * 32 + rowof(r, lane);
          const float v = acc[mi][ni][r] * rs[tl];
          const size_t o = (size_t)(m0 + tl) * 512 + f;
          if (seg == 0) ((u16*)(p.ws + OFF_HQ))[o] = f2bf(siluf_(v));
          else if (seg == 3) ((u16*)(p.ws + OFF_HG))[o] = f2bf(siluf_(v));
          else {
            const float sg = 1.f / (1.f + __expf(-v));
            ((float*)(p.ws + OFF_LOGF))[o] = logf(lb + (1.f - lb) * sg);
          }
          if ((r & 3) == 3) __builtin_amdgcn_sched_barrier(0);
        }
    }
  }
}

__device__ __forceinline__ void hgrn_load_cumsum(const P& p, int tok0, int hh, int d, int hf, float (&lf)[32],
                                                 float (&cs)[32]) {
  const float* src = (const float*)(p.ws + OFF_LOGF) + (size_t)(tok0 + hf * 32) * 512 + hh * 128 + d;
#pragma unroll
  for (int i = 0; i < 32; ++i) lf[i] = src[(size_t)i * 512];
  float run = 0.f;
#pragma unroll
  for (int i = 0; i < 32; ++i) { run += lf[i]; cs[i] = run; }
}
__device__ __forceinline__ void put_td(char* base, int t, int d, float v) {
  const int kt = d >> 6, dd = d & 63;
  *(u16*)(base + kt * 8192 + t * 128 + (((dd >> 3) ^ ((t >> 1) & 7)) << 4) + (dd & 7) * 2) = f2bf(v);
}

__device__ __forceinline__ void h1_item(const P& p, int item, char* smem, int tid) {
  const int lane = tid & 63, w = tid >> 6, wm = w & 1, wn = w >> 1;
  const int b = item >> 9, hh = (item >> 7) & 3, c = item & 127;
  const int tok0 = b * SEQ + c * 64;
  const int d = tid & 127, hf = tid >> 7;
  char* vts = smem;
  char* kts = smem + 16384;
  float* tot = (float*)(smem + 65536);
  u32x4 vr[4];
  g2r<128>(vr, (const u16*)(p.ws + OFF_HVT) + ((size_t)(b * 512 + hh * 128)) * 8192 + c * 64, 8192, tid);
  float lf[32], cs[32];
  hgrn_load_cumsum(p, tok0, hh, d, hf, lf, cs);
  tot[hf * 128 + d] = cs[31];
  r2s<128>(vr, vts, tid);
  __syncthreads();
  const float after = hf ? 0.f : tot[128 + d];
  if (hf) ((float*)(p.ws + OFF_GDEC))[(size_t)item * 128 + d] = __expf(cs[31] + tot[d]);
#pragma unroll
  for (int ch = 0; ch < 4; ++ch) {
    u32 o[4];
#pragma unroll
    for (int j = 0; j < 4; ++j) {
      const int i0 = ch * 8 + 2 * j;
      const float k0 = (1.f - __expf(lf[i0])) * __expf(cs[31] - cs[i0] + after);
      const float k1 = (1.f - __expf(lf[i0 + 1])) * __expf(cs[31] - cs[i0 + 1] + after);
      o[j] = pack2(k0, k1);
    }
    const int chunk = hf * 4 + ch;
    *(u32x4*)(kts + d * 128 + ((chunk ^ ((d >> 1) & 7)) << 4)) = u32x4{o[0], o[1], o[2], o[3]};
  }
  __syncthreads();
  f32x16 acc[2][2];
  zero_acc<2>(acc);
  mma_tile<2, 2>(acc, vts, wm * 64, kts, wn * 64, lane);
  u16* us = (u16*)(p.ws + OFF_US) + (size_t)item * 16384;
#pragma unroll
  for (int mi = 0; mi < 2; ++mi)
#pragma unroll
    for (int ni = 0; ni < 2; ++ni)
#pragma unroll
      for (int r = 0; r < 16; ++r) {
        const int e = wm * 64 + mi * 32 + rowof(r, lane);
        const int dd = wn * 64 + ni * 32 + (lane & 31);
        us[e * 128 + dd] = f2bf(acc[mi][ni][r]);
      }
}

__device__ __forceinline__ void h2_item(const P& p, int item, int tid) {
  const int g = item * 256 + tid;
  const int bh = g >> 13, e = (g >> 6) & 127, dp = g & 63;
  float s0 = 0.f, s1 = 0.f;
  u32* us = (u32*)(p.ws + OFF_US) + (size_t)bh * 128 * 8192 + e * 64 + dp;
  const float2* gd = (const float2*)(p.ws + OFF_GDEC) + (size_t)bh * 128 * 64 + dp;
#pragma unroll 1
  for (int c0 = 0; c0 < 128; c0 += 16) {
    u32 u[16];
    float2 g2[16];
#pragma unroll
    for (int i = 0; i < 16; ++i) { u[i] = us[(size_t)(c0 + i) * 8192]; g2[i] = gd[(c0 + i) * 64]; }
#pragma unroll
    for (int i = 0; i < 16; ++i) {
      us[(size_t)(c0 + i) * 8192] = pack2(s0, s1);
      s0 = g2[i].x * s0 + bf2f((u16)(u[i] & 0xFFFF));
      s1 = g2[i].y * s1 + bf2f((u16)(u[i] >> 16));
    }
  }
}

__device__ __forceinline__ void h3_item(const P& p, int l, int item, char* smem, int tid) {
  const int lane = tid & 63, w = tid >> 6, h = lane >> 5, lr = lane & 31;
  const int b = item >> 9, hh = (item >> 7) & 3, c = item & 127;
  const int tok0 = b * SEQ + c * 64;
  const int d = tid & 127, hf = tid >> 7;
  char* R0 = smem;
  char* R1 = smem + 16384;
  char* R2 = smem + 32768;
  char* R3 = smem + 49152;
  float* tot = (float*)(smem + 65536);
  const u16* usb = (const u16*)(p.ws + OFF_US) + (size_t)item * 16384;
  u32x4 vr[4], s0r[4], s1r[4];
  g2r<128>(vr, (const u16*)(p.ws + OFF_HVT) + ((size_t)(b * 512 + hh * 128)) * 8192 + c * 64, 8192, tid);
  g2r<128>(s0r, usb, 128, tid);
  g2r<128>(s1r, usb + 64, 128, tid);
  float lf[32], cs[32], q[32];
  hgrn_load_cumsum(p, tok0, hh, d, hf, lf, cs);
  {
    const u16* qs = (const u16*)(p.ws + OFF_HQ) + (size_t)(tok0 + hf * 32) * 512 + hh * 128 + d;
#pragma unroll
    for (int i = 0; i < 32; ++i) q[i] = bf2f(qs[(size_t)i * 512]);
  }
  if (hf == 0) tot[d] = cs[31];
  r2s<128>(vr, R3, tid);
  r2s<128>(s0r, R2, tid);
  __syncthreads();
  const float t0 = tot[d];
#pragma unroll
  for (int i = 0; i < 32; ++i) {
    const int t = hf * 32 + i;
    const float rel = hf ? cs[i] : cs[i] - t0;
    put_td(R0, t, d, q[i] * __expf(rel));
    put_td(R1, t, d, (1.f - __expf(lf[i])) * __expf(-rel));
  }
  __syncthreads();
  {
    const int sb = w & 1, tb = w >> 1;
    f32x16 a1[1][1];
#pragma unroll
    for (int r = 0; r < 16; ++r) a1[0][0][r] = 0.f;
    if (sb <= tb) {
      mma_tile<1, 1>(a1, R1, sb * 32, R0, tb * 32, lane);
      mma_tile<1, 1>(a1, R1 + 8192, sb * 32, R0 + 8192, tb * 32, lane);
    }
    __syncthreads();
    const int t = tb * 32 + lr;
#pragma unroll
    for (int rg = 0; rg < 4; ++rg) {
      float v[4];
#pragma unroll
      for (int j = 0; j < 4; ++j) {
        const int s = sb * 32 + 8 * rg + 4 * h + j;
        v[j] = (s <= t) ? a1[0][0][rg * 4 + j] : 0.f;
      }
      const int s0 = sb * 32 + 8 * rg + 4 * h;
      *(u32x2*)(R1 + t * 128 + (((s0 >> 3) ^ ((t >> 1) & 7)) << 4) + (s0 & 7) * 2) =
          u32x2{pack2(v[0], v[1]), pack2(v[2], v[3])};
    }
#pragma unroll
    for (int i = 0; i < 32; ++i) {
      const int tt = hf * 32 + i;
      put_td(R0, tt, d, q[i] * __expf(hf ? cs[i] + t0 : cs[i]));
    }
  }
  __syncthreads();
  f32x16 o[1][2];
#pragma unroll
  for (int ni = 0; ni < 2; ++ni)
#pragma unroll
    for (int r = 0; r < 16; ++r) o[0][ni][r] = 0.f;
  mma_tile<1, 2>(o, R2, w * 32, R0, 0, lane);
  mma_tile<1, 2>(o, R3, w * 32, R1, 0, lane);
  __syncthreads();
  r2s<128>(s1r, R2, tid);
  __syncthreads();
  mma_tile<1, 2>(o, R2, w * 32, R0 + 8192, 0, lane);
  float* red = tot;
#pragma unroll
  for (int ni = 0; ni < 2; ++ni) {
    float ss = 0.f;
#pragma unroll
    for (int r = 0; r < 16; ++r) ss += o[0][ni][r] * o[0][ni][r];
    ss += __shfl_xor(ss, 32);
    if (h == 0) red[w * 64 + ni * 32 + lr] = ss;
  }
  __syncthreads();
#pragma unroll
  for (int ni = 0; ni < 2; ++ni) {
    const int t = ni * 32 + lr;
    const float ss = red[t] + red[64 + t] + red[128 + t] + red[192 + t];
    const float rn = rsqrtf(ss * (1.f / 128.f) + EPS);
    const size_t rowo = (size_t)(tok0 + t) * 512 + hh * 128;
#pragma unroll
    for (int rg = 0; rg < 4; ++rg) {
      const int e0 = w * 32 + 8 * rg + 4 * h;
      const u32x2 gg = *(const u32x2*)((const u16*)(p.ws + OFF_HG) + rowo + e0);
      const float4 nw = *(const float4*)(p.hn + l * 128 + e0);
      const float y0 = o[0][ni][rg * 4 + 0] * rn * nw.x * bf2f((u16)(gg.x & 0xFFFF));
      const float y1 = o[0][ni][rg * 4 + 1] * rn * nw.y * bf2f((u16)(gg.x >> 16));
      const float y2 = o[0][ni][rg * 4 + 2] * rn * nw.z * bf2f((u16)(gg.y & 0xFFFF));
      const float y3 = o[0][ni][rg * 4 + 3] * rn * nw.w * bf2f((u16)(gg.y >> 16));
      *(u32x2*)((u16*)(p.ws + OFF_YH) + rowo + e0) = u32x2{pack2(y0, y1), pack2(y2, y3)};
    }
  }
}

__device__ __forceinline__ size_t code_rowoff(int q) {
  const int g = q >> 7, r = q & 127;
  return (size_t)128 * ((size_t)64 * g * (g + 1) + (size_t)r * (g + 1));
}
__device__ __forceinline__ u32 tocode(float s) {
  u32 u = __float_as_uint(s);
  if ((u << 1) == 0) u = 0;
  u = (u & 0x80000000u) ? ~u : (u | 0x80000000u);
  u >>= 16;
  return u < 1 ? 1 : u;
}
__device__ __forceinline__ void b1_item(const P& p, int item, char* smem, int tid) {
  const int lane = tid & 63, w = tid >> 6, wm = w & 1, wn = w >> 1, lr = lane & 31;
  const int b = item >= 2080;
  int idx = item - b * 2080;
  int g = (int)((sqrtf(8.f * idx + 1.f) - 1.f) * 0.5f);
  while (g * (g + 1) / 2 > idx) --g;
  while ((g + 1) * (g + 2) / 2 <= idx) ++g;
  const int kt = idx - g * (g + 1) / 2;
  const int q0 = b * SEQ + g * 128, k0 = b * SEQ + kt * 128;
  char* ys = smem;
  char* xs = smem + 16384;
  float* wsm = (float*)(smem + 49152);
  const u16* IQ = (const u16*)(p.ws + OFF_IQ) + (size_t)q0 * 256;
  const u16* IK = (const u16*)(p.ws + OFF_IK) + (size_t)k0 * 64;
  u32x4 xr[4], yr[4];
  g2r<128>(yr, IK, 64, tid);
  g2r<128>(xr, IQ, 256, tid);
  if (tid < 128) *(float4*)(wsm + tid * 4) = *(const float4*)(p.ws + OFF_IW + (size_t)(q0 + tid) * 16);
  r2s<128>(yr, ys, tid);
  r2s<128>(xr, xs, tid);
  __syncthreads();
  f32x16 sc[2][2];
  zero_acc<2>(sc);
#pragma unroll 1
  for (int hd = 0; hd < 4; ++hd) {
    if (hd < 3) g2r<128>(xr, IQ + (hd + 1) * 64, 256, tid);
#pragma unroll
    for (int mi = 0; mi < 2; ++mi) {
      f32x16 acc[1][2];
#pragma unroll
      for (int ni = 0; ni < 2; ++ni)
#pragma unroll
        for (int r = 0; r < 16; ++r) acc[0][ni][r] = 0.f;
      mma_tile<1, 2>(acc, xs + (hd & 1) * 16384, wm * 64 + mi * 32, ys, wn * 64, lane);
#pragma unroll
      for (int r = 0; r < 16; ++r) {
        const float wv = wsm[(wm * 64 + mi * 32 + rowof(r, lane)) * 4 + hd];
#pragma unroll
        for (int ni = 0; ni < 2; ++ni) sc[mi][ni][r] += wv * fmaxf(acc[0][ni][r], 0.f);
      }
      __builtin_amdgcn_sched_barrier(0);
    }
    if (hd < 3) r2s<128>(xr, xs + ((hd + 1) & 1) * 16384, tid);
    __syncthreads();
  }
  u16* codes = (u16*)(p.ws + OFF_CODES) + (size_t)b * CODES_PER_BATCH;
  char* st = smem + 16384;
#pragma unroll
  for (int mi = 0; mi < 2; ++mi)
#pragma unroll
    for (int r = 0; r < 16; ++r) {
      const int ql = wm * 64 + mi * 32 + rowof(r, lane);
      const int q = g * 128 + ql;
#pragma unroll
      for (int ni = 0; ni < 2; ++ni) {
        const int kl = wn * 64 + ni * 32 + lr;
        const bool vis = (kt * 128 + kl) <= q;
        const u32 cd = vis ? tocode(sc[mi][ni][r]) : 0u;
        *(u16*)(st + ql * 256 + (2 * (ni * 32 + lr) + wn) * 2) = (u16)cd;
      }
    }
  __syncthreads();
  {
    u16* dst0 = codes + code_rowoff(g * 128) + kt * 128;
    const size_t rstride = (size_t)128 * (g + 1);
#pragma unroll
    for (int i = 0; i < 8; ++i) {
      const int cid = tid + 256 * i;
      const int row = cid >> 4, c = cid & 15;
      __builtin_nontemporal_store(*(const u32x4*)(st + row * 256 + c * 16), (u32x4*)(dst0 + (size_t)row * rstride + c * 8));
    }
  }
}

__device__ __forceinline__ int wave_isum(int c) {
#pragma unroll
  for (int o = 32; o >= 1; o >>= 1) c += __shfl_xor(c, o);
  return c;
}
__device__ __forceinline__ int count_ge(const u32 (&r)[64], int nj, u32 t) {
  const u16 tm1 = (u16)(t - 1);
  const u16x2 tv = {tm1, tm1};
  const u16x2 one = {1, 1};
  u16x2 acc = {0, 0};
#pragma unroll
  for (int jb = 0; jb < 8; ++jb) {
    if (jb * 8 < nj) {
#pragma unroll
      for (int jj = 0; jj < 8; ++jj) {
        u16x2 d = __builtin_elementwise_sub_sat(__builtin_bit_cast(u16x2, r[jb * 8 + jj]), tv);
        d = __builtin_elementwise_min(d, one);
        acc += d;
      }
    }
  }
  return wave_isum((int)acc.x + (int)acc.y);
}
__device__ __forceinline__ int snake_item(int k, int bid, int nb);
__device__ __forceinline__ void b2_load(const P& p, int item, int tid, u32 (&r)[64]) {
  const int lane = tid & 63, w = tid >> 6;
  const int Q = item * 4 + w;
  const int b = Q >> 13, q = Q & 8191;
  const int nj = (q >> 7) + 1;
  const u32* row = (const u32*)((const u16*)(p.ws + OFF_CODES) + (size_t)b * CODES_PER_BATCH + code_rowoff(q));
#pragma unroll
  for (int j = 0; j < 64; ++j) r[j] = (j < nj) ? __builtin_nontemporal_load(row + j * 64 + lane) : 0u;
}
__device__ __forceinline__ void b2_process(const P& p, int item, char* smem, int tid, const u32 (&r)[64]) {
  const int lane = tid & 63, w = tid >> 6;
  const int Q = item * 4 + w;
  const int q = Q & 8191;
  const int nj = (q >> 7) + 1;
  u16x2 m1 = {0, 0}, m2 = {0, 0};
#pragma unroll
  for (int jb = 0; jb < 8; ++jb) {
    if (jb * 8 < nj) {
#pragma unroll
      for (int jj = 0; jj < 8; ++jj) {
        const u16x2 x = __builtin_bit_cast(u16x2, r[jb * 8 + jj]);
        const u16x2 t = __builtin_elementwise_min(m1, x);
        m1 = __builtin_elementwise_max(m1, x);
        m2 = __builtin_elementwise_max(m2, t);
      }
    }
  }
  int L = min((int)m2.x, (int)m2.y), H = max((int)m1.x, (int)m1.y);
#pragma unroll
  for (int o = 32; o >= 1; o >>= 1) { L = min(L, __shfl_xor(L, o)); H = max(H, __shfl_xor(H, o)); }
  u32 T = 0;
  int need = 0;
  u32 lo = L < 1 ? 1u : (u32)L;
  if (lo > 1 || count_ge(r, nj, 1) >= 256) {
    const int R = H - (int)lo + 1;
    if (R <= 2048) {
      u32* hist = (u32*)(smem + w * 8192);
      const int nbl = (R + 63) >> 6;
      for (int i = 0; i < nbl; ++i) hist[i * 64 + lane] = 0u;
#pragma unroll
      for (int jb = 0; jb < 8; ++jb) {
        if (jb * 8 < nj) {
#pragma unroll
          for (int jj = 0; jj < 8; ++jj) {
            const u32 v = r[jb * 8 + jj];
            const u32 c0 = v & 0xFFFFu, c1 = v >> 16;
            if (c0 >= lo) atomicAdd(&hist[c0 - lo], 1u);
            if (c1 >= lo) atomicAdd(&hist[c1 - lo], 1u);
          }
        }
      }
      int sl = 0;
      for (int i = 0; i < nbl; ++i) sl += (int)hist[lane * nbl + i];
      int suf = sl;
#pragma unroll
      for (int d = 1; d <= 32; d <<= 1) {
        const int v = __shfl_down(suf, d);
        suf += (lane + d < 64) ? v : 0;
      }
      const u64 okm = __ballot(suf >= 256);
      const int istar = 63 - __builtin_clzll(okm);
      int cacc = suf - sl, tbin = 0, cgt = 0;
      bool found = false;
      for (int i = nbl - 1; i >= 0; --i) {
        const int hc = (int)hist[lane * nbl + i];
        if (!found && cacc + hc >= 256) { found = true; tbin = lane * nbl + i; cgt = cacc; }
        cacc += hc;
      }
      tbin = __shfl(tbin, istar);
      cgt = __shfl(cgt, istar);
      T = lo + (u32)tbin;
      need = 256 - cgt;
    } else {
      u32 hi = (u32)H + 1u;
      while (hi - lo > 1) {
        const u32 mid = (lo + hi) >> 1;
        if (count_ge(r, nj, mid) >= 256) lo = mid; else hi = mid;
      }
      T = lo;
      const int cgt = (T >= 65535u) ? 0 : count_ge(r, nj, T + 1);
      need = 256 - cgt;
    }
  }
  int mlo[2] = {0, 0}, mhi[2] = {0, 0};
  const u32 thi = (T << 16) | 0xFFFFu;
#pragma unroll
  for (int j = 0; j < 64; ++j) {
    if (j < nj) {
#pragma unroll
      for (int hfw = 0; hfw < 2; ++hfw) {
        const u32 cd = hfw ? (r[j] >> 16) : (r[j] & 0xFFFFu);
        u64 word = hfw ? __ballot(r[j] > thi) : __ballot(cd > T);
        if (T > 0 && need > 0) {
          const bool eq = cd == T;
          const u64 eqm = __ballot(eq);
          if (eqm != 0) {
            const int rank = __builtin_amdgcn_mbcnt_hi((u32)(eqm >> 32), __builtin_amdgcn_mbcnt_lo((u32)eqm, 0));
            word |= __ballot(eq && rank < need);
            need -= __popcll(eqm);
          }
        }
        const int widx = 2 * j + hfw;
        if (lane == (widx & 63)) { mlo[widx >> 6] = (int)(u32)word; mhi[widx >> 6] = (int)(u32)(word >> 32); }
      }
    }
  }
  u32x2* mrow = (u32x2*)(p.ws + OFF_MASK + (size_t)Q * 1024);
#pragma unroll
  for (int k = 0; k < 2; ++k)
    if (lane + 64 * k < 2 * nj) mrow[lane + 64 * k] = u32x2{(u32)mlo[k], (u32)mhi[k]};
}

__device__ __forceinline__ void b2_phase(const P& p, int bid, int nb, char* smem, int tid) {
  const int rounds = (4096 + nb - 1) / nb;
  u32 ra[64], rb[64];
  int ia = snake_item(0, bid, nb);
  if (ia < 4096) b2_load(p, ia, tid, ra);
#pragma unroll 1
  for (int k = 0; k < rounds; k += 2) {
    const int ib = (k + 1 < rounds) ? snake_item(k + 1, bid, nb) : 4096;
    if (ib < 4096) b2_load(p, ib, tid, rb);
    if (ia < 4096) b2_process(p, ia, smem, tid, ra);
    ia = (k + 2 < rounds) ? snake_item(k + 2, bid, nb) : 4096;
    if (ia < 4096) b2_load(p, ia, tid, ra);
    if (ib < 4096) b2_process(p, ib, smem, tid, rb);
  }
}

__device__ __forceinline__ void b3_item(const P& p, int l, int item, char* smem, int tid) {
  const int lane = tid & 63, w = tid >> 6, h = lane >> 5, lr = lane & 31;
  const int g = 63 - (item >> 4), rem = item & 15, b = rem >> 3, head = rem & 7;
  const int q0 = g * 128;
  const int nkt = 2 * g + 2;
  const u16* AK = (const u16*)(p.ws + OFF_AK) + (size_t)b * SEQ * 512 + head * 64;
  const u16* AVT = (const u16*)(p.ws + OFF_AVT) + ((size_t)(b * 512 + head * 64)) * 8192;
  const u64* MK = (const u64*)(p.ws + OFF_MASK) + (size_t)(b * SEQ + q0) * 128;
  bf16x8 qf[4];
  {
    const u16* qrow = (const u16*)(p.ws + OFF_AQ) + (size_t)(b * SEQ + q0 + w * 32 + lr) * 512 + head * 64;
#pragma unroll
    for (int ks = 0; ks < 4; ++ks) qf[ks] = *(const bf16x8*)(qrow + ks * 16 + 8 * h);
  }
  u32x4 kr[2], vr[2];
  u64 mr = 0;
  g2r<64>(kr, AK, 512, tid);
  g2r<64>(vr, AVT, 8192, tid);
  if (tid < 128) mr = MK[(size_t)tid * 128];
  r2s<64>(kr, smem, tid);
  r2s<64>(vr, smem + 8192, tid);
  if (tid < 128) *(u64*)(smem + 16384 + tid * 8) = mr;
  __syncthreads();
  f32x16 oacc[2];
#pragma unroll
  for (int i = 0; i < 2; ++i)
#pragma unroll
    for (int r = 0; r < 16; ++r) oacc[i][r] = 0.f;
  float mrun = -5e29f, lrun = 0.f;
  float mq = fabsf(p.qn[l * 64 + lane]), mk = fabsf(p.kn[l * 64 + lane]);
#pragma unroll
  for (int o = 32; o >= 1; o >>= 1) { mq = fmaxf(mq, __shfl_xor(mq, o)); mk = fmaxf(mk, __shfl_xor(mk, o)); }
  const bool fast = (0.125f * 1.4426950408889634f * 64.f * 1.03f) * mq * mk + 1.f < 60.f;
  for (int kt = 0; kt < nkt; ++kt) {
    const char* buf = smem + (kt & 1) * 17408;
    char* nbuf = smem + ((kt + 1) & 1) * 17408;
    if (kt + 1 < nkt) {
      g2r<64>(kr, AK + (size_t)(kt + 1) * 64 * 512, 512, tid);
      g2r<64>(vr, AVT + (kt + 1) * 64, 8192, tid);
      if (tid < 128) mr = MK[(size_t)tid * 128 + kt + 1];
    }
    const u64 m64 = *(const u64*)(buf + 16384 + (w * 32 + lr) * 8);
    const u64 msh = ~(m64 >> (4 * h));
    const int w0 = (int)(u32)msh, w1 = (int)(u32)(msh >> 32);
    f32x16 s[2];
#pragma unroll
    for (int kb = 0; kb < 2; ++kb) {
#pragma unroll
      for (int r = 0; r < 16; ++r)
        s[kb][r] = __int_as_float(__builtin_amdgcn_sbfe(kb ? w1 : w0, (r & 3) + 8 * (r >> 2), 1) & (int)0xF149F2CAu);
#pragma unroll
      for (int ks = 0; ks < 4; ++ks)
        s[kb] = __builtin_amdgcn_mfma_f32_32x32x16_bf16(lds_frag(buf, kb * 32 + lr, ks * 2 + h), qf[ks], s[kb], 0, 0, 0);
    }
    float psum = 0.f;
    if (fast) {
#pragma unroll
      for (int kb = 0; kb < 2; ++kb)
#pragma unroll
        for (int r = 0; r < 16; ++r) {
          const float pv = __builtin_amdgcn_exp2f(s[kb][r]);
          s[kb][r] = pv;
          psum += pv;
        }
    } else {
      float tmax = s[0][0];
#pragma unroll
      for (int kb = 0; kb < 2; ++kb)
#pragma unroll
        for (int r = 0; r < 16; ++r) tmax = fmaxf(tmax, s[kb][r]);
      tmax = fmaxf(tmax, __shfl_xor(tmax, 32));
      if (__any(tmax > mrun)) {
        const float mnew = fmaxf(mrun, tmax);
        const float alpha = __builtin_amdgcn_exp2f(mrun - mnew);
        mrun = mnew;
        lrun *= alpha;
#pragma unroll
        for (int i = 0; i < 2; ++i)
#pragma unroll
          for (int r = 0; r < 16; ++r) oacc[i][r] *= alpha;
      }
#pragma unroll
      for (int kb = 0; kb < 2; ++kb)
#pragma unroll
        for (int r = 0; r < 16; ++r) {
          const float pv = __builtin_amdgcn_exp2f(s[kb][r] - mrun);
          s[kb][r] = pv;
          psum += pv;
        }
    }
    lrun += psum;
    const char* vt = buf + 8192;
#pragma unroll
    for (int kb = 0; kb < 2; ++kb)
#pragma unroll
      for (int s2 = 0; s2 < 2; ++s2) {
        union { bf16x8 v; u32 u[4]; } pf;
#pragma unroll
        for (int j = 0; j < 4; ++j) pf.u[j] = pack2(s[kb][8 * s2 + 2 * j], s[kb][8 * s2 + 2 * j + 1]);
#pragma unroll
        for (int db = 0; db < 2; ++db) {
          const int drow = db * 32 + lr;
          const int ch = kb * 4 + 2 * s2;
          const int sw = (drow >> 1) & 7;
          union { bf16x8 v; u32x2 u[2]; } vf;
          vf.u[0] = *(const u32x2*)(vt + drow * 128 + ((ch ^ sw) << 4) + 8 * h);
          vf.u[1] = *(const u32x2*)(vt + drow * 128 + (((ch + 1) ^ sw) << 4) + 8 * h);
          oacc[db] = __builtin_amdgcn_mfma_f32_32x32x16_bf16(vf.v, pf.v, oacc[db], 0, 0, 0);
        }
      }
    if (kt + 1 < nkt) {
      r2s<64>(kr, nbuf, tid);
      r2s<64>(vr, nbuf + 8192, tid);
      if (tid < 128) *(u64*)(nbuf + 16384 + tid * 8) = mr;
    }
    __syncthreads();
  }
  lrun += __shfl_xor(lrun, 32);
  const float inv = 1.f / lrun;
  u16* yrow = (u16*)(p.ws + OFF_YA) + (size_t)(b * SEQ + q0 + w * 32 + lr) * 512 + head * 64;
#pragma unroll
  for (int db = 0; db < 2; ++db)
#pragma unroll
    for (int rg = 0; rg < 4; ++rg) {
      const int d0 = db * 32 + 8 * rg + 4 * h;
      *(u32x2*)(yrow + d0) = u32x2{pack2(oacc[db][rg * 4] * inv, oacc[db][rg * 4 + 1] * inv),
                                   pack2(oacc[db][rg * 4 + 2] * inv, oacc[db][rg * 4 + 3] * inv)};
    }
}

__device__ __forceinline__ void d1_item(const P& p, int l, int mt, int nt, char* smem, int tid) {
  const int lane = tid & 63, w = tid >> 6, wm = w & 1, wn = w >> 1, lr = lane & 31;
  const int m0 = mt * 128, n0 = nt * 64;
  float* rs = (float*)(smem + 65536);
  const float* rowss = (const float*)(p.ws + OFF_ROWSS);
  if (tid < 128) rs[tid] = row_rstd(rowss, m0 + tid);
  const u16* XB = (const u16*)(p.ws + OFF_XB) + (size_t)m0 * 1024;
  f32x16 ag[2][2];
  zero_acc<2>(ag);
  gemm_loop<128, 2>(ag, XB, 1024, (const u16*)(p.ws + OFF_WGATE) + (size_t)nt * 128 * 1024, 1024, 16, smem, tid);
#pragma unroll
  for (int mi = 0; mi < 2; ++mi)
#pragma unroll
    for (int r = 0; r < 16; ++r) {
      const float rstd = rs[wm * 64 + mi * 32 + rowof(r, lane)];
      ag[mi][0][r] = sigmoidf_(ag[mi][0][r] * rstd);
      ag[mi][1][r] = sigmoidf_(ag[mi][1][r] * rstd);
    }
  f32x16 res[2][1], ap[2][1];
#pragma unroll
  for (int br = 0; br < 2; ++br) {
    zero_acc<1>(ap);
    const u16* Y = (const u16*)(p.ws + (br ? OFF_YH : OFF_YA)) + (size_t)m0 * 512;
    const u16* WP = (const u16*)(p.ws + (br ? OFF_WPH : OFF_WPA)) + (size_t)n0 * 512;
    gemm_loop<64, 1>(ap, Y, 512, WP, 512, 8, smem, tid);
#pragma unroll
    for (int mi = 0; mi < 2; ++mi)
#pragma unroll
      for (int r = 0; r < 16; ++r) {
        const float v = ag[mi][br][r] * ap[mi][0][r];
        res[mi][0][r] = br ? res[mi][0][r] + v : v;
      }
  }
  u16* M = (u16*)(p.ws + OFF_MERGED);
#pragma unroll
  for (int mi = 0; mi < 2; ++mi)
#pragma unroll
    for (int r = 0; r < 16; ++r) {
      const int tok = m0 + wm * 64 + mi * 32 + rowof(r, lane);
      M[(size_t)tok * 1024 + n0 + wn * 32 + lr] = f2bf(res[mi][0][r]);
    }
}

__device__ __forceinline__ void resid_item(const P& p, const u16* A, int K, const u16* W, float* rowss_next, int mt, int nt, char* smem,
                           int tid) {
  const int lane = tid & 63, w = tid >> 6, wm = w & 1, wn = w >> 1, lr = lane & 31;
  const int m0 = mt * 128, n0 = nt * 128;
  f32x16 acc[2][2];
  zero_acc<2>(acc);
  gemm_loop<128, 2>(acc, A + (size_t)m0 * K, K, W + (size_t)n0 * K, K, K >> 6, smem, tid);
  u16* XB = (u16*)(p.ws + OFF_XB);
  float myss = 0.f;
  int mytok = 0;
#pragma unroll
  for (int mi = 0; mi < 2; ++mi)
#pragma unroll
    for (int r = 0; r < 16; ++r) {
      const int tok = m0 + wm * 64 + mi * 32 + rowof(r, lane);
      float ss = 0.f;
#pragma unroll
      for (int ni = 0; ni < 2; ++ni) {
        const size_t o = (size_t)tok * 1024 + n0 + wn * 64 + ni * 32 + lr;
        const float xn = p.out[o] + acc[mi][ni][r];
        p.out[o] = xn;
        XB[o] = f2bf(xn);
        ss += xn * xn;
      }
#pragma unroll
      for (int of = 16; of >= 1; of >>= 1) ss += __shfl_xor(ss, of);
      if (lr == mi * 16 + r) { myss = ss; mytok = tok; }
      __builtin_amdgcn_sched_barrier(0);
    }
  rowss_next[(size_t)mytok * 16 + nt * 2 + wn] = myss;
}

__device__ __forceinline__ void e_item(const P& p, int l, int mt, int nt, char* smem, int tid) {
  const int lane = tid & 63, w = tid >> 6, wm = w & 1, wn = w >> 1, lr = lane & 31;
  const int m0 = mt * 128;
  float* rs = (float*)(smem + 65536);
  const float* rowss = (const float*)(p.ws + OFF_ROWSS) + (size_t)NTOK * 16;
  if (tid < 128) rs[tid] = row_rstd(rowss, m0 + tid);
  f32x16 acc[2][2];
  zero_acc<2>(acc);
  gemm_loop<128, 2>(acc, (const u16*)(p.ws + OFF_XB) + (size_t)m0 * 1024, 1024,
                    (const u16*)(p.ws + OFF_WFFI) + (size_t)nt * 128 * 1024, 1024, 16, smem, tid);
  u16* ACT = (u16*)(p.ws + OFF_ACT);
#pragma unroll
  for (int mi = 0; mi < 2; ++mi)
#pragma unroll
    for (int r = 0; r < 16; ++r) {
      const int tl = wm * 64 + mi * 32 + rowof(r, lane);
      const float rstd = rs[tl];
      const float gv = acc[mi][0][r] * rstd, uv = acc[mi][1][r] * rstd;
      ACT[(size_t)(m0 + tl) * DFF + nt * 64 + wn * 32 + lr] = f2bf(siluf_(gv) * uv);
    }
}

constexpr int PPL = 10;
#ifndef ONLY_S
#define ONLY_S -1
#endif
#define EN(k) (ONLY_S < 0 || ONLY_S == (k))
template <class F>
__device__ __forceinline__ void for_tiles(int NT, int bid, int nb, F f) {
  if ((nb & 63) == 0) {
    const int vx = bid & 7, j = bid >> 3, JN = nb >> 6;
    const int jm = j & 7, jn = j >> 3;
    const int NG = (NT + JN - 1) / JN;
    const int wl = NT - (NG - 1) * JN;
    const bool fold = (wl * 2 == JN);
    const int NGF = fold ? NG - 1 : NG;
    for (int r = 0; r < 2 * NGF; ++r) {
      const int mh = r / NGF, ng = r - mh * NGF;
      const int mt = vx * 16 + mh * 8 + jm, nt = ng * JN + jn;
      if (nt < NT) f(mt, nt);
    }
    if (fold) f(vx * 16 + (jn / wl) * 8 + jm, (NG - 1) * JN + (jn % wl));
  } else {
    for (int it = bid; it < 128 * NT; it += nb) f(it / NT, it % NT);
  }
}
__device__ __forceinline__ int snake_item(int k, int bid, int nb) {
  return (k & 1) ? (((k + 1) * nb - 1 - bid) ^ 7) : (k * nb + bid);
}

__device__ __forceinline__ void run_phase(const P& p, int ph, char* smem) {
  int tid0 = threadIdx.x;
  asm volatile("" : "+v"(tid0));
  const int nb = gridDim.x;
  int bid = blockIdx.x;
  asm volatile("" : "+s"(bid));
#define LAUNDER int tid = tid0; asm volatile("" : "+v"(tid)); __syncthreads();
  if (ph == 0) {
    if (EN(11)) for (int it = bid; it < 4096 + 4128; it += nb) { LAUNDER
      if (it < 4096) p0_rows(p, it, tid); else conv_item(p, 0, it - 4096, smem, tid);
    }
    return;
  }
  const int l = (ph - 1) / PPL;
  const int smap[PPL] = {0, 4, 5, 6, 2, 3, 7, 8, 9, 10};
  const int s = smap[(ph - 1) % PPL];
  float* rowss = (float*)(p.ws + OFF_ROWSS);
  switch (s) {
    case 0: if (EN(0)) {
      const int par = (bid >> 8) & 1;
      if (l > 0 && par) for (int it = bid; it < 704; it += nb) { LAUNDER conv_item(p, l, 3424 + it, smem, tid); }
      for_tiles(31, bid, nb, [&](int mt, int nt) { LAUNDER phaseA_tile(p, l, mt, nt, smem, tid); });
      if (l > 0 && !par) for (int it = bid; it < 704; it += nb) { LAUNDER conv_item(p, l, 3424 + it, smem, tid); }
    } break;
    case 2: if (EN(2)) for (int it = bid; it < 256; it += nb) { LAUNDER h2_item(p, it, tid); } break;
    case 3: if (EN(3)) for (int it = bid; it < 1024; it += nb) { LAUNDER h3_item(p, l, it, smem, tid); } break;
    case 4: if (EN(4)) for (int it = bid; it < 4160; it += nb) { LAUNDER b1_item(p, it, smem, tid); } break;
    case 5: if (EN(5)) { int tid = tid0; asm volatile("" : "+v"(tid)); b2_phase(p, bid, nb, smem, tid); } break;
    case 6: if (EN(6)) {
      const int par = (bid >> 8) & 1;
      if (par) for (int it = bid; it < 1024; it += nb) { LAUNDER h1_item(p, it, smem, tid); }
      for (int k = 0; k * nb < 1024; ++k) { const int it = snake_item(k, bid, nb); if (it < 1024) { LAUNDER b3_item(p, l, it, smem, tid); } }
      if (!par) for (int it = bid; it < 1024; it += nb) { LAUNDER h1_item(p, it, smem, tid); }
    } break;
    case 7: if (EN(7)) for_tiles(16, bid, nb, [&](int mt, int nt) { LAUNDER d1_item(p, l, mt, nt, smem, tid); }); break;
    case 8:
      if (EN(8)) for_tiles(8, bid, nb, [&](int mt, int nt) { LAUNDER
        resid_item(p, (const u16*)(p.ws + OFF_MERGED), 1024, (const u16*)(p.ws + OFF_WOUT), rowss + (size_t)NTOK * 16, mt, nt, smem, tid); });
      break;
    case 9: if (EN(9)) for_tiles(44, bid, nb, [&](int mt, int nt) { LAUNDER e_item(p, l, mt, nt, smem, tid); }); break;
    case 10: if (EN(10)) {
      const int par = (bid >> 8) & 1;
      if (l < 3 && par) for (int it = bid; it < 3424; it += nb) { LAUNDER conv_item(p, l + 1, it, smem, tid); }
      for_tiles(8, bid, nb, [&](int mt, int nt) { LAUNDER
        resid_item(p, (const u16*)(p.ws + OFF_ACT), DFF, (const u16*)(p.ws + OFF_WFFO), rowss, mt, nt, smem, tid); });
      if (l < 3 && !par) for (int it = bid; it < 3424; it += nb) { LAUNDER conv_item(p, l + 1, it, smem, tid); }
    } break;
  }
#undef LAUNDER
}

constexpr int NPHASE = 1 + PPL * DEPTH;

#ifndef REP_MASK
#define REP_MASK 0
#endif
#define XB_TMO      128
#define XB_XCNT(j)  (256  + 64 * (j))
#define XB_XSUB(j)  (1280 + 64 * (j))
#define XB_XGEN(j)  (2304 + 64 * (j))
#define XB_TOP      3328
#define XB_TOPGEN   3392
#define XCD_BAR_WORDS 3456
#define XB_SPIN_CAP (1u << 18)
#define LAS __attribute__((address_space(3)))

__device__ __forceinline__ unsigned xb_ld(unsigned* p)              { return __hip_atomic_load(p, __ATOMIC_RELAXED, __HIP_MEMORY_SCOPE_AGENT); }
__device__ __forceinline__ unsigned xb_add(unsigned* p, unsigned v) { return __hip_atomic_fetch_add(p, v, __ATOMIC_RELAXED, __HIP_MEMORY_SCOPE_AGENT); }
__device__ __forceinline__ unsigned xb_xcc_id() { return (unsigned)__builtin_amdgcn_s_getreg((3 << 11) | 20) & 0xFu; }
#define XB_SPIN(cond, bar) do { unsigned _sp = 0; while (cond) { __builtin_amdgcn_s_sleep(1); \
    if ((++_sp & 255u) == 0u) { if (xb_ld(&(bar)[XB_TMO])) break; if (_sp > XB_SPIN_CAP) { atomicAdd(&(bar)[XB_TMO], 1u); break; } } } } while (0)

struct XcdBarrier {
    unsigned* bar; unsigned x;
    volatile LAS unsigned* st;
};

__device__ __forceinline__ XcdBarrier xcd_barrier_post(unsigned* bar, volatile LAS unsigned* st) {
    XcdBarrier b; b.bar = bar; b.x = xb_xcc_id(); b.st = st;
    if (threadIdx.x == 0) (void)xb_add(&bar[XB_XCNT(b.x)], 1u);
    return b;
}
__device__ __forceinline__ void xcd_barrier_complete(unsigned* bar, unsigned x, unsigned& nloc, unsigned& nx) {
    const unsigned G = gridDim.x * gridDim.y * gridDim.z;
    unsigned sum, cnt, mine, sp = 0u;
    for (;;) {
        sum = 0u; cnt = 0u; mine = 0u;
#pragma unroll
        for (unsigned j = 0; j < 16; ++j) { const unsigned c = xb_ld(&bar[XB_XCNT(j)]); sum += c; cnt += (c > 0u) ? 1u : 0u; mine = (j == x) ? c : mine; }
        if (sum == G) break;
        __builtin_amdgcn_s_sleep(1);
        if ((++sp & 255u) == 0u) { if (xb_ld(&bar[XB_TMO])) break; if (sp > XB_SPIN_CAP) { atomicAdd(&bar[XB_TMO], 1u); break; } }
    }
    nloc = mine > 0u ? mine : 1u; nx = cnt > 0u ? cnt : 1u;
}

__device__ __forceinline__ void xcd_barrier(const XcdBarrier& b) {
    asm volatile("s_waitcnt vmcnt(0)" ::: "memory");
    __syncthreads();
    if (threadIdx.x == 0) {
        unsigned* bar = b.bar;
        __builtin_amdgcn_s_waitcnt(0);
        unsigned nloc = b.st[0], nx = b.st[1];
        if (nloc == 0u) { xcd_barrier_complete(bar, b.x, nloc, nx); b.st[0] = nloc; b.st[1] = nx; }
        const unsigned old = xb_add(&bar[XB_XSUB(b.x)], 1u);
        const unsigned gen = old / nloc;
        if (old + 1u == (gen + 1u) * nloc) {
            __builtin_amdgcn_fence(__ATOMIC_RELEASE, "agent");
            asm volatile("s_waitcnt vmcnt(0)" ::: "memory");
            const unsigned og = xb_add(&bar[XB_TOP], 1u);
            const unsigned tg = og / nx;
            if (og + 1u == (tg + 1u) * nx) xb_add(&bar[XB_TOPGEN], 1u);
            else XB_SPIN(xb_ld(&bar[XB_TOPGEN]) == tg, bar);
            __builtin_amdgcn_fence(__ATOMIC_ACQUIRE, "agent");
            xb_add(&bar[XB_XGEN(b.x)], 1u);
            asm volatile("s_waitcnt vmcnt(0)" ::: "memory");
        } else {
            XB_SPIN(xb_ld(&bar[XB_XGEN(b.x)]) == gen, bar);
            __builtin_amdgcn_fence(__ATOMIC_ACQUIRE, "agent");
            asm volatile("s_waitcnt vmcnt(0)" ::: "memory");
        }
    }
    __syncthreads();
}


template <bool COOP>
__global__ void __launch_bounds__(256, 2) mega(P p, int ph0, int ph1) {
  __shared__ __attribute__((aligned(16))) char smem[66560];
  __shared__ uint4 xb_words;
  if (threadIdx.x == 0) xb_words = make_uint4(0u, 0u, 0u, 0u);
  __syncthreads();
  XcdBarrier xb = xcd_barrier_post((unsigned*)(p.ws + OFF_BAR), (volatile LAS unsigned*)&xb_words);
  for (int ph = ph0; ph < ph1; ++ph) {
    int reps = 1;
    if (REP_MASK != 0 && ph > 0 && ((REP_MASK >> ((ph - 1) % PPL)) & 1)) reps = 2;
    for (int rp = 0; rp < reps; ++rp) {
      run_phase(p, ph, smem);
      if (COOP) {
        if (ph + 1 < ph1 || rp + 1 < reps) {
          if (ph == 0) cg::this_grid().sync();
          else xcd_barrier(xb);
        }
      }
    }
  }
}

extern "C" void kernel_launch(void* const* d_in, const int* in_sizes, int n_in, void* d_out, int out_size, void* d_ws,
                              size_t ws_size, hipStream_t stream) {
  if (ws_size < WS_END) { fprintf(stderr, "workspace too small: %zu\n", ws_size); return; }
  P p{};
  p.x = (const float*)d_in[0]; p.pos = (const int*)d_in[1]; p.w_in = (const float*)d_in[2];
  p.w_pa = (const float*)d_in[3]; p.w_ph = (const float*)d_in[4]; p.w_out = (const float*)d_in[5];
  p.nmix = (const float*)d_in[6]; p.nffn = (const float*)d_in[7]; p.qn = (const float*)d_in[8];
  p.kn = (const float*)d_in[9]; p.hn = (const float*)d_in[10]; p.hlb = (const float*)d_in[11];
  p.w_ffi = (const float*)d_in[12]; p.w_ffo = (const float*)d_in[13];
  p.out = (float*)d_out; p.ws = (char*)d_ws;
#if COOP_MODE
  static int grid_blocks = 0;
  if (!grid_blocks) {
    int dev = 0, cus = 0, per_cu = 0;
    hipGetDevice(&dev);
    hipDeviceGetAttribute(&cus, hipDeviceAttributeMultiprocessorCount, dev);
    hipOccupancyMaxActiveBlocksPerMultiprocessor(&per_cu, mega<true>, 256, 0);
    if (per_cu > 2) per_cu = 2;
    grid_blocks = cus * per_cu;
  }
  int ph0 = 0, ph1 = NPHASE;
  hipMemsetAsync((char*)d_ws + OFF_BAR, 0, 16384, stream);
  void* args[] = {&p, &ph0, &ph1};
  hipError_t e = hipLaunchCooperativeKernel((void*)mega<true>, dim3(grid_blocks), dim3(256), args, 0, stream);
  if (e != hipSuccess) fprintf(stderr, "cooperative launch failed: %s (grid %d)\n", hipGetErrorString(e), grid_blocks);
#else
  for (int ph = 0; ph < NPHASE; ++ph) mega<false><<<dim3(512), dim3(256), 0, stream>>>(p, ph, ph + 1);
#endif
}
```

```cpp
#include <hip/hip_runtime.h>
#include <hip/hip_cooperative_groups.h>
#include <stdint.h>
#include <stdio.h>
namespace cg = cooperative_groups;

#ifndef COOP_MODE
#define COOP_MODE 1
#endif

typedef unsigned short u16;
typedef unsigned int u32;
typedef unsigned long long u64;
typedef __attribute__((ext_vector_type(8))) short bf16x8;
typedef __attribute__((ext_vector_type(16))) float f32x16;
typedef __attribute__((ext_vector_type(4))) u32 u32x4;
typedef __attribute__((ext_vector_type(2))) u32 u32x2;
typedef __attribute__((ext_vector_type(2))) unsigned short u16x2;

constexpr int NTOK = 16384, SEQ = 8192, DEPTH = 4;
constexpr int DFF = 2816;
constexpr float EPS = 1e-6f;
constexpr size_t MiB = (size_t)1 << 20;
constexpr size_t OFF_WIN = 0, OFF_WGATE = 8 * MiB, OFF_WPA = 12 * MiB, OFF_WPH = 13 * MiB, OFF_WOUT = 14 * MiB,
                 OFF_WFFI = 16 * MiB, OFF_WFFO = 27 * MiB, OFF_AQ = 33 * MiB, OFF_AK = 49 * MiB, OFF_AVT = 65 * MiB,
                 OFF_IQ = 81 * MiB, OFF_IK = 89 * MiB, OFF_IW = 91 * MiB, OFF_HQ = 92 * MiB, OFF_HVT = 108 * MiB,
                 OFF_HG = 124 * MiB, OFF_LOGF = 140 * MiB, OFF_XB = 172 * MiB, OFF_YH = 204 * MiB, OFF_MASK = 220 * MiB,
                 OFF_ROWSS = 236 * MiB, OFF_CODES = 238 * MiB, OFF_YA = OFF_CODES, OFF_US = OFF_CODES + 16 * MiB,
                 OFF_GDEC = OFF_CODES + 48 * MiB, OFF_MERGED = OFF_AQ, OFF_ACT = OFF_AQ, OFF_BAR = 32 * MiB + 768 * 1024, WS_END = 368 * MiB;
constexpr size_t CODES_PER_BATCH = (size_t)16384 * 2080;

struct P {
  const float* x; const int* pos; const float* w_in; const float* w_pa; const float* w_ph; const float* w_out;
  const float* nmix; const float* nffn; const float* qn; const float* kn; const float* hn; const float* hlb;
  const float* w_ffi; const float* w_ffo; float* out; char* ws;
};

__device__ __forceinline__ u16 f2bf(float f) {
  u32 u = __float_as_uint(f);
  u += 0x7FFFu + ((u >> 16) & 1u);
  return (u16)(u >> 16);
}
__device__ __forceinline__ float bf2f(u16 v) { return __uint_as_float(((u32)v) << 16); }
__device__ __forceinline__ u32 pack2(float a, float b) { u32 r; asm("v_cvt_pk_bf16_f32 %0, %1, %2" : "=v"(r) : "v"(a), "v"(b)); return r; }
__device__ __forceinline__ float wave_sum(float v) {
#pragma unroll
  for (int o = 32; o >= 1; o >>= 1) v += __shfl_xor(v, o);
  return v;
}
__device__ __forceinline__ float sigmoidf_(float x) { return 1.f / (1.f + __expf(-x)); }
__device__ __forceinline__ float siluf_(float x) { return x / (1.f + __expf(-x)); }

template <int ROWS>
__device__ __forceinline__ void g2r(u32x4 (&r)[ROWS / 32], const u16* g, size_t ld, int tid) {
  const int c = tid & 7, row = tid >> 3;
#pragma unroll
  for (int i = 0; i < ROWS / 32; ++i) r[i] = *(const u32x4*)(g + (size_t)(row + 32 * i) * ld + c * 8);
}
template <int ROWS>
__device__ __forceinline__ void r2s(const u32x4 (&r)[ROWS / 32], char* s, int tid) {
  const int c = tid & 7, row = tid >> 3;
#pragma unroll
  for (int i = 0; i < ROWS / 32; ++i) {
    const int rr = row + 32 * i;
    *(u32x4*)(s + rr * 128 + ((c ^ ((rr >> 1) & 7)) << 4)) = r[i];
  }
}
__device__ __forceinline__ bf16x8 lds_frag(const char* s, int row, int kc) {
  return *(const bf16x8*)(s + row * 128 + ((kc ^ ((row >> 1) & 7)) << 4));
}
__device__ __forceinline__ int rowof(int reg, int lane) { return (reg & 3) + 8 * (reg >> 2) + 4 * (lane >> 5); }

template <int MI, int NI>
__device__ __forceinline__ void mma_tile(f32x16 (&acc)[MI][NI], const char* xs, int xrow0, const char* ys, int yrow0,
                                         int lane) {
  const int r = lane & 31, h = lane >> 5;
  bf16x8 a[2][MI], b[2][NI];
#pragma unroll
  for (int mi = 0; mi < MI; ++mi) a[0][mi] = lds_frag(xs, xrow0 + mi * 32 + r, h);
#pragma unroll
  for (int ni = 0; ni < NI; ++ni) b[0][ni] = lds_frag(ys, yrow0 + ni * 32 + r, h);
#pragma unroll
  for (int ks = 0; ks < 4; ++ks) {
    const int c = ks & 1, n = c ^ 1;
    if (ks < 3) {
#pragma unroll
      for (int mi = 0; mi < MI; ++mi) a[n][mi] = lds_frag(xs, xrow0 + mi * 32 + r, (ks + 1) * 2 + h);
#pragma unroll
      for (int ni = 0; ni < NI; ++ni) b[n][ni] = lds_frag(ys, yrow0 + ni * 32 + r, (ks + 1) * 2 + h);
    }
    __builtin_amdgcn_sched_barrier(0);
#pragma unroll
    for (int mi = 0; mi < MI; ++mi)
#pragma unroll
      for (int ni = 0; ni < NI; ++ni)
        acc[mi][ni] = __builtin_amdgcn_mfma_f32_32x32x16_bf16(a[c][mi], b[c][ni], acc[mi][ni], 0, 0, 0);
    __builtin_amdgcn_sched_barrier(0);
  }
}

template <int YR, int NI>
__device__ __forceinline__ void gemm_loop_shallow(f32x16 (&acc)[2][NI], const u16* X, size_t ldx, const u16* Y, size_t ldy,
                                          int KT, char* smem, int tid) {
  const int lane = tid & 63, w = tid >> 6, wm = w & 1, wn = w >> 1;
  char* xs = smem;
  char* ys = smem + 32768;
  u32x4 xr[4], yr[YR / 32];
  g2r<128>(xr, X, ldx, tid);
  g2r<YR>(yr, Y, ldy, tid);
  r2s<128>(xr, xs, tid);
  r2s<YR>(yr, ys, tid);
  __syncthreads();
#pragma unroll 1
  for (int kt = 0; kt < KT; ++kt) {
    const int cur = kt & 1;
    if (kt + 1 < KT) {
      g2r<128>(xr, X + (size_t)(kt + 1) * 64, ldx, tid);
      g2r<YR>(yr, Y + (size_t)(kt + 1) * 64, ldy, tid);
    }
    mma_tile<2, NI>(acc, xs + cur * 16384, wm * 64, ys + cur * (YR * 128), wn * 32 * NI, lane);
    if (kt + 1 < KT) {
      r2s<128>(xr, xs + (cur ^ 1) * 16384, tid);
      r2s<YR>(yr, ys + (cur ^ 1) * (YR * 128), tid);
    }
    __syncthreads();
  }
}
template <int YR, int NI>
__device__ __forceinline__ void gemm_loop_deep(f32x16 (&acc)[2][NI], const u16* X, size_t ldx, const u16* Y, size_t ldy,
                                          int KT, char* smem, int tid) {
  const int lane = tid & 63, w = tid >> 6, wm = w & 1, wn = w >> 1;
  char* xs = smem;
  char* ys = smem + 32768;
  u32x4 xa[4], ya[YR / 32], xb[4], yb[YR / 32];
  g2r<128>(xa, X, ldx, tid);
  g2r<YR>(ya, Y, ldy, tid);
  g2r<128>(xb, X + 64, ldx, tid);
  g2r<YR>(yb, Y + 64, ldy, tid);
  r2s<128>(xa, xs, tid);
  r2s<YR>(ya, ys, tid);
  __syncthreads();
#pragma unroll 1
  for (int kt = 0; kt < KT; kt += 2) {
    if (kt + 2 < KT) {
      g2r<128>(xa, X + (size_t)(kt + 2) * 64, ldx, tid);
      g2r<YR>(ya, Y + (size_t)(kt + 2) * 64, ldy, tid);
    }
    mma_tile<2, NI>(acc, xs, wm * 64, ys, wn * 32 * NI, lane);
    r2s<128>(xb, xs + 16384, tid);
    r2s<YR>(yb, ys + YR * 128, tid);
    __syncthreads();
    if (kt + 3 < KT) {
      g2r<128>(xb, X + (size_t)(kt + 3) * 64, ldx, tid);
      g2r<YR>(yb, Y + (size_t)(kt + 3) * 64, ldy, tid);
    }
    mma_tile<2, NI>(acc, xs + 16384, wm * 64, ys + YR * 128, wn * 32 * NI, lane);
    if (kt + 2 < KT) {
      r2s<128>(xa, xs, tid);
      r2s<YR>(ya, ys, tid);
    }
    __syncthreads();
  }
}
template <int YR, int NI>
__device__ __forceinline__ void gemm_loop(f32x16 (&acc)[2][NI], const u16* X, size_t ldx, const u16* Y, size_t ldy,
                                          int KT, char* smem, int tid) {
  if constexpr (YR == 128) gemm_loop_deep<YR, NI>(acc, X, ldx, Y, ldy, KT, smem, tid);
  else gemm_loop_shallow<YR, NI>(acc, X, ldx, Y, ldy, KT, smem, tid);
}
template <int NI>
__device__ __forceinline__ void zero_acc(f32x16 (&acc)[2][NI]) {
#pragma unroll
  for (int mi = 0; mi < 2; ++mi)
#pragma unroll
    for (int ni = 0; ni < NI; ++ni)
#pragma unroll
      for (int r = 0; r < 16; ++r) acc[mi][ni][r] = 0.f;
}

__device__ __forceinline__ int conv_map(int mode, int n) {
  if (mode == 0) return n < 1860 ? n : (n < 1920 ? -1 : n - 60);
  if (mode == 1) {
    const int tile = n >> 7, r = n & 127, sub = r >> 5;
    return 3908 + (sub & 1) * 1024 + tile * 64 + (sub >> 1) * 32 + (r & 31);
  }
  if (mode == 3) {
    const int tile = n >> 7, r = n & 127, sub = r >> 5;
    const int j = tile * 64 + (sub >> 1) * 32 + (r & 31);
    return (sub & 1) ? DFF + j : j;
  }
  return n;
}
__device__ __forceinline__ void conv_tile(const float* src, int ld, int K, int mode, const float* scale, u16* dst, int tile, float* lds,
                          int tid) {
  const int ktiles = K >> 6;
  const int ntile = tile / ktiles, ktile = tile - ntile * ktiles;
  const int n0 = ntile * 64, k0 = ktile * 64;
  const int n4 = (tid & 15) * 4, kq = tid >> 4;
  const int col = conv_map(mode, n0 + n4);
  float4 vv[4];
#pragma unroll
  for (int i = 0; i < 4; ++i) {
    const int k = kq + 16 * i;
    vv[i] = float4{0.f, 0.f, 0.f, 0.f};
    if (col >= 0) {
      typedef __attribute__((ext_vector_type(4))) float f4v;
      const f4v t = __builtin_nontemporal_load((const f4v*)(src + (size_t)(k0 + k) * ld + col));
      vv[i] = float4{t.x, t.y, t.z, t.w};
    }
    if (scale) { const float sc = scale[k0 + k]; vv[i].x *= sc; vv[i].y *= sc; vv[i].z *= sc; vv[i].w *= sc; }
  }
#pragma unroll
  for (int i = 0; i < 4; ++i) {
    float* d = lds + (kq + 16 * i) * 65 + n4;
    d[0] = vv[i].x; d[1] = vv[i].y; d[2] = vv[i].z; d[3] = vv[i].w;
  }
  __syncthreads();
  const int nr = tid >> 2, part = tid & 3;
  u32 o[8];
#pragma unroll
  for (int i = 0; i < 8; ++i)
    o[i] = pack2(lds[(part * 16 + 2 * i) * 65 + nr], lds[(part * 16 + 2 * i + 1) * 65 + nr]);
  u32x4* d = (u32x4*)(dst + (size_t)(n0 + nr) * K + k0 + part * 16);
  d[0] = u32x4{o[0], o[1], o[2], o[3]};
  d[1] = u32x4{o[4], o[5], o[6], o[7]};
}
__device__ __forceinline__ void conv_item(const P& p, int l, int c, char* smem, int tid) {
  const float* src; int ld, K, mode; const float* scale = nullptr; u16* dst;
  if (c < 992) { src = p.w_in + (size_t)l * 1024 * 5956; ld = 5956; K = 1024; mode = 0; scale = p.nmix + l * 1024; dst = (u16*)(p.ws + OFF_WIN); }
  else if (c < 1504) { c -= 992; src = p.w_in + (size_t)l * 1024 * 5956; ld = 5956; K = 1024; mode = 1; scale = p.nmix + l * 1024; dst = (u16*)(p.ws + OFF_WGATE); }
  else if (c < 1632) { c -= 1504; src = p.w_pa + (size_t)l * 512 * 1024; ld = 1024; K = 512; mode = 2; dst = (u16*)(p.ws + OFF_WPA); }
  else if (c < 1760) { c -= 1632; src = p.w_ph + (size_t)l * 512 * 1024; ld = 1024; K = 512; mode = 2; dst = (u16*)(p.ws + OFF_WPH); }
  else if (c < 2016) { c -= 1760; src = p.w_out + (size_t)l * 1024 * 1024; ld = 1024; K = 1024; mode = 2; dst = (u16*)(p.ws + OFF_WOUT); }
  else if (c < 3424) { c -= 2016; src = p.w_ffi + (size_t)l * 1024 * 5632; ld = 5632; K = 1024; mode = 3; scale = p.nffn + l * 1024; dst = (u16*)(p.ws + OFF_WFFI); }
  else { c -= 3424; src = p.w_ffo + (size_t)l * DFF * 1024; ld = 1024; K = DFF; mode = 2; dst = (u16*)(p.ws + OFF_WFFO); }
  conv_tile(src, ld, K, mode, scale, dst, c, (float*)smem, tid);
}

__device__ __forceinline__ void p0_rows(const P& p, int item, int tid) {
  const int lane = tid & 63, w = tid >> 6;
  const int tok = item * 4 + w;
  const float4* xr = (const float4*)(p.x + (size_t)tok * 1024);
  float4* orow = (float4*)(p.out + (size_t)tok * 1024);
  u32x2* xb = (u32x2*)(p.ws + OFF_XB + (size_t)tok * 2048);
  float ss = 0.f;
#pragma unroll
  for (int i = 0; i < 4; ++i) {
    float4 v = xr[lane + 64 * i];
    ss += v.x * v.x + v.y * v.y + v.z * v.z + v.w * v.w;
    orow[lane + 64 * i] = v;
    xb[lane + 64 * i] = u32x2{pack2(v.x, v.y), pack2(v.z, v.w)};
  }
  ss = wave_sum(ss);
  float* rowss = (float*)(p.ws + OFF_ROWSS);
  if (lane < 16) rowss[(size_t)tok * 16 + lane] = lane == 0 ? ss : 0.f;
}


__device__ __forceinline__ float row_rstd(const float* part, int tok) {
  const float4* q = (const float4*)(part + (size_t)tok * 16);
  const float4 a = q[0], b = q[1], c = q[2], d = q[3];
  const float ss = ((a.x + a.y) + (a.z + a.w)) + ((b.x + b.y) + (b.z + b.w)) + ((c.x + c.y) + (c.z + c.w)) + ((d.x + d.y) + (d.z + d.w));
  return rsqrtf(ss * (1.f / 1024.f) + EPS);
}
__device__ __forceinline__ void rope_cs(int pos, int d1, float& c, float& s) {
  const float inv = exp2f(-(float)d1 * (13.287712379549449f / 32.f));
  const float ang = (float)pos * inv;
  double rv = (double)ang * 0.15915494309189535;
  rv -= floor(rv);
  const float r = (float)rv;
  c = __builtin_amdgcn_cosf(r);
  s = __builtin_amdgcn_sinf(r);
}

__device__ __forceinline__ void phaseA_tile(const P& p, int l, int mt, int nt, char* smem, int tid) {
  const int lane = tid & 63, w = tid >> 6, wm = w & 1, wn = w >> 1, h = lane >> 5, lr = lane & 31;
  const int m0 = mt * 128;
  float* rs = (float*)(smem + 65536);
  const float* rowss = (const float*)(p.ws + OFF_ROWSS);
  if (tid < 128) rs[tid] = row_rstd(rowss, m0 + tid);
  const u16* XB = (const u16*)(p.ws + OFF_XB) + (size_t)m0 * 1024;
  const u16* W = (const u16*)(p.ws + OFF_WIN) + (size_t)nt * 128 * 1024;
  const bool fr = (nt < 15) || (nt >= 23 && nt < 27);
  f32x16 acc[2][2];
  zero_acc<2>(acc);
  if (fr) gemm_loop<128, 2>(acc, W, 1024, XB, 1024, 16, smem, tid);
  else gemm_loop<128, 2>(acc, XB, 1024, W, 1024, 16, smem, tid);

  if (fr) {
    if (nt < 8 || (nt >= 12 && nt < 15)) {
      const bool isidx = nt >= 12;
      const int fbase = isidx ? (nt - 12) * 128 + wm * 64 : nt * 128 + wm * 64;
      if (isidx && nt == 14 && wm == 1) {
#pragma unroll
        for (int ni = 0; ni < 2; ++ni) {
          const int tl = wn * 64 + ni * 32 + lr;
          const float rstd = rs[tl] * 0.5f;
          if (h == 0) {
            float4 o = {acc[0][ni][0] * rstd, acc[0][ni][1] * rstd, acc[0][ni][2] * rstd, acc[0][ni][3] * rstd};
            *(float4*)(p.ws + OFF_IW + (size_t)(m0 + tl) * 16) = o;
          }
        }
        return;
      }
      const bool isk = (!isidx) && fbase >= 512;
      const int head = isidx ? (nt == 14 ? 0 : (fbase >> 6)) : ((fbase & 511) >> 6);
      const float* nw = isidx ? nullptr : (isk ? p.kn + l * 64 : p.qn + l * 64);
      u16* dst; int dld;
      float oscale = 1.f;
      if (!isidx) { dst = (u16*)(p.ws + (isk ? OFF_AK : OFF_AQ)); dld = 512; if (!isk) oscale = 0.125f * 1.4426950408889634f; }
      else if (nt < 14) { dst = (u16*)(p.ws + OFF_IQ); dld = 256; oscale = 0.125f; }
      else { dst = (u16*)(p.ws + OFF_IK); dld = 64; }
#pragma unroll
      for (int ni = 0; ni < 2; ++ni) {
        const int tl = wn * 64 + ni * 32 + lr;
        const int tok = m0 + tl;
        const float rstd = rs[tl];
        const int pos = p.pos[tok];
        float rn = rstd;
        if (!isidx) {
          float ss = 0.f;
#pragma unroll
          for (int mi = 0; mi < 2; ++mi)
#pragma unroll
            for (int r = 0; r < 16; ++r) { const float v = acc[mi][ni][r] * rstd; ss += v * v; }
          ss += __shfl_xor(ss, 32);
          rn = rstd * rsqrtf(ss * (1.f / 64.f) + EPS);
        }
        u16* drow = dst + (size_t)tok * dld + head * 64;
#pragma unroll
        for (int rg = 0; rg < 4; ++rg) {
          float o1[4], o2[4];
#pragma unroll
          for (int j = 0; j < 4; ++j) {
            const int r = rg * 4 + j;
            const int d1 = j + 8 * rg + 4 * h;
            float x1 = acc[0][ni][r] * rn, x2 = acc[1][ni][r] * rn;
            if (!isidx) { x1 *= nw[d1]; x2 *= nw[d1 + 32]; }
            float c, s;
            rope_cs(pos, d1, c, s);
            o1[j] = (x1 * c - x2 * s) * oscale;
            o2[j] = (x2 * c + x1 * s) * oscale;
          }
          const int d1b = 8 * rg + 4 * h;
          *(u32x2*)(drow + d1b) = u32x2{pack2(o1[0], o1[1]), pack2(o1[2], o1[3])};
          *(u32x2*)(drow + d1b + 32) = u32x2{pack2(o2[0], o2[1]), pack2(o2[2], o2[3])};
          __builtin_amdgcn_sched_barrier(0);
        }
      }
    } else {
      const bool isav = nt < 12;
      u16* dst = (u16*)(p.ws + (isav ? OFF_AVT : OFF_HVT));
#pragma unroll
      for (int ni = 0; ni < 2; ++ni) {
        const int tl = wn * 64 + ni * 32 + lr;
        const int tok = m0 + tl;
        const float rstd = rs[tl];
        const int b = tok >> 13, t = tok & 8191;
#pragma unroll
        for (int mi = 0; mi < 2; ++mi)
#pragma unroll
          for (int r = 0; r < 16; ++r) {
            const int f = (isav ? (nt - 8) : (nt - 23)) * 128 + wm * 64 + mi * 32 + rowof(r, lane);
            dst[((size_t)(b * 512 + f)) * 8192 + t] = f2bf(acc[mi][ni][r] * rstd);
            if ((r & 3) == 3) __builtin_amdgcn_sched_barrier(0);
          }
      }
    }
  } else {
    const int seg = (nt - 15) >> 2;
    const int fb = ((nt - 15) & 3) * 128 + wn * 64;
#pragma unroll
    for (int ni = 0; ni < 2; ++ni) {
      const int f = fb + ni * 32 + lr;
      float lb = 0.f;
      if (seg == 1) {
        float e[4], mx = -1e30f;
#pragma unroll
        for (int i = 0; i < 4; ++i) { e[i] = p.hlb[i * 512 + f]; mx = fmaxf(mx, e[i]); }
        float tot = 0.f, part = 0.f;
#pragma unroll
        for (int i = 0; i < 4; ++i) { e[i] = __expf(e[i] - mx); tot += e[i]; if (i >= 1 && i <= l) part += e[i]; }
        lb = part / tot;
      }
#pragma unroll
      for (int mi = 0; mi < 2; ++mi)
#pragma unroll
        for (int r = 0; r < 16; ++r) {
          const int tl = wm * 64 + mi * 32 + rowof(r, lane);
          const float v = acc[mi][ni][r] * rs[tl];
          const size_t o = (size_t)(m0 + tl) * 512 + f;
          if (seg == 0) ((u16*)(p.ws + OFF_HQ))[o] = f2bf(siluf_(v));
          else if (seg == 3) ((u16*)(p.ws + OFF_HG))[o] = f2bf(siluf_(v));
          else {
            const float sg = 1.f / (1.f + __expf(-v));
            ((float*)(p.ws + OFF_LOGF))[o] = logf(lb + (1.f - lb) * sg);
          }
          if ((r & 3) == 3) __builtin_amdgcn_sched_barrier(0);
        }
    }
  }
}

__device__ __forceinline__ void hgrn_load_cumsum(const P& p, int tok0, int hh, int d, int hf, float (&lf)[32],
                                                 float (&cs)[32]) {
  const float* src = (const float*)(p.ws + OFF_LOGF) + (size_t)(tok0 + hf * 32) * 512 + hh * 128 + d;
#pragma unroll
  for (int i = 0; i < 32; ++i) lf[i] = src[(size_t)i * 512];
  float run = 0.f;
#pragma unroll
  for (int i = 0; i < 32; ++i) { run += lf[i]; cs[i] = run; }
}
__device__ __forceinline__ void put_td(char* base, int t, int d, float v) {
  const int kt = d >> 6, dd = d & 63;
  *(u16*)(base + kt * 8192 + t * 128 + (((dd >> 3) ^ ((t >> 1) & 7)) << 4) + (dd & 7) * 2) = f2bf(v);
}

__device__ __forceinline__ void h1_item(const P& p, int item, char* smem, int tid) {
  const int lane = tid & 63, w = tid >> 6, wm = w & 1, wn = w >> 1;
  const int b = item >> 9, hh = (item >> 7) & 3, c = item & 127;
  const int tok0 = b * SEQ + c * 64;
  const int d = tid & 127, hf = tid >> 7;
  char* vts = smem;
  char* kts = smem + 16384;
  float* tot = (float*)(smem + 65536);
  u32x4 vr[4];
  g2r<128>(vr, (const u16*)(p.ws + OFF_HVT) + ((size_t)(b * 512 + hh * 128)) * 8192 + c * 64, 8192, tid);
  float lf[32], cs[32];
  hgrn_load_cumsum(p, tok0, hh, d, hf, lf, cs);
  tot[hf * 128 + d] = cs[31];
  r2s<128>(vr, vts, tid);
  __syncthreads();
  const float after = hf ? 0.f : tot[128 + d];
  if (hf) ((float*)(p.ws + OFF_GDEC))[(size_t)item * 128 + d] = __expf(cs[31] + tot[d]);
#pragma unroll
  for (int ch = 0; ch < 4; ++ch) {
    u32 o[4];
#pragma unroll
    for (int j = 0; j < 4; ++j) {
      const int i0 = ch * 8 + 2 * j;
      const float k0 = (1.f - __expf(lf[i0])) * __expf(cs[31] - cs[i0] + after);
      const float k1 = (1.f - __expf(lf[i0 + 1])) * __expf(cs[31] - cs[i0 + 1] + after);
      o[j] = pack2(k0, k1);
    }
    const int chunk = hf * 4 + ch;
    *(u32x4*)(kts + d * 128 + ((chunk ^ ((d >> 1) & 7)) << 4)) = u32x4{o[0], o[1], o[2], o[3]};
  }
  __syncthreads();
  f32x16 acc[2][2];
  zero_acc<2>(acc);
  mma_tile<2, 2>(acc, vts, wm * 64, kts, wn * 64, lane);
  u16* us = (u16*)(p.ws + OFF_US) + (size_t)item * 16384;
#pragma unroll
  for (int mi = 0; mi < 2; ++mi)
#pragma unroll
    for (int ni = 0; ni < 2; ++ni)
#pragma unroll
      for (int r = 0; r < 16; ++r) {
        const int e = wm * 64 + mi * 32 + rowof(r, lane);
        const int dd = wn * 64 + ni * 32 + (lane & 31);
        us[e * 128 + dd] = f2bf(acc[mi][ni][r]);
      }
}

__device__ __forceinline__ void h2_item(const P& p, int item, int tid) {
  const int g = item * 256 + tid;
  const int bh = g >> 13, e = (g >> 6) & 127, dp = g & 63;
  float s0 = 0.f, s1 = 0.f;
  u32* us = (u32*)(p.ws + OFF_US) + (size_t)bh * 128 * 8192 + e * 64 + dp;
  const float2* gd = (const float2*)(p.ws + OFF_GDEC) + (size_t)bh * 128 * 64 + dp;
#pragma unroll 1
  for (int c0 = 0; c0 < 128; c0 += 16) {
    u32 u[16];
    float2 g2[16];
#pragma unroll
    for (int i = 0; i < 16; ++i) { u[i] = us[(size_t)(c0 + i) * 8192]; g2[i] = gd[(c0 + i) * 64]; }
#pragma unroll
    for (int i = 0; i < 16; ++i) {
      us[(size_t)(c0 + i) * 8192] = pack2(s0, s1);
      s0 = g2[i].x * s0 + bf2f((u16)(u[i] & 0xFFFF));
      s1 = g2[i].y * s1 + bf2f((u16)(u[i] >> 16));
    }
  }
}

__device__ __forceinline__ void h3_item(const P& p, int l, int item, char* smem, int tid) {
  const int lane = tid & 63, w = tid >> 6, h = lane >> 5, lr = lane & 31;
  const int b = item >> 9, hh = (item >> 7) & 3, c = item & 127;
  const int tok0 = b * SEQ + c * 64;
  const int d = tid & 127, hf = tid >> 7;
  char* R0 = smem;
  char* R1 = smem + 16384;
  char* R2 = smem + 32768;
  char* R3 = smem + 49152;
  float* tot = (float*)(smem + 65536);
  const u16* usb = (const u16*)(p.ws + OFF_US) + (size_t)item * 16384;
  u32x4 vr[4], s0r[4], s1r[4];
  g2r<128>(vr, (const u16*)(p.ws + OFF_HVT) + ((size_t)(b * 512 + hh * 128)) * 8192 + c * 64, 8192, tid);
  g2r<128>(s0r, usb, 128, tid);
  g2r<128>(s1r, usb + 64, 128, tid);
  float lf[32], cs[32], q[32];
  hgrn_load_cumsum(p, tok0, hh, d, hf, lf, cs);
  {
    const u16* qs = (const u16*)(p.ws + OFF_HQ) + (size_t)(tok0 + hf * 32) * 512 + hh * 128 + d;
#pragma unroll
    for (int i = 0; i < 32; ++i) q[i] = bf2f(qs[(size_t)i * 512]);
  }
  if (hf == 0) tot[d] = cs[31];
  r2s<128>(vr, R3, tid);
  r2s<128>(s0r, R2, tid);
  __syncthreads();
  const float t0 = tot[d];
#pragma unroll
  for (int i = 0; i < 32; ++i) {
    const int t = hf * 32 + i;
    const float rel = hf ? cs[i] : cs[i] - t0;
    put_td(R0, t, d, q[i] * __expf(rel));
    put_td(R1, t, d, (1.f - __expf(lf[i])) * __expf(-rel));
  }
  __syncthreads();
  {
    const int sb = w & 1, tb = w >> 1;
    f32x16 a1[1][1];
#pragma unroll
    for (int r = 0; r < 16; ++r) a1[0][0][r] = 0.f;
    if (sb <= tb) {
      mma_tile<1, 1>(a1, R1, sb * 32, R0, tb * 32, lane);
      mma_tile<1, 1>(a1, R1 + 8192, sb * 32, R0 + 8192, tb * 32, lane);
    }
    __syncthreads();
    const int t = tb * 32 + lr;
#pragma unroll
    for (int rg = 0; rg < 4; ++rg) {
      float v[4];
#pragma unroll
      for (int j = 0; j < 4; ++j) {
        const int s = sb * 32 + 8 * rg + 4 * h + j;
        v[j] = (s <= t) ? a1[0][0][rg * 4 + j] : 0.f;
      }
      const int s0 = sb * 32 + 8 * rg + 4 * h;
      *(u32x2*)(R1 + t * 128 + (((s0 >> 3) ^ ((t >> 1) & 7)) << 4) + (s0 & 7) * 2) =
          u32x2{pack2(v[0], v[1]), pack2(v[2], v[3])};
    }
#pragma unroll
    for (int i = 0; i < 32; ++i) {
      const int tt = hf * 32 + i;
      put_td(R0, tt, d, q[i] * __expf(hf ? cs[i] + t0 : cs[i]));
    }
  }
  __syncthreads();
  f32x16 o[1][2];
#pragma unroll
  for (int ni = 0; ni < 2; ++ni)
#pragma unroll
    for (int r = 0; r < 16; ++r) o[0][ni][r] = 0.f;
  mma_tile<1, 2>(o, R2, w * 32, R0, 0, lane);
  mma_tile<1, 2>(o, R3, w * 32, R1, 0, lane);
  __syncthreads();
  r2s<128>(s1r, R2, tid);
  __syncthreads();
  mma_tile<1, 2>(o, R2, w * 32, R0 + 8192, 0, lane);
  float* red = tot;
#pragma unroll
  for (int ni = 0; ni < 2; ++ni) {
    float ss = 0.f;
#pragma unroll
    for (int r = 0; r < 16; ++r) ss += o[0][ni][r] * o[0][ni][r];
    ss += __shfl_xor(ss, 32);
    if (h == 0) red[w * 64 + ni * 32 + lr] = ss;
  }
  __syncthreads();
#pragma unroll
  for (int ni = 0; ni < 2; ++ni) {
    const int t = ni * 32 + lr;
    const float ss = red[t] + red[64 + t] + red[128 + t] + red[192 + t];
    const float rn = rsqrtf(ss * (1.f / 128.f) + EPS);
    const size_t rowo = (size_t)(tok0 + t) * 512 + hh * 128;
#pragma unroll
    for (int rg = 0; rg < 4; ++rg) {
      const int e0 = w * 32 + 8 * rg + 4 * h;
      const u32x2 gg = *(const u32x2*)((const u16*)(p.ws + OFF_HG) + rowo + e0);
      const float4 nw = *(const float4*)(p.hn + l * 128 + e0);
      const float y0 = o[0][ni][rg * 4 + 0] * rn * nw.x * bf2f((u16)(gg.x & 0xFFFF));
      const float y1 = o[0][ni][rg * 4 + 1] * rn * nw.y * bf2f((u16)(gg.x >> 16));
      const float y2 = o[0][ni][rg * 4 + 2] * rn * nw.z * bf2f((u16)(gg.y & 0xFFFF));
      const float y3 = o[0][ni][rg * 4 + 3] * rn * nw.w * bf2f((u16)(gg.y >> 16));
      *(u32x2*)((u16*)(p.ws + OFF_YH) + rowo + e0) = u32x2{pack2(y0, y1), pack2(y2, y3)};
    }
  }
}

__device__ __forceinline__ size_t code_rowoff(int q) {
  const int g = q >> 7, r = q & 127;
  return (size_t)128 * ((size_t)64 * g * (g + 1) + (size_t)r * (g + 1));
}
__device__ __forceinline__ u32 tocode(float s) {
  u32 u = __float_as_uint(s);
  if ((u << 1) == 0) u = 0;
  u = (u & 0x80000000u) ? ~u : (u | 0x80000000u);
  u >>= 16;
  return u < 1 ? 1 : u;
}
__device__ __forceinline__ void b1_item(const P& p, int item, char* smem, int tid) {
  const int lane = tid & 63, w = tid >> 6, wm = w & 1, wn = w >> 1, lr = lane & 31;
  const int b = item >= 2080;
  int idx = item - b * 2080;
  int g = (int)((sqrtf(8.f * idx + 1.f) - 1.f) * 0.5f);
  while (g * (g + 1) / 2 > idx) --g;
  while ((g + 1) * (g + 2) / 2 <= idx) ++g;
  const int kt = idx - g * (g + 1) / 2;
  const int q0 = b * SEQ + g * 128, k0 = b * SEQ + kt * 128;
  char* ys = smem;
  char* xs = smem + 16384;
  float* wsm = (float*)(smem + 49152);
  const u16* IQ = (const u16*)(p.ws + OFF_IQ) + (size_t)q0 * 256;
  const u16* IK = (const u16*)(p.ws + OFF_IK) + (size_t)k0 * 64;
  u32x4 xr[4], yr[4];
  g2r<128>(yr, IK, 64, tid);
  g2r<128>(xr, IQ, 256, tid);
  if (tid < 128) *(float4*)(wsm + tid * 4) = *(const float4*)(p.ws + OFF_IW + (size_t)(q0 + tid) * 16);
  r2s<128>(yr, ys, tid);
  r2s<128>(xr, xs, tid);
  __syncthreads();
  f32x16 sc[2][2];
  zero_acc<2>(sc);
#pragma unroll 1
  for (int hd = 0; hd < 4; ++hd) {
    if (hd < 3) g2r<128>(xr, IQ + (hd + 1) * 64, 256, tid);
#pragma unroll
    for (int mi = 0; mi < 2; ++mi) {
      f32x16 acc[1][2];
#pragma unroll
      for (int ni = 0; ni < 2; ++ni)
#pragma unroll
        for (int r = 0; r < 16; ++r) acc[0][ni][r] = 0.f;
      mma_tile<1, 2>(acc, xs + (hd & 1) * 16384, wm * 64 + mi * 32, ys, wn * 64, lane);
#pragma unroll
      for (int r = 0; r < 16; ++r) {
        const float wv = wsm[(wm * 64 + mi * 32 + rowof(r, lane)) * 4 + hd];
#pragma unroll
        for (int ni = 0; ni < 2; ++ni) sc[mi][ni][r] += wv * fmaxf(acc[0][ni][r], 0.f);
      }
      __builtin_amdgcn_sched_barrier(0);
    }
    if (hd < 3) r2s<128>(xr, xs + ((hd + 1) & 1) * 16384, tid);
    __syncthreads();
  }
  u16* codes = (u16*)(p.ws + OFF_CODES) + (size_t)b * CODES_PER_BATCH;
  char* st = smem + 16384;
#pragma unroll
  for (int mi = 0; mi < 2; ++mi)
#pragma unroll
    for (int r = 0; r < 16; ++r) {
      const int ql = wm * 64 + mi * 32 + rowof(r, lane);
      const int q = g * 128 + ql;
#pragma unroll
      for (int ni = 0; ni < 2; ++ni) {
        const int kl = wn * 64 + ni * 32 + lr;
        const bool vis = (kt * 128 + kl) <= q;
        const u32 cd = vis ? tocode(sc[mi][ni][r]) : 0u;
        *(u16*)(st + ql * 256 + (2 * (ni * 32 + lr) + wn) * 2) = (u16)cd;
      }
    }
  __syncthreads();
  {
    u16* dst0 = codes + code_rowoff(g * 128) + kt * 128;
    const size_t rstride = (size_t)128 * (g + 1);
#pragma unroll
    for (int i = 0; i < 8; ++i) {
      const int cid = tid + 256 * i;
      const int row = cid >> 4, c = cid & 15;
      __builtin_nontemporal_store(*(const u32x4*)(st + row * 256 + c * 16), (u32x4*)(dst0 + (size_t)row * rstride + c * 8));
    }
  }
}

__device__ __forceinline__ int wave_isum(int c) {
#pragma unroll
  for (int o = 32; o >= 1; o >>= 1) c += __shfl_xor(c, o);
  return c;
}
__device__ __forceinline__ int count_ge(const u32 (&r)[64], int nj, u32 t) {
  const u16 tm1 = (u16)(t - 1);
  const u16x2 tv = {tm1, tm1};
  const u16x2 one = {1, 1};
  u16x2 acc = {0, 0};
#pragma unroll
  for (int jb = 0; jb < 8; ++jb) {
    if (jb * 8 < nj) {
#pragma unroll
      for (int jj = 0; jj < 8; ++jj) {
        u16x2 d = __builtin_elementwise_sub_sat(__builtin_bit_cast(u16x2, r[jb * 8 + jj]), tv);
        d = __builtin_elementwise_min(d, one);
        acc += d;
      }
    }
  }
  return wave_isum((int)acc.x + (int)acc.y);
}
__device__ __forceinline__ int snake_item(int k, int bid, int nb);
__device__ __forceinline__ void b2_load(const P& p, int item, int tid, u32 (&r)[64]) {
  const int lane = tid & 63, w = tid >> 6;
  const int Q = item * 4 + w;
  const int b = Q >> 13, q = Q & 8191;
  const int nj = (q >> 7) + 1;
  const u32* row = (const u32*)((const u16*)(p.ws + OFF_CODES) + (size_t)b * CODES_PER_BATCH + code_rowoff(q));
#pragma unroll
  for (int j = 0; j < 64; ++j) r[j] = (j < nj) ? __builtin_nontemporal_load(row + j * 64 + lane) : 0u;
}
__device__ __forceinline__ void b2_process(const P& p, int item, char* smem, int tid, const u32 (&r)[64]) {
  const int lane = tid & 63, w = tid >> 6;
  const int Q = item * 4 + w;
  const int q = Q & 8191;
  const int nj = (q >> 7) + 1;
  u16x2 m1 = {0, 0}, m2 = {0, 0};
#pragma unroll
  for (int jb = 0; jb < 8; ++jb) {
    if (jb * 8 < nj) {
#pragma unroll
      for (int jj = 0; jj < 8; ++jj) {
        const u16x2 x = __builtin_bit_cast(u16x2, r[jb * 8 + jj]);
        const u16x2 t = __builtin_elementwise_min(m1, x);
        m1 = __builtin_elementwise_max(m1, x);
        m2 = __builtin_elementwise_max(m2, t);
      }
    }
  }
  int L = min((int)m2.x, (int)m2.y), H = max((int)m1.x, (int)m1.y);
#pragma unroll
  for (int o = 32; o >= 1; o >>= 1) { L = min(L, __shfl_xor(L, o)); H = max(H, __shfl_xor(H, o)); }
  u32 T = 0;
  int need = 0;
  u32 lo = L < 1 ? 1u : (u32)L;
  if (lo > 1 || count_ge(r, nj, 1) >= 256) {
    const int R = H - (int)lo + 1;
    if (R <= 2048) {
      u32* hist = (u32*)(smem + w * 8192);
      const int nbl = (R + 63) >> 6;
      for (int i = 0; i < nbl; ++i) hist[i * 64 + lane] = 0u;
#pragma unroll
      for (int jb = 0; jb < 8; ++jb) {
        if (jb * 8 < nj) {
#pragma unroll
          for (int jj = 0; jj < 8; ++jj) {
            const u32 v = r[jb * 8 + jj];
            const u32 c0 = v & 0xFFFFu, c1 = v >> 16;
            if (c0 >= lo) atomicAdd(&hist[c0 - lo], 1u);
            if (c1 >= lo) atomicAdd(&hist[c1 - lo], 1u);
          }
        }
      }
      int sl = 0;
      for (int i = 0; i < nbl; ++i) sl += (int)hist[lane * nbl + i];
      int suf = sl;
#pragma unroll
      for (int d = 1; d <= 32; d <<= 1) {
        const int v = __shfl_down(suf, d);
        suf += (lane + d < 64) ? v : 0;
      }
      const u64 okm = __ballot(suf >= 256);
      const int istar = 63 - __builtin_clzll(okm);
      int cacc = suf - sl, tbin = 0, cgt = 0;
      bool found = false;
      for (int i = nbl - 1; i >= 0; --i) {
        const int hc = (int)hist[lane * nbl + i];
        if (!found && cacc + hc >= 256) { found = true; tbin = lane * nbl + i; cgt = cacc; }
        cacc += hc;
      }
      tbin = __shfl(tbin, istar);
      cgt = __shfl(cgt, istar);
      T = lo + (u32)tbin;
      need = 256 - cgt;
    } else {
      u32 hi = (u32)H + 1u;
      while (hi - lo > 1) {
        const u32 mid = (lo + hi) >> 1;
        if (count_ge(r, nj, mid) >= 256) lo = mid; else hi = mid;
      }
      T = lo;
      const int cgt = (T >= 65535u) ? 0 : count_ge(r, nj, T + 1);
      need = 256 - cgt;
    }
  }
  int mlo[2] = {0, 0}, mhi[2] = {0, 0};
  const u32 thi = (T << 16) | 0xFFFFu;
#pragma unroll
  for (int j = 0; j < 64; ++j) {
    if (j < nj) {
#pragma unroll
      for (int hfw = 0; hfw < 2; ++hfw) {
        const u32 cd = hfw ? (r[j] >> 16) : (r[j] & 0xFFFFu);
        u64 word = hfw ? __ballot(r[j] > thi) : __ballot(cd > T);
        if (T > 0 && need > 0) {
          const bool eq = cd == T;
          const u64 eqm = __ballot(eq);
          if (eqm != 0) {
            const int rank = __builtin_amdgcn_mbcnt_hi((u32)(eqm >> 32), __builtin_amdgcn_mbcnt_lo((u32)eqm, 0));
            word |= __ballot(eq && rank < need);
            need -= __popcll(eqm);
          }
        }
        const int widx = 2 * j + hfw;
        if (lane == (widx & 63)) { mlo[widx >> 6] = (int)(u32)word; mhi[widx >> 6] = (int)(u32)(word >> 32); }
      }
    }
  }
  u32x2* mrow = (u32x2*)(p.ws + OFF_MASK + (size_t)Q * 1024);
#pragma unroll
  for (int k = 0; k < 2; ++k)
    if (lane + 64 * k < 2 * nj) mrow[lane + 64 * k] = u32x2{(u32)mlo[k], (u32)mhi[k]};
}

__device__ __forceinline__ void b2_phase(const P& p, int bid, int nb, char* smem, int tid) {
  const int rounds = (4096 + nb - 1) / nb;
  u32 ra[64], rb[64];
  int ia = snake_item(0, bid, nb);
  if (ia < 4096) b2_load(p, ia, tid, ra);
#pragma unroll 1
  for (int k = 0; k < rounds; k += 2) {
    const int ib = (k + 1 < rounds) ? snake_item(k + 1, bid, nb) : 4096;
    if (ib < 4096) b2_load(p, ib, tid, rb);
    if (ia < 4096) b2_process(p, ia, smem, tid, ra);
    ia = (k + 2 < rounds) ? snake_item(k + 2, bid, nb) : 4096;
    if (ia < 4096) b2_load(p, ia, tid, ra);
    if (ib < 4096) b2_process(p, ib, smem, tid, rb);
  }
}

__device__ __forceinline__ void b3_item(const P& p, int l, int item, char* smem, int tid) {
  const int lane = tid & 63, w = tid >> 6, h = lane >> 5, lr = lane & 31;
  const int g = 63 - (item >> 4), rem = item & 15, b = rem >> 3, head = rem & 7;
  const int q0 = g * 128;
  const int nkt = 2 * g + 2;
  const u16* AK = (const u16*)(p.ws + OFF_AK) + (size_t)b * SEQ * 512 + head * 64;
  const u16* AVT = (const u16*)(p.ws + OFF_AVT) + ((size_t)(b * 512 + head * 64)) * 8192;
  const u64* MK = (const u64*)(p.ws + OFF_MASK) + (size_t)(b * SEQ + q0) * 128;
  bf16x8 qf[4];
  {
    const u16* qrow = (const u16*)(p.ws + OFF_AQ) + (size_t)(b * SEQ + q0 + w * 32 + lr) * 512 + head * 64;
#pragma unroll
    for (int ks = 0; ks < 4; ++ks) qf[ks] = *(const bf16x8*)(qrow + ks * 16 + 8 * h);
  }
  u32x4 kr[2], vr[2];
  u64 mr = 0;
  g2r<64>(kr, AK, 512, tid);
  g2r<64>(vr, AVT, 8192, tid);
  if (tid < 128) mr = MK[(size_t)tid * 128];
  r2s<64>(kr, smem, tid);
  r2s<64>(vr, smem + 8192, tid);
  if (tid < 128) *(u64*)(smem + 16384 + tid * 8) = mr;
  __syncthreads();
  f32x16 oacc[2];
#pragma unroll
  for (int i = 0; i < 2; ++i)
#pragma unroll
    for (int r = 0; r < 16; ++r) oacc[i][r] = 0.f;
  float mrun = -5e29f, lrun = 0.f;
  float mq = fabsf(p.qn[l * 64 + lane]), mk = fabsf(p.kn[l * 64 + lane]);
#pragma unroll
  for (int o = 32; o >= 1; o >>= 1) { mq = fmaxf(mq, __shfl_xor(mq, o)); mk = fmaxf(mk, __shfl_xor(mk, o)); }
  const bool fast = (0.125f * 1.4426950408889634f * 64.f * 1.03f) * mq * mk + 1.f < 60.f;
  for (int kt = 0; kt < nkt; ++kt) {
    const char* buf = smem + (kt & 1) * 17408;
    char* nbuf = smem + ((kt + 1) & 1) * 17408;
    if (kt + 1 < nkt) {
      g2r<64>(kr, AK + (size_t)(kt + 1) * 64 * 512, 512, tid);
      g2r<64>(vr, AVT + (kt + 1) * 64, 8192, tid);
      if (tid < 128) mr = MK[(size_t)tid * 128 + kt + 1];
    }
    const u64 m64 = *(const u64*)(buf + 16384 + (w * 32 + lr) * 8);
    const u64 msh = ~(m64 >> (4 * h));
    const int w0 = (int)(u32)msh, w1 = (int)(u32)(msh >> 32);
    f32x16 s[2];
#pragma unroll
    for (int kb = 0; kb < 2; ++kb) {
#pragma unroll
      for (int r = 0; r < 16; ++r)
        s[kb][r] = __int_as_float(__builtin_amdgcn_sbfe(kb ? w1 : w0, (r & 3) + 8 * (r >> 2), 1) & (int)0xF149F2CAu);
#pragma unroll
      for (int ks = 0; ks < 4; ++ks)
        s[kb] = __builtin_amdgcn_mfma_f32_32x32x16_bf16(lds_frag(buf, kb * 32 + lr, ks * 2 + h), qf[ks], s[kb], 0, 0, 0);
    }
    float psum = 0.f;
    if (fast) {
#pragma unroll
      for (int kb = 0; kb < 2; ++kb)
#pragma unroll
        for (int r = 0; r < 16; ++r) {
          const float pv = __builtin_amdgcn_exp2f(s[kb][r]);
          s[kb][r] = pv;
          psum += pv;
        }
    } else {
      float tmax = s[0][0];
#pragma unroll
      for (int kb = 0; kb < 2; ++kb)
#pragma unroll
        for (int r = 0; r < 16; ++r) tmax = fmaxf(tmax, s[kb][r]);
      tmax = fmaxf(tmax, __shfl_xor(tmax, 32));
      if (__any(tmax > mrun)) {
        const float mnew = fmaxf(mrun, tmax);
        const float alpha = __builtin_amdgcn_exp2f(mrun - mnew);
        mrun = mnew;
        lrun *= alpha;
#pragma unroll
        for (int i = 0; i < 2; ++i)
#pragma unroll
          for (int r = 0; r < 16; ++r) oacc[i][r] *= alpha;
      }
#pragma unroll
      for (int kb = 0; kb < 2; ++kb)
#pragma unroll
        for (int r = 0; r < 16; ++r) {
          const float pv = __builtin_amdgcn_exp2f(s[kb][r] - mrun);
          s[kb][r] = pv;
          psum += pv;
        }
    }
    lrun += psum;
    const char* vt = buf + 8192;
#pragma unroll
    for (int kb = 0; kb < 2; ++kb)
#pragma unroll
      for (int s2 = 0; s2 < 2; ++s2) {
        union { bf16x8 v; u32 u[4]; } pf;
#pragma unroll
        for (int j = 0; j < 4; ++j) pf.u[j] = pack2(s[kb][8 * s2 + 2 * j], s[kb][8 * s2 + 2 * j + 1]);
#pragma unroll
        for (int db = 0; db < 2; ++db) {
          const int drow = db * 32 + lr;
          const int ch = kb * 4 + 2 * s2;
          const int sw = (drow >> 1) & 7;
          union { bf16x8 v; u32x2 u[2]; } vf;
          vf.u[0] = *(const u32x2*)(vt + drow * 128 + ((ch ^ sw) << 4) + 8 * h);
          vf.u[1] = *(const u32x2*)(vt + drow * 128 + (((ch + 1) ^ sw) << 4) + 8 * h);
          oacc[db] = __builtin_amdgcn_mfma_f32_32x32x16_bf16(vf.v, pf.v, oacc[db], 0, 0, 0);
        }
      }
    if (kt + 1 < nkt) {
      r2s<64>(kr, nbuf, tid);
      r2s<64>(vr, nbuf + 8192, tid);
      if (tid < 128) *(u64*)(nbuf + 16384 + tid * 8) = mr;
    }
    __syncthreads();
  }
  lrun += __shfl_xor(lrun, 32);
  const float inv = 1.f / lrun;
  u16* yrow = (u16*)(p.ws + OFF_YA) + (size_t)(b * SEQ + q0 + w * 32 + lr) * 512 + head * 64;
#pragma unroll
  for (int db = 0; db < 2; ++db)
#pragma unroll
    for (int rg = 0; rg < 4; ++rg) {
      const int d0 = db * 32 + 8 * rg + 4 * h;
      *(u32x2*)(yrow + d0) = u32x2{pack2(oacc[db][rg * 4] * inv, oacc[db][rg * 4 + 1] * inv),
                                   pack2(oacc[db][rg * 4 + 2] * inv, oacc[db][rg * 4 + 3] * inv)};
    }
}

__device__ __forceinline__ void d1_item(const P& p, int l, int mt, int nt, char* smem, int tid) {
  const int lane = tid & 63, w = tid >> 6, wm = w & 1, wn = w >> 1, lr = lane & 31;
  const int m0 = mt * 128, n0 = nt * 64;
  float* rs = (float*)(smem + 65536);
  const float* rowss = (const float*)(p.ws + OFF_ROWSS);
  if (tid < 128) rs[tid] = row_rstd(rowss, m0 + tid);
  const u16* XB = (const u16*)(p.ws + OFF_XB) + (size_t)m0 * 1024;
  f32x16 ag[2][2];
  zero_acc<2>(ag);
  gemm_loop<128, 2>(ag, XB, 1024, (const u16*)(p.ws + OFF_WGATE) + (size_t)nt * 128 * 1024, 1024, 16, smem, tid);
#pragma unroll
  for (int mi = 0; mi < 2; ++mi)
#pragma unroll
    for (int r = 0; r < 16; ++r) {
      const float rstd = rs[wm * 64 + mi * 32 + rowof(r, lane)];
      ag[mi][0][r] = sigmoidf_(ag[mi][0][r] * rstd);
      ag[mi][1][r] = sigmoidf_(ag[mi][1][r] * rstd);
    }
  f32x16 res[2][1], ap[2][1];
#pragma unroll
  for (int br = 0; br < 2; ++br) {
    zero_acc<1>(ap);
    const u16* Y = (const u16*)(p.ws + (br ? OFF_YH : OFF_YA)) + (size_t)m0 * 512;
    const u16* WP = (const u16*)(p.ws + (br ? OFF_WPH : OFF_WPA)) + (size_t)n0 * 512;
    gemm_loop<64, 1>(ap, Y, 512, WP, 512, 8, smem, tid);
#pragma unroll
    for (int mi = 0; mi < 2; ++mi)
#pragma unroll
      for (int r = 0; r < 16; ++r) {
        const float v = ag[mi][br][r] * ap[mi][0][r];
        res[mi][0][r] = br ? res[mi][0][r] + v : v;
      }
  }
  u16* M = (u16*)(p.ws + OFF_MERGED);
#pragma unroll
  for (int mi = 0; mi < 2; ++mi)
#pragma unroll
    for (int r = 0; r < 16; ++r) {
      const int tok = m0 + wm * 64 + mi * 32 + rowof(r, lane);
      M[(size_t)tok * 1024 + n0 + wn * 32 + lr] = f2bf(res[mi][0][r]);
    }
}

__device__ __forceinline__ void resid_item(const P& p, const u16* A, int K, const u16* W, float* rowss_next, int mt, int nt, char* smem,
                           int tid) {
  const int lane = tid & 63, w = tid >> 6, wm = w & 1, wn = w >> 1, lr = lane & 31;
  const int m0 = mt * 128, n0 = nt * 128;
  f32x16 acc[2][2];
  zero_acc<2>(acc);
  gemm_loop<128, 2>(acc, A + (size_t)m0 * K, K, W + (size_t)n0 * K, K, K >> 6, smem, tid);
  u16* XB = (u16*)(p.ws + OFF_XB);
  float myss = 0.f;
  int mytok = 0;
#pragma unroll
  for (int mi = 0; mi < 2; ++mi)
#pragma unroll
    for (int r = 0; r < 16; ++r) {
      const int tok = m0 + wm * 64 + mi * 32 + rowof(r, lane);
      float ss = 0.f;
#pragma unroll
      for (int ni = 0; ni < 2; ++ni) {
        const size_t o = (size_t)tok * 1024 + n0 + wn * 64 + ni * 32 + lr;
        const float xn = p.out[o] + acc[mi][ni][r];
        p.out[o] = xn;
        XB[o] = f2bf(xn);
        ss += xn * xn;
      }
#pragma unroll
      for (int of = 16; of >= 1; of >>= 1) ss += __shfl_xor(ss, of);
      if (lr == mi * 16 + r) { myss = ss; mytok = tok; }
      __builtin_amdgcn_sched_barrier(0);
    }
  rowss_next[(size_t)mytok * 16 + nt * 2 + wn] = myss;
}

__device__ __forceinline__ void e_item(const P& p, int l, int mt, int nt, char* smem, int tid) {
  const int lane = tid & 63, w = tid >> 6, wm = w & 1, wn = w >> 1, lr = lane & 31;
  const int m0 = mt * 128;
  float* rs = (float*)(smem + 65536);
  const float* rowss = (const float*)(p.ws + OFF_ROWSS) + (size_t)NTOK * 16;
  if (tid < 128) rs[tid] = row_rstd(rowss, m0 + tid);
  f32x16 acc[2][2];
  zero_acc<2>(acc);
  gemm_loop<128, 2>(acc, (const u16*)(p.ws + OFF_XB) + (size_t)m0 * 1024, 1024,
                    (const u16*)(p.ws + OFF_WFFI) + (size_t)nt * 128 * 1024, 1024, 16, smem, tid);
  u16* ACT = (u16*)(p.ws + OFF_ACT);
#pragma unroll
  for (int mi = 0; mi < 2; ++mi)
#pragma unroll
    for (int r = 0; r < 16; ++r) {
      const int tl = wm * 64 + mi * 32 + rowof(r, lane);
      const float rstd = rs[tl];
      const float gv = acc[mi][0][r] * rstd, uv = acc[mi][1][r] * rstd;
      ACT[(size_t)(m0 + tl) * DFF + nt * 64 + wn * 32 + lr] = f2bf(siluf_(gv) * uv);
    }
}

constexpr int PPL = 10;
#ifndef ONLY_S
#define ONLY_S -1
#endif
#define EN(k) (ONLY_S < 0 || ONLY_S == (k))
template <class F>
__device__ __forceinline__ void for_tiles(int NT, int bid, int nb, F f) {
  if ((nb & 63) == 0) {
    const int vx = bid & 7, j = bid >> 3, JN = nb >> 6;
    const int jm = j & 7, jn = j >> 3;
    const int NG = (NT + JN - 1) / JN;
    const int wl = NT - (NG - 1) * JN;
    const bool fold = (wl * 2 == JN);
    const int NGF = fold ? NG - 1 : NG;
    for (int r = 0; r < 2 * NGF; ++r) {
      const int mh = r / NGF, ng = r - mh * NGF;
      const int mt = vx * 16 + mh * 8 + jm, nt = ng * JN + jn;
      if (nt < NT) f(mt, nt);
    }
    if (fold) f(vx * 16 + (jn / wl) * 8 + jm, (NG - 1) * JN + (jn % wl));
  } else {
    for (int it = bid; it < 128 * NT; it += nb) f(it / NT, it % NT);
  }
}
__device__ __forceinline__ int snake_item(int k, int bid, int nb) {
  return (k & 1) ? (((k + 1) * nb - 1 - bid) ^ 7) : (k * nb + bid);
}

__device__ __forceinline__ void run_phase(const P& p, int ph, char* smem) {
  int tid0 = threadIdx.x;
  asm volatile("" : "+v"(tid0));
  const int nb = gridDim.x;
  int bid = blockIdx.x;
  asm volatile("" : "+s"(bid));
#define LAUNDER int tid = tid0; asm volatile("" : "+v"(tid)); __syncthreads();
  if (ph == 0) {
    if (EN(11)) for (int it = bid; it < 4096 + 992; it += nb) { LAUNDER
      if (it < 4096) p0_rows(p, it, tid); else conv_item(p, 0, it - 4096, smem, tid);
    }
    return;
  }
  const int l = (ph - 1) / PPL;
  const int smap[PPL] = {0, 4, 5, 6, 2, 3, 7, 8, 9, 10};
  const int s = smap[(ph - 1) % PPL];
  float* rowss = (float*)(p.ws + OFF_ROWSS);
  switch (s) {
    case 0: if (EN(0)) {
      const int par = (bid >> 8) & 1;
      const int cbase = l > 0 ? 3424 : 992, ccnt = l > 0 ? 704 : 3136;
      if (par) for (int it = bid; it < ccnt; it += nb) { LAUNDER conv_item(p, l, cbase + it, smem, tid); }
      for_tiles(31, bid, nb, [&](int mt, int nt) { LAUNDER phaseA_tile(p, l, mt, nt, smem, tid); });
      if (!par) for (int it = bid; it < ccnt; it += nb) { LAUNDER conv_item(p, l, cbase + it, smem, tid); }
    } break;
    case 2: if (EN(2)) for (int it = bid; it < 256; it += nb) { LAUNDER h2_item(p, it, tid); } break;
    case 3: if (EN(3)) for (int it = bid; it < 1024; it += nb) { LAUNDER h3_item(p, l, it, smem, tid); } break;
    case 4: if (EN(4)) for (int it = bid; it < 4160; it += nb) { LAUNDER b1_item(p, it, smem, tid); } break;
    case 5: if (EN(5)) { int tid = tid0; asm volatile("" : "+v"(tid)); b2_phase(p, bid, nb, smem, tid); } break;
    case 6: if (EN(6)) {
      const int par = (bid >> 8) & 1;
      if (par) for (int it = bid; it < 1024; it += nb) { LAUNDER h1_item(p, it, smem, tid); }
      for (int k = 0; k * nb < 1024; ++k) { const int it = snake_item(k, bid, nb); if (it < 1024) { LAUNDER b3_item(p, l, it, smem, tid); } }
      if (!par) for (int it = bid; it < 1024; it += nb) { LAUNDER h1_item(p, it, smem, tid); }
    } break;
    case 7: if (EN(7)) for_tiles(16, bid, nb, [&](int mt, int nt) { LAUNDER d1_item(p, l, mt, nt, smem, tid); }); break;
    case 8:
      if (EN(8)) for_tiles(8, bid, nb, [&](int mt, int nt) { LAUNDER
        resid_item(p, (const u16*)(p.ws + OFF_MERGED), 1024, (const u16*)(p.ws + OFF_WOUT), rowss + (size_t)NTOK * 16, mt, nt, smem, tid); });
      break;
    case 9: if (EN(9)) for_tiles(44, bid, nb, [&](int mt, int nt) { LAUNDER e_item(p, l, mt, nt, smem, tid); }); break;
    case 10: if (EN(10)) {
      const int par = (bid >> 8) & 1;
      if (l < 3 && par) for (int it = bid; it < 3424; it += nb) { LAUNDER conv_item(p, l + 1, it, smem, tid); }
      for_tiles(8, bid, nb, [&](int mt, int nt) { LAUNDER
        resid_item(p, (const u16*)(p.ws + OFF_ACT), DFF, (const u16*)(p.ws + OFF_WFFO), rowss, mt, nt, smem, tid); });
      if (l < 3 && !par) for (int it = bid; it < 3424; it += nb) { LAUNDER conv_item(p, l + 1, it, smem, tid); }
    } break;
  }
#undef LAUNDER
}

constexpr int NPHASE = 1 + PPL * DEPTH;

#ifndef REP_MASK
#define REP_MASK 0
#endif
#define XB_TMO      128
#define XB_XCNT(j)  (256  + 64 * (j))
#define XB_XSUB(j)  (1280 + 64 * (j))
#define XB_XGEN(j)  (2304 + 64 * (j))
#define XB_TOP      3328
#define XB_TOPGEN   3392
#define XCD_BAR_WORDS 3456
#define XB_SPIN_CAP (1u << 18)
#define LAS __attribute__((address_space(3)))

__device__ __forceinline__ unsigned xb_ld(unsigned* p)              { return __hip_atomic_load(p, __ATOMIC_RELAXED, __HIP_MEMORY_SCOPE_AGENT); }
__device__ __forceinline__ unsigned xb_add(unsigned* p, unsigned v) { return __hip_atomic_fetch_add(p, v, __ATOMIC_RELAXED, __HIP_MEMORY_SCOPE_AGENT); }
__device__ __forceinline__ unsigned xb_xcc_id() { return (unsigned)__builtin_amdgcn_s_getreg((3 << 11) | 20) & 0xFu; }
#define XB_SPIN(cond, bar) do { unsigned _sp = 0; while (cond) { __builtin_amdgcn_s_sleep(1); \
    if ((++_sp & 255u) == 0u) { if (xb_ld(&(bar)[XB_TMO])) break; if (_sp > XB_SPIN_CAP) { atomicAdd(&(bar)[XB_TMO], 1u); break; } } } } while (0)

struct XcdBarrier {
    unsigned* bar; unsigned x;
    volatile LAS unsigned* st;
};

__device__ __forceinline__ XcdBarrier xcd_barrier_post(unsigned* bar, volatile LAS unsigned* st) {
    XcdBarrier b; b.bar = bar; b.x = xb_xcc_id(); b.st = st;
    if (threadIdx.x == 0) (void)xb_add(&bar[XB_XCNT(b.x)], 1u);
    return b;
}
__device__ __forceinline__ void xcd_barrier_complete(unsigned* bar, unsigned x, unsigned& nloc, unsigned& nx) {
    const unsigned G = gridDim.x * gridDim.y * gridDim.z;
    unsigned sum, cnt, mine, sp = 0u;
    for (;;) {
        sum = 0u; cnt = 0u; mine = 0u;
#pragma unroll
        for (unsigned j = 0; j < 16; ++j) { const unsigned c = xb_ld(&bar[XB_XCNT(j)]); sum += c; cnt += (c > 0u) ? 1u : 0u; mine = (j == x) ? c : mine; }
        if (sum == G) break;
        __builtin_amdgcn_s_sleep(1);
        if ((++sp & 255u) == 0u) { if (xb_ld(&bar[XB_TMO])) break; if (sp > XB_SPIN_CAP) { atomicAdd(&bar[XB_TMO], 1u); break; } }
    }
    nloc = mine > 0u ? mine : 1u; nx = cnt > 0u ? cnt : 1u;
}

__device__ __forceinline__ void xcd_barrier(const XcdBarrier& b) {
    asm volatile("s_waitcnt vmcnt(0)" ::: "memory");
    __syncthreads();
    if (threadIdx.x == 0) {
        unsigned* bar = b.bar;
        __builtin_amdgcn_s_waitcnt(0);
        unsigned nloc = b.st[0], nx = b.st[1];
        if (nloc == 0u) { xcd_barrier_complete(bar, b.x, nloc, nx); b.st[0] = nloc; b.st[1] = nx; }
        const unsigned old = xb_add(&bar[XB_XSUB(b.x)], 1u);
        const unsigned gen = old / nloc;
        if (old + 1u == (gen + 1u) * nloc) {
            __builtin_amdgcn_fence(__ATOMIC_RELEASE, "agent");
            asm volatile("s_waitcnt vmcnt(0)" ::: "memory");
            const unsigned og = xb_add(&bar[XB_TOP], 1u);
            const unsigned tg = og / nx;
            if (og + 1u == (tg + 1u) * nx) xb_add(&bar[XB_TOPGEN], 1u);
            else XB_SPIN(xb_ld(&bar[XB_TOPGEN]) == tg, bar);
            __builtin_amdgcn_fence(__ATOMIC_ACQUIRE, "agent");
            xb_add(&bar[XB_XGEN(b.x)], 1u);
            asm volatile("s_waitcnt vmcnt(0)" ::: "memory");
        } else {
            XB_SPIN(xb_ld(&bar[XB_XGEN(b.x)]) == gen, bar);
            __builtin_amdgcn_fence(__ATOMIC_ACQUIRE, "agent");
            asm volatile("s_waitcnt vmcnt(0)" ::: "memory");
        }
    }
    __syncthreads();
}


template <bool COOP>
__global__ void __launch_bounds__(256, 2) mega(P p, int ph0, int ph1) {
  __shared__ __attribute__((aligned(16))) char smem[66560];
  __shared__ uint4 xb_words;
  if (threadIdx.x == 0) xb_words = make_uint4(0u, 0u, 0u, 0u);
  __syncthreads();
  XcdBarrier xb = xcd_barrier_post((unsigned*)(p.ws + OFF_BAR), (volatile LAS unsigned*)&xb_words);
  for (int ph = ph0; ph < ph1; ++ph) {
    int reps = 1;
    if (REP_MASK != 0 && ph > 0 && ((REP_MASK >> ((ph - 1) % PPL)) & 1)) reps = 2;
    for (int rp = 0; rp < reps; ++rp) {
      run_phase(p, ph, smem);
      if (COOP) {
        if (ph + 1 < ph1 || rp + 1 < reps) {
          if (ph == 0) cg::this_grid().sync();
          else xcd_barrier(xb);
        }
      }
    }
  }
}

extern "C" void kernel_launch(void* const* d_in, const int* in_sizes, int n_in, void* d_out, int out_size, void* d_ws,
                              size_t ws_size, hipStream_t stream) {
  if (ws_size < WS_END) { fprintf(stderr, "workspace too small: %zu\n", ws_size); return; }
  P p{};
  p.x = (const float*)d_in[0]; p.pos = (const int*)d_in[1]; p.w_in = (const float*)d_in[2];
  p.w_pa = (const float*)d_in[3]; p.w_ph = (const float*)d_in[4]; p.w_out = (const float*)d_in[5];
  p.nmix = (const float*)d_in[6]; p.nffn = (const float*)d_in[7]; p.qn = (const float*)d_in[8];
  p.kn = (const float*)d_in[9]; p.hn = (const float*)d_in[10]; p.hlb = (const float*)d_in[11];
  p.w_ffi = (const float*)d_in[12]; p.w_ffo = (const float*)d_in[13];
  p.out = (float*)d_out; p.ws = (char*)d_ws;
#if COOP_MODE
  static int grid_blocks = 0;
  if (!grid_blocks) {
    int dev = 0, cus = 0, per_cu = 0;
    hipGetDevice(&dev);
    hipDeviceGetAttribute(&cus, hipDeviceAttributeMultiprocessorCount, dev);
    hipOccupancyMaxActiveBlocksPerMultiprocessor(&per_cu, mega<true>, 256, 0);
    if (per_cu > 2) per_cu = 2;
    grid_blocks = cus * per_cu;
  }
  int ph0 = 0, ph1 = NPHASE;
  hipMemsetAsync((char*)d_ws + OFF_BAR, 0, 16384, stream);
  void* args[] = {&p, &ph0, &ph1};
  hipError_t e = hipLaunchCooperativeKernel((void*)mega<true>, dim3(grid_blocks), dim3(256), args, 0, stream);
  if (e != hipSuccess) fprintf(stderr, "cooperative launch failed: %s (grid %d)\n", hipGetErrorString(e), grid_blocks);
#else
  for (int ph = 0; ph < NPHASE; ++ph) mega<false><<<dim3(512), dim3(256), 0, stream>>>(p, ph, ph + 1);
#endif
}
```
